# Optimizing an MI355X kernel written in HIP

```python
import jax, jax.numpy as jnp
from jax import lax
import numpy as np

D_MODEL = 1024
BATCH = 8
SEQ = 2048
DEPTH = 2

CTX_LEN = 256
GRID_W = 64

N_MOD = 6
DEEPNORM_ALPHA = (2.0 * DEPTH) ** 0.25
DEEPNORM_BETA = (8.0 * DEPTH) ** -0.25
LN_EPS = 1e-5
RMS_EPS = 1e-6

MLA_V = 64
MLA_HEADS = D_MODEL // (2 * MLA_V)
MLA_NOPE = 64
MLA_ROPE = 32
MLA_Q_RANK = 384
MLA_KV_RANK = 256
ROPE_AXIS = MLA_ROPE // 2
ROPE_THETA = 10000.0
Q_BLOCK = 128

RWKV_HEAD = 64
RWKV_HEADS = D_MODEL // (2 * RWKV_HEAD)
RWKV_W = RWKV_HEADS * RWKV_HEAD
DECAY_LORA = 64
AAA_LORA = 64
GATE_LORA = 128
GN_EPS = 64e-5
RWKV_IN = 3 * RWKV_W + 2 * DECAY_LORA + 2 * AAA_LORA + GATE_LORA
RWKV_SPLIT = (RWKV_W, 2 * RWKV_W, 3 * RWKV_W, 3 * RWKV_W + 2 * DECAY_LORA, 3 * RWKV_W + 2 * DECAY_LORA + 2 * AAA_LORA)

EVEN_SPLIT = (MLA_Q_RANK, MLA_Q_RANK + MLA_KV_RANK, MLA_Q_RANK + MLA_KV_RANK + MLA_ROPE)
EVEN_IN = EVEN_SPLIT[-1] + RWKV_IN

LRU_WIDTH = D_MODEL
LRU_BLOCKS = 8
LRU_BLOCK = LRU_WIDTH // LRU_BLOCKS
LRU_C = 8.0
CONV_W = 4

D_FF = 4 * D_MODEL

kernel_name = 'hybrid_mla_rwkv7_rglru_diffusion_trunk'


def layer_norm(x, g, b):
    xf = x.astype(jnp.float32)
    mu = jnp.mean(xf, axis=-1, keepdims=True)
    var = jnp.mean(jnp.square(xf - mu), axis=-1, keepdims=True)
    return ((xf - mu) * lax.rsqrt(var + LN_EPS)).astype(x.dtype) * g + b


def rms_norm(x, g):
    xf = x.astype(jnp.float32)
    return (xf * lax.rsqrt(jnp.mean(jnp.square(xf), axis=-1, keepdims=True) + RMS_EPS)).astype(x.dtype) * g


def modulate(x, shift, scale):
    return x * (1.0 + scale) + shift


def squared_relu_mlp(h, w1, w2):
    return jnp.square(jax.nn.relu(h @ w1)) @ w2


def axial_rope_tables(n):
    rows_n = n // GRID_W
    rows = jnp.repeat(jnp.arange(rows_n, dtype=jnp.float32), GRID_W)
    cols = jnp.tile(jnp.arange(GRID_W, dtype=jnp.float32), rows_n)
    inv_freq = ROPE_THETA ** (-jnp.arange(0, ROPE_AXIS, 2, dtype=jnp.float32) / ROPE_AXIS)
    ang_r = rows[:, None] * inv_freq
    ang_c = cols[:, None] * inv_freq
    ang = jnp.concatenate([ang_r, ang_r, ang_c, ang_c], axis=-1)
    return jnp.cos(ang), jnp.sin(ang)


def rotate_half_axial(x):
    xs = x.reshape(x.shape[:-1] + (2, 2, ROPE_AXIS // 2))
    x1, x2 = xs[..., 0, :], xs[..., 1, :]
    return jnp.stack([-x2, x1], axis=-2).reshape(x.shape)


def apply_rope(x, cos, sin):
    return x * cos.astype(x.dtype) + rotate_half_axial(x) * sin.astype(x.dtype)


def softmax_attend(q, k, v):
    s = jnp.einsum('bqhd,bkhd->bhqk', q, k).astype(jnp.float32) * (MLA_NOPE + MLA_ROPE) ** -0.5
    p = jax.nn.softmax(s, axis=-1).astype(v.dtype)
    return jnp.einsum('bhqk,bkhd->bqhd', p, v)


def blocked_attend(q, k, v):
    b, n, h, dk = q.shape
    qb = q.reshape(b, n // Q_BLOCK, Q_BLOCK, h, dk).transpose(1, 0, 2, 3, 4)
    out = lax.map(lambda blk: softmax_attend(blk, k, v), qb)
    return out.transpose(1, 0, 2, 3, 4).reshape(b, n, h, v.shape[-1])


def mla_features(f_q, f_kv, f_kr, q_norm, w_uq, kv_norm, w_uk, w_uv, rope):
    b, n = f_q.shape[:2]
    q = (rms_norm(f_q, q_norm) @ w_uq).reshape(b, n, MLA_HEADS, MLA_NOPE + MLA_ROPE)
    q_nope, q_rope = q[..., :MLA_NOPE], q[..., MLA_NOPE:]
    ckv = rms_norm(f_kv, kv_norm)
    k_nope = (ckv @ w_uk).reshape(b, n, MLA_HEADS, MLA_NOPE)
    v = (ckv @ w_uv).reshape(b, n, MLA_HEADS, MLA_V)
    k_rope = f_kr
    if rope is not None:
        cos, sin = rope
        q_rope = apply_rope(q_rope, cos[:, None, :], sin[:, None, :])
        k_rope = apply_rope(k_rope, cos, sin)
    q = jnp.concatenate([q_nope, q_rope], axis=-1)
    k = jnp.concatenate([k_nope, jnp.broadcast_to(k_rope[:, :, None, :], (b, n, MLA_HEADS, MLA_ROPE))], axis=-1)
    return q, k, v


def centred_shift(f):
    prev = jnp.pad(f[:, :-1], ((0, 0), (1, 0), (0, 0)))
    nxt = jnp.pad(f[:, 1:], ((0, 0), (0, 1), (0, 0)))
    return 0.5 * (prev + nxt)


def rwkv_features(f, mu, w0, w2, a0, a2, g2, k_k, k_a):
    f = f.astype(jnp.float32)
    f = f + mu * (centred_shift(f) - f)
    r, k, v, wl, al, gl = jnp.split(f, RWKV_SPLIT, axis=-1)
    b, n = f.shape[:2]
    heads = lambda t: t.reshape(t.shape[:-1] + (RWKV_HEADS, RWKV_HEAD))
    w_raw = w0 + jnp.einsum('bndl,dlc->bndc', jnp.tanh(wl.reshape(b, n, 2, DECAY_LORA)), w2)
    decay = jnp.exp(-jnp.exp(-jax.nn.softplus(-w_raw) - 0.5))
    a = jax.nn.sigmoid(a0 + jnp.einsum('bndl,dlc->bndc', al.reshape(b, n, 2, AAA_LORA), a2))
    g = jax.nn.sigmoid(gl) @ g2
    kk = heads(k * k_k)
    kk = kk * lax.rsqrt(jnp.sum(kk * kk, axis=-1, keepdims=True) + 1e-12)
    k_dir = heads(k[:, :, None, :] * (1.0 + (a - 1.0) * k_a))
    return heads(r), k_dir, heads(v), kk, heads(a), heads(decay), g


def rwkv7_scan(r, decay, k, v, kk, a, s0, reverse):
    def step(S, inp):
        r_t, w_t, k_t, v_t, kk_t, a_t = inp
        sa = jnp.einsum('bhij,bhj->bhi', S, kk_t)
        S = S * w_t[:, :, None, :] - sa[..., :, None] * (kk_t * a_t)[..., None, :] + v_t[..., :, None] * k_t[..., None, :]
        return S, jnp.einsum('bhij,bhj->bhi', S, r_t)
    xs = tuple(jnp.moveaxis(t.astype(jnp.float32), 1, 0) for t in (r, decay, k, v, kk, a))
    s_final, ys = lax.scan(step, s0, xs, reverse=reverse)
    return s_final, jnp.moveaxis(ys, 0, 1)


def rwkv_output(y, r, k_dir, v, r_k, gn_w, gn_b, g):
    b, n = y.shape[:2]
    mu = jnp.mean(y, axis=-1, keepdims=True)
    var = jnp.mean(jnp.square(y - mu), axis=-1, keepdims=True)
    yn = ((y - mu) * lax.rsqrt(var + GN_EPS)).reshape(b, n, RWKV_W) * gn_w + gn_b
    bonus = (jnp.sum(r[:, :, None] * k_dir * r_k, axis=(2, -1))[..., None] * v).reshape(b, n, RWKV_W)
    return (yn + bonus) * g


def depthwise_conv(x, w, b):
    y = lax.conv_general_dilated(x, w[:, None, :].astype(x.dtype), window_strides=(1,),
                                 padding=[(CONV_W // 2, CONV_W - 1 - CONV_W // 2)],
                                 dimension_numbers=('NWC', 'WIO', 'NWC'), feature_group_count=x.shape[-1])
    return y + b


def block_diag_linear(x, w, b):
    xb = x.reshape(x.shape[:-1] + (LRU_BLOCKS, LRU_BLOCK))
    return jnp.einsum('bnkc,kcd->bnkd', xb, w).reshape(x.shape) + b


def rglru_inputs(x, wa, ba, wx, bx, lam):
    xf = x.astype(jnp.float32)
    r = jax.nn.sigmoid(block_diag_linear(xf, wa, ba))
    i = jax.nn.sigmoid(block_diag_linear(xf, wx, bx))
    log_a = -LRU_C * r * jax.nn.softplus(-lam)
    return jnp.exp(log_a), jnp.sqrt(-jnp.expm1(2.0 * log_a)) * (i * xf)


def _lin_combine(e1, e2):
    a1, b1 = e1
    a2, b2 = e2
    return a1 * a2, a2 * b1 + b2


def rglru_scan(a, u, h0, reverse):
    a_cum, h = lax.associative_scan(_lin_combine, (a, u), axis=1, reverse=reverse)
    return h + a_cum * h0[:, None, :]


def even_mixer(hl, hc, w_in, q_norm, w_uq, kv_norm, w_uk, w_uv, mu, w0, w2, a0, a2, g2, k_k, k_a, r_k,
               gn_w, gn_b, w_out, ctx_out):
    b, n = hl.shape[:2]
    fq_l, fkv_l, fkr_l, frw_l = jnp.split(hl @ w_in, EVEN_SPLIT, axis=-1)
    fq_c, fkv_c, fkr_c, frw_c = jnp.split(hc @ w_in, EVEN_SPLIT, axis=-1)
    q_l, k_l, v_l = mla_features(fq_l, fkv_l, fkr_l, q_norm, w_uq, kv_norm, w_uk, w_uv, axial_rope_tables(n))
    q_c, k_c, v_c = mla_features(fq_c, fkv_c, fkr_c, q_norm, w_uq, kv_norm, w_uk, w_uv, None)
    att_l = blocked_attend(q_l, jnp.concatenate([k_l, k_c], axis=1),
                           jnp.concatenate([v_l, v_c], axis=1)).reshape(b, n, MLA_HEADS * MLA_V)
    r_l, kd_l, vr_l, kk_l, a_l, w_l, g_l = rwkv_features(frw_l, mu, w0, w2, a0, a2, g2, k_k, k_a)
    r_c, kd_c, vr_c, kk_c, a_c, w_c, g_c = rwkv_features(frw_c, mu, w0, w2, a0, a2, g2, k_k, k_a)
    s0 = jnp.zeros((b, RWKV_HEADS, RWKV_HEAD, RWKV_HEAD), jnp.float32)
    ys_l, ys_c = [], []
    for d, reverse in ((0, False), (1, True)):
        s_ctx, y_c = rwkv7_scan(r_c, w_c[:, :, d], kd_c[:, :, d], vr_c, kk_c, a_c[:, :, d], s0, reverse)
        _, y_l = rwkv7_scan(r_l, w_l[:, :, d], kd_l[:, :, d], vr_l, kk_l, a_l[:, :, d], s_ctx, reverse)
        ys_l.append(y_l)
        ys_c.append(y_c)
    rw_l = rwkv_output(ys_l[0] + ys_l[1], r_l, kd_l, vr_l, r_k, gn_w, gn_b, g_l).astype(hl.dtype)
    y_lat = jnp.concatenate([att_l, rw_l], axis=-1) @ w_out
    if ctx_out:
        att_c = softmax_attend(q_c, k_c, v_c).reshape(b, hc.shape[1], MLA_HEADS * MLA_V)
        rw_c = rwkv_output(ys_c[0] + ys_c[1], r_c, kd_c, vr_c, r_k, gn_w, gn_b, g_c).astype(hc.dtype)
        y_ctx = jnp.concatenate([att_c, rw_c], axis=-1) @ w_out
    else:
        y_ctx = None
    return y_lat, y_ctx


def odd_mixer(hl, hc, w_in, conv_w, conv_b, ga_w, ga_b, gx_w, gx_b, lam, w_out, ctx_out):
    b = hl.shape[0]
    gate_l, xr_l = jnp.split(hl @ w_in, 2, axis=-1)
    gate_c, xr_c = jnp.split(hc @ w_in, 2, axis=-1)
    xr_l = depthwise_conv(xr_l, conv_w, conv_b)
    xr_c = depthwise_conv(xr_c, conv_w, conv_b)
    hs_l, hs_c = [], []
    for d, reverse in ((0, False), (1, True)):
        a_c, u_c = rglru_inputs(xr_c, ga_w[d], ga_b[d], gx_w[d], gx_b[d], lam[d])
        h_c = rglru_scan(a_c, u_c, jnp.zeros((b, LRU_WIDTH), jnp.float32), reverse)
        h0 = h_c[:, 0] if reverse else h_c[:, -1]
        a_l, u_l = rglru_inputs(xr_l, ga_w[d], ga_b[d], gx_w[d], gx_b[d], lam[d])
        hs_l.append(rglru_scan(a_l, u_l, h0, reverse))
        hs_c.append(h_c)
    y_lat = (jax.nn.gelu(gate_l) * (hs_l[0] + hs_l[1]).astype(hl.dtype)) @ w_out
    if ctx_out:
        y_ctx = (jax.nn.gelu(gate_c) * (hs_c[0] + hs_c[1]).astype(hc.dtype)) @ w_out
    else:
        y_ctx = None
    return y_lat, y_ctx


def trunk_layer(x, xc, c, c_ctx, mixer_fn, mixer_params, mod_w, mod_b, ln1_g, ln1_b, mlp_w1, mlp_w2,
                ln2_g, ln2_b, ctx_out):
    mod_l = jnp.split(jax.nn.silu(c) @ mod_w + mod_b, N_MOD, axis=-1)
    mod_c = jnp.split(jax.nn.silu(c_ctx) @ mod_w + mod_b, N_MOD, axis=-1)
    sh1, sc1, g1, sh2, sc2, g2 = [m[:, None, :] for m in mod_l]
    csh1, csc1, cg1, csh2, csc2, cg2 = mod_c
    y_l, y_c = mixer_fn(modulate(x, sh1, sc1), modulate(xc, csh1, csc1), *mixer_params, ctx_out=ctx_out)
    x = layer_norm(DEEPNORM_ALPHA * x + g1 * y_l, ln1_g, ln1_b)
    x = layer_norm(DEEPNORM_ALPHA * x + g2 * squared_relu_mlp(modulate(x, sh2, sc2), mlp_w1, mlp_w2), ln2_g, ln2_b)
    if ctx_out:
        xc = layer_norm(DEEPNORM_ALPHA * xc + cg1 * y_c, ln1_g, ln1_b)
        xc = layer_norm(DEEPNORM_ALPHA * xc + cg2 * squared_relu_mlp(modulate(xc, csh2, csc2), mlp_w1, mlp_w2),
                        ln2_g, ln2_b)
    return x, xc


def setup_inputs(seed: int = 0) -> dict:
    key = jax.random.key(seed)
    ks = jax.random.split(key, 64)
    keys = iter([ks[i] for i in range(64)])

    def nrm(shape, scale):
        return scale * jax.random.normal(next(keys), shape, jnp.float32)

    def uni(shape, lo, hi):
        return jax.random.uniform(next(keys), shape, jnp.float32, lo, hi)

    def lru_lambda(shape):
        p = uni(shape, 0.9, 0.999) ** (1.0 / LRU_C)
        return jnp.log(p) - jnp.log1p(-p)

    D = D_MODEL
    return {
        'x': nrm((BATCH, SEQ, D), 1.0),
        'c': nrm((BATCH, D), 1.0),
        'ctx': nrm((BATCH, CTX_LEN, D), 1.0),
        'c_ctx': nrm((D,), 1.0),
        'l0_mod_w': nrm((D, N_MOD * D), 0.5 * D ** -0.5),
        'l0_mod_b': nrm((N_MOD * D,), 0.02),
        'l0_w_in': nrm((D, EVEN_IN), D ** -0.5),
        'l0_mla_q_norm': 1.0 + nrm((MLA_Q_RANK,), 0.05),
        'l0_mla_w_uq': nrm((MLA_Q_RANK, MLA_HEADS * (MLA_NOPE + MLA_ROPE)), MLA_Q_RANK ** -0.5),
        'l0_mla_kv_norm': 1.0 + nrm((MLA_KV_RANK,), 0.05),
        'l0_mla_w_uk': nrm((MLA_KV_RANK, MLA_HEADS * MLA_NOPE), MLA_KV_RANK ** -0.5),
        'l0_mla_w_uv': nrm((MLA_KV_RANK, MLA_HEADS * MLA_V), MLA_KV_RANK ** -0.5),
        'l0_rwkv_mu': uni((RWKV_IN,), 0.0, 1.0),
        'l0_rwkv_w0': uni((2, RWKV_W), -6.0, 1.0),
        'l0_rwkv_w2': nrm((2, DECAY_LORA, RWKV_W), 0.5 * DECAY_LORA ** -0.5),
        'l0_rwkv_a0': nrm((2, RWKV_W), 0.5),
        'l0_rwkv_a2': nrm((2, AAA_LORA, RWKV_W), 0.5 * AAA_LORA ** -0.5),
        'l0_rwkv_g2': nrm((GATE_LORA, RWKV_W), GATE_LORA ** -0.5),
        'l0_rwkv_k_k': 0.85 + nrm((RWKV_W,), 0.05),
        'l0_rwkv_k_a': 1.0 + nrm((RWKV_W,), 0.05),
        'l0_rwkv_r_k': nrm((RWKV_HEADS, RWKV_HEAD), 0.1),
        'l0_rwkv_gn_w': 1.0 + nrm((RWKV_W,), 0.05),
        'l0_rwkv_gn_b': nrm((RWKV_W,), 0.02),
        'l0_w_out': nrm((MLA_HEADS * MLA_V + RWKV_W, D), DEEPNORM_BETA * D ** -0.5),
        'l0_ln1_g': 1.0 + nrm((D,), 0.05),
        'l0_ln1_b': nrm((D,), 0.02),
        'l0_mlp_w1': nrm((D, D_FF), D ** -0.5),
        'l0_mlp_w2': nrm((D_FF, D), DEEPNORM_BETA * D_FF ** -0.5),
        'l0_ln2_g': 1.0 + nrm((D,), 0.05),
        'l0_ln2_b': nrm((D,), 0.02),
        'l1_mod_w': nrm((D, N_MOD * D), 0.5 * D ** -0.5),
        'l1_mod_b': nrm((N_MOD * D,), 0.02),
        'l1_w_in': nrm((D, 2 * LRU_WIDTH), D ** -0.5),
        'l1_conv_w': nrm((CONV_W, LRU_WIDTH), CONV_W ** -0.5),
        'l1_conv_b': nrm((LRU_WIDTH,), 0.02),
        'l1_lru_ga_w': nrm((2, LRU_BLOCKS, LRU_BLOCK, LRU_BLOCK), LRU_BLOCK ** -0.5),
        'l1_lru_ga_b': nrm((2, LRU_WIDTH), 0.02),
        'l1_lru_gx_w': nrm((2, LRU_BLOCKS, LRU_BLOCK, LRU_BLOCK), LRU_BLOCK ** -0.5),
        'l1_lru_gx_b': nrm((2, LRU_WIDTH), 0.02),
        'l1_lru_lambda': lru_lambda((2, LRU_WIDTH)),
        'l1_w_out': nrm((LRU_WIDTH, D), DEEPNORM_BETA * LRU_WIDTH ** -0.5),
        'l1_ln1_g': 1.0 + nrm((D,), 0.05),
        'l1_ln1_b': nrm((D,), 0.02),
        'l1_mlp_w1': nrm((D, D_FF), D ** -0.5),
        'l1_mlp_w2': nrm((D_FF, D), DEEPNORM_BETA * D_FF ** -0.5),
        'l1_ln2_g': 1.0 + nrm((D,), 0.05),
        'l1_ln2_b': nrm((D,), 0.02),
    }


def reference(x, c, ctx, c_ctx,
              l0_mod_w, l0_mod_b, l0_w_in, l0_mla_q_norm, l0_mla_w_uq, l0_mla_kv_norm, l0_mla_w_uk, l0_mla_w_uv,
              l0_rwkv_mu, l0_rwkv_w0, l0_rwkv_w2, l0_rwkv_a0, l0_rwkv_a2, l0_rwkv_g2, l0_rwkv_k_k, l0_rwkv_k_a,
              l0_rwkv_r_k, l0_rwkv_gn_w, l0_rwkv_gn_b, l0_w_out,
              l0_ln1_g, l0_ln1_b, l0_mlp_w1, l0_mlp_w2, l0_ln2_g, l0_ln2_b,
              l1_mod_w, l1_mod_b, l1_w_in, l1_conv_w, l1_conv_b, l1_lru_ga_w, l1_lru_ga_b, l1_lru_gx_w, l1_lru_gx_b,
              l1_lru_lambda, l1_w_out,
              l1_ln1_g, l1_ln1_b, l1_mlp_w1, l1_mlp_w2, l1_ln2_g, l1_ln2_b):
    mixers = (
        (even_mixer, (l0_w_in, l0_mla_q_norm, l0_mla_w_uq, l0_mla_kv_norm, l0_mla_w_uk, l0_mla_w_uv,
                      l0_rwkv_mu, l0_rwkv_w0, l0_rwkv_w2, l0_rwkv_a0, l0_rwkv_a2, l0_rwkv_g2, l0_rwkv_k_k,
                      l0_rwkv_k_a, l0_rwkv_r_k, l0_rwkv_gn_w, l0_rwkv_gn_b, l0_w_out)),
        (odd_mixer, (l1_w_in, l1_conv_w, l1_conv_b, l1_lru_ga_w, l1_lru_ga_b, l1_lru_gx_w, l1_lru_gx_b,
                     l1_lru_lambda, l1_w_out)),
    )
    commons = (
        (l0_mod_w, l0_mod_b, l0_ln1_g, l0_ln1_b, l0_mlp_w1, l0_mlp_w2, l0_ln2_g, l0_ln2_b),
        (l1_mod_w, l1_mod_b, l1_ln1_g, l1_ln1_b, l1_mlp_w1, l1_mlp_w2, l1_ln2_g, l1_ln2_b),
    )
    xc = ctx
    for layer in range(DEPTH):
        mixer_fn, mixer_params = mixers[layer % 2]
        x, xc = trunk_layer(x, xc, c, c_ctx, mixer_fn, mixer_params, *commons[layer],
                            ctx_out=(layer < DEPTH - 1))
    return x
```

```cpp
#include <hip/hip_runtime.h>
#include <hip/hip_cooperative_groups.h>
#include <cstdint>
#include <cstdio>
#include <cstring>
namespace cg = cooperative_groups;

typedef unsigned short bf16_t;
typedef short bf16x8 __attribute__((ext_vector_type(8)));
typedef float f32x2 __attribute__((ext_vector_type(2)));
typedef float f32x4 __attribute__((ext_vector_type(4)));
typedef float f32x16 __attribute__((ext_vector_type(16)));
typedef unsigned u32x2 __attribute__((ext_vector_type(2)));
typedef unsigned u32x4 __attribute__((ext_vector_type(4)));
#define DI __device__ __forceinline__

constexpr int MT = 18432, TB = 2304, NCX = 256;
constexpr size_t MiB = 1u << 20;
constexpr float ALPHA = 1.41421356237f;
constexpr int SMEM_BYTES = 59392;
#ifndef N_LAUNCH_SPLIT
#define N_LAUNCH_SPLIT 0
#endif

constexpr size_t O_WIN0 = 0;
constexpr size_t O_WUQ = O_WIN0 + (size_t)2816 * 1024 * 2;
constexpr size_t O_WUK = O_WUQ + (size_t)768 * 384 * 2;
constexpr size_t O_WUV = O_WUK + (size_t)512 * 256 * 2;
constexpr size_t O_W2T = O_WUV + (size_t)512 * 256 * 2;
constexpr size_t O_A2T = O_W2T + (size_t)2 * 512 * 64 * 2;
constexpr size_t O_G2T = O_A2T + (size_t)2 * 512 * 64 * 2;
constexpr size_t O_WOUT0 = O_G2T + (size_t)512 * 128 * 2;
constexpr size_t O_W1_0 = O_WOUT0 + (size_t)1024 * 1024 * 2;
constexpr size_t O_W2_0 = O_W1_0 + (size_t)4096 * 1024 * 2;
constexpr size_t O_WIN1 = O_W2_0 + (size_t)4096 * 1024 * 2;
constexpr size_t O_GAT = O_WIN1 + (size_t)2048 * 1024 * 2;
constexpr size_t O_GXT = O_GAT + (size_t)16 * 128 * 128 * 2;
constexpr size_t O_WOUT1 = O_GXT + (size_t)16 * 128 * 128 * 2;
constexpr size_t O_W1_1 = O_WOUT1 + (size_t)1024 * 1024 * 2;
constexpr size_t O_W2_1 = O_W1_1 + (size_t)4096 * 1024 * 2;
constexpr size_t O_MODS = O_W2_1 + (size_t)4096 * 1024 * 2;
constexpr size_t O_ROPE = O_MODS + (size_t)2 * 9 * 6144 * 4;
constexpr size_t O_RSQ = O_ROPE + 4096;
constexpr size_t O_CNT = O_RSQ + (size_t)MT * 2 * 4;
constexpr size_t O_BAR = O_CNT + 256;
constexpr size_t O_STATS = O_BAR + 3456 * 4;
constexpr size_t O_SP = O_STATS + (size_t)MT * 2 * 4;
constexpr size_t O_WEND = O_SP + 2048 * 4;
static_assert(O_WEND <= 52 * MiB, "weight region overflow");
constexpr size_t O_A = 52 * MiB;
constexpr size_t O_X = 88 * MiB;
constexpr size_t O_B = 160 * MiB;
constexpr size_t O_FRW = O_X;
constexpr size_t O_FQ = O_FRW + (size_t)MT * 1920 * 2;
constexpr size_t O_FKV = O_FQ + (size_t)MT * 384 * 2;
constexpr size_t O_Q = O_FKV + (size_t)MT * 256 * 2;
constexpr size_t O_K = O_Q + (size_t)MT * 768 * 2;
constexpr size_t O_FKR = O_K + (size_t)MT * 768 * 2;
constexpr size_t O_BON = O_FKR + (size_t)MT * 32 * 4;
static_assert(O_BON + (size_t)2 * MT * 8 * 4 <= 256 * MiB, "mixer region overflow");
constexpr size_t O_GATE = O_B;
constexpr size_t O_XR = O_B + 36 * MiB;
constexpr size_t O_CARRY = O_B + 72 * MiB;
constexpr size_t O_HIN = O_CARRY + 9 * MiB;
constexpr size_t OO_Y = 0;
constexpr size_t OO_VT = 36 * MiB;

struct CvtJob { const float* src; bf16_t* dst; const float* scale; int K, N, Npad, nbatch, tile0, pad_; };
struct Params {
  const float* in[47];
  float* out; char* ws;
  CvtJob jobs[20];
  int njobs, ncvt, ncvt_early, pad2_;
};

DI int opaque_tid() { int t = threadIdx.x; asm volatile("" : "+v"(t)); return t; }
#define VT (opaque_tid() & 255)
DI unsigned cvtpk(float lo, float hi) { unsigned r; asm("v_cvt_pk_bf16_f32 %0, %1, %2" : "=v"(r) : "v"(lo), "v"(hi)); return r; }
DI float bf2f(bf16_t b) { return __uint_as_float((unsigned)b << 16); }
DI float lo_f(unsigned w) { return __uint_as_float(w << 16); }
DI float hi_f(unsigned w) { return __uint_as_float(w & 0xffff0000u); }
DI u32x2 pack4(f32x4 v) { u32x2 r; r.x = cvtpk(v[0], v[1]); r.y = cvtpk(v[2], v[3]); return r; }
DI float sigmoidf_(float x) { return __builtin_amdgcn_rcpf(1.f + __expf(-x)); }
DI float tanh_fast(float x) { x = fminf(fmaxf(x, -15.f), 15.f); float t = __expf(2.f * x); return (t - 1.f) * __builtin_amdgcn_rcpf(t + 1.f); }
DI float one_minus_exp(float x) { const float ps = -x * (1.f + x * (0.5f + x * (0.16666667f + x * (0.041666668f + x * (0.0083333338f + x * 0.0013888889f))))); return x > -0.35f ? ps : 1.f - __expf(x); }
DI float gelu_tanh(float x) { float u = 0.7978845608f * (x + 0.044715f * x * x * x); return 0.5f * x * (1.f + tanh_fast(u)); }
template <int CTRL> DI float dppf(float v) { return __int_as_float(__builtin_amdgcn_update_dpp(0, __float_as_int(v), CTRL, 0xF, 0xF, true)); }
DI float red8(float v) { v += dppf<0xB1>(v); v += dppf<0x4E>(v); v += dppf<0x141>(v); return v; }
DI float red16(float v) { v = red8(v); v += dppf<0x140>(v); return v; }
DI f32x4 mfma16(bf16x8 a, bf16x8 b, f32x4 c) { return __builtin_amdgcn_mfma_f32_16x16x32_bf16(a, b, c, 0, 0, 0); }
DI f32x16 mfma32(bf16x8 a, bf16x8 b, f32x16 c) { return __builtin_amdgcn_mfma_f32_32x32x16_bf16(a, b, c, 0, 0, 0); }
DI const float* xrow_in(const Params& p, int row) {
  const int b = row / TB, j = row - b * TB;
  return j < NCX ? p.in[2] + (size_t)(b * NCX + j) * 1024 : p.in[0] + (size_t)(b * 2048 + j - NCX) * 1024;
}
DI int modrow_of(int row) { const int b = row / TB, j = row - b * TB; return j < NCX ? 8 : b; }

DI void p0_misc(const Params& p) {
  const int tid = VT;
  float* rsq = (float*)(p.ws + O_RSQ);
  for (int i = tid; i < MT * 2; i += 256) rsq[i] = 0.f;
  unsigned* cnt = (unsigned*)(p.ws + O_CNT);
  if (tid < 64) cnt[tid] = 0u;
  { float* spt = (float*)(p.ws + O_SP); for (int i = tid; i < 2048; i += 256) spt[i] = 8.f * log1pf(__expf(-p.in[39][i])); }
  float* rope = (float*)(p.ws + O_ROPE);
  for (int i = tid; i < 512; i += 256) {
    const int pos = i >> 3, f = i & 7;
    const float inv = powf(10000.f, -(float)(2 * f) / 16.f);
    const float ang = (float)pos * inv;
    rope[i * 2] = cosf(ang); rope[i * 2 + 1] = sinf(ang);
  }
}
DI void p0_zero_y(const Params& p, int u) {
  f32x4* y = (f32x4*)((char*)p.out + OO_Y) + (size_t)u * 4096;
  const f32x4 z = {0.f, 0.f, 0.f, 0.f};
  for (int i = VT; i < 4096; i += 256) y[i] = z;
}
DI void p0_mods(const Params& p, int u, char* smem) {
  const int tid = VT, layer = u / 192, n0 = (u % 192) * 32;
  float* sl = (float*)smem;
  float* red = sl + 9216;
  const float* c = p.in[1]; const float* cc = p.in[3];
  __syncthreads();
  for (int i = tid; i < 9216; i += 256) { const float v = i < 8192 ? c[i] : cc[i - 8192]; sl[i] = v / (1.f + __expf(-v)); }
  __syncthreads();
  const float* W = p.in[layer ? 30 : 4]; const float* bias = p.in[layer ? 31 : 5];
  const int kg = tid >> 5, cn = tid & 31;
  float acc[9];
#pragma unroll
  for (int r = 0; r < 9; ++r) acc[r] = 0.f;
  const float* wp = W + (size_t)(kg * 128) * 6144 + n0 + cn;
#pragma unroll 1
  for (int k0 = 0; k0 < 128; k0 += 16) {
    float w[16];
#pragma unroll
    for (int q = 0; q < 16; ++q) w[q] = wp[(size_t)(k0 + q) * 6144];
#pragma unroll
    for (int q = 0; q < 16; ++q) {
#pragma unroll
      for (int r = 0; r < 9; ++r) acc[r] += sl[r * 1024 + kg * 128 + k0 + q] * w[q];
    }
  }
#pragma unroll
  for (int r = 0; r < 9; ++r) red[(kg * 9 + r) * 32 + cn] = acc[r];
  __syncthreads();
  float* mods = (float*)(p.ws + O_MODS) + (size_t)layer * 9 * 6144;
  for (int i = tid; i < 288; i += 256) {
    const int r = i >> 5, n = i & 31;
    float sacc = bias[n0 + n];
#pragma unroll
    for (int g = 0; g < 8; ++g) sacc += red[(g * 9 + r) * 32 + n];
    mods[r * 6144 + n0 + n] = sacc;
  }
}
DI void p0_cvt(const Params& p, int t, char* smem) {
  int ji = 0;
  for (int q = 1; q < p.njobs; ++q) if (t >= p.jobs[q].tile0) ji = q;
  const CvtJob& J = p.jobs[ji];
  int lt = t - J.tile0;
  const int tk = J.K >> 6, tn = J.Npad >> 6;
  const int bi = lt / (tk * tn); lt -= bi * tk * tn;
  const int k0 = (lt / tn) * 64, n0 = (lt % tn) * 64;
  const float* src = J.src + (size_t)bi * J.K * J.N;
  bf16_t* dst = J.dst + (size_t)bi * J.Npad * J.K;
  float* tile = (float*)smem;
  const int tid = VT, a = tid >> 6, l = tid & 63;
  __syncthreads();
#pragma unroll 4
  for (int i = 0; i < 16; ++i) {
    const int kk = i * 4 + a, n = n0 + l;
    float v = 0.f;
    if (n < J.N) { v = src[(size_t)(k0 + kk) * J.N + n]; if (J.scale) v *= J.scale[k0 + kk]; }
    tile[kk * 65 + l] = v;
  }
  __syncthreads();
#pragma unroll 4
  for (int i = 0; i < 16; ++i) {
    const int nn = i * 4 + a;
    dst[(size_t)(n0 + nn) * J.K + k0 + l] = (bf16_t)(cvtpk(tile[l * 65 + nn], 0.f) & 0xffffu);
  }
}
DI void phase0(const Params& p, char* smem, int bid, int nb) {
  const int ncp = (p.ncvt_early + 1) & ~1;
  const int total = 384 + ncp + 2;
  for (int t = bid; t < total; t += nb) {
    if (t < 384) p0_mods(p, t, smem);
    else if (t - 384 < ncp) { if (t - 384 < p.ncvt_early) p0_cvt(p, t - 384, smem); else { __syncthreads(); __syncthreads(); } }
    else { const int z = t - 384 - ncp; if (z == 0) p0_misc(p); }
  }
}

DI void phase_prep_a0(const Params& p, int bid, int nb) {
  const float* mods = (const float*)(p.ws + O_MODS);
  bf16_t* H = (bf16_t*)(p.ws + O_A);
  const int stride = nb * 256;
  for (int i0 = bid * 256 + VT; i0 < MT * 128; i0 += 3 * stride) {
    f32x4 x0[3], x1[3], sh0[3], sh1[3], sc0[3], sc1[3];
#pragma unroll
    for (int q = 0; q < 3; ++q) {
      const int i = i0 + q * stride;
      if (i < MT * 128) {
        const int row = i >> 7, c = (i & 127) * 8;
        const float* src = xrow_in(p, row) + c;
        const float* mp = mods + modrow_of(row) * 6144 + c;
        x0[q] = *(const f32x4*)src; x1[q] = *(const f32x4*)(src + 4);
        sh0[q] = *(const f32x4*)mp; sh1[q] = *(const f32x4*)(mp + 4);
        sc0[q] = *(const f32x4*)(mp + 1024); sc1[q] = *(const f32x4*)(mp + 1028);
      }
    }
#pragma unroll
    for (int q = 0; q < 3; ++q) {
      const int i = i0 + q * stride;
      if (i < MT * 128) {
        const int row = i >> 7, c = (i & 127) * 8;
        const f32x4 y0 = x0[q] * (1.f + sc0[q]) + sh0[q], y1 = x1[q] * (1.f + sc1[q]) + sh1[q];
        u32x4 w; w.x = cvtpk(y0[0], y0[1]); w.y = cvtpk(y0[2], y0[3]); w.z = cvtpk(y1[0], y1[1]); w.w = cvtpk(y1[2], y1[3]);
        *(u32x4*)(H + (size_t)row * 1024 + c) = w;
      }
    }
  }
}

namespace g8 {
constexpr int BM = 256, BK = 64, HALF = 128, HT = HALF * BK, NXCD = 8, WGM = 8;
DI int lds_byte(int r, int c) { const int st = (r >> 4) * 2 + (c >> 5), rr = r & 15, cc = c & 31, ob = rr * 64 + cc * 2; return st * 1024 + (ob ^ (((ob >> 9) & 1) << 5)); }
DI void stage_rc(int b, int& R, int& C) { const int st = b / 1024, sb = b % 1024, swz = sb ^ (((sb >> 9) & 1) << 5); R = (st >> 1) * 16 + swz / 64; C = (st & 1) * 32 + (swz % 64) / 2; }
}
typedef __attribute__((address_space(3))) unsigned char lds_u8;
template <class Epi>
DI void gemm8_phase(const bf16_t* __restrict__ A, int lda, const bf16_t* __restrict__ Bt, int ldb, int K,
                    int nM, int nN, int mode, int base, const Epi& epi, char* dsm, int bid, int nb, int ksplit = 1) {
  using namespace g8;
  constexpr int HTB = HALF * BK * 2;
  lds_u8* lds = (lds_u8*)dsm;
  const int tid = opaque_tid(), wid = __builtin_amdgcn_readfirstlane(tid >> 6), lane = tid & 63, wr = wid >> 2, wc = wid & 3, fr = lane & 15, fq = lane >> 4;
  unsigned voffA[2], voffB[2];
#pragma unroll
  for (int i = 0; i < 2; ++i) { int R, C; stage_rc(tid * 16 + i * 8192, R, C); voffA[i] = (unsigned)(R * lda + C) * 2u; voffB[i] = (unsigned)(R * ldb + C) * 2u; }
  const size_t hstepA = (size_t)HALF * lda * 2, hstepB = (size_t)HALF * ldb * 2;
  const unsigned ldsw = (unsigned)wid * 1024u;
  const int aoff = lds_byte(wr * 64 + fr, fq * 8), boff = lds_byte(wc * 32 + fr, fq * 8);
  #define SA(b,h) (((b)*2+(h))*HTB)
  #define SB(b,h) ((4+(b)*2+(h))*HTB)
  #define STAGE(bufoff,gbase,voff) do{ _Pragma("unroll") for(int _i=0;_i<2;++_i) \
    __builtin_amdgcn_global_load_lds((const unsigned*)((const char*)(gbase)+(voff)[_i]),(__attribute__((address_space(3))) unsigned*)(lds+(bufoff)+ldsw+_i*8192),16,0,0);}while(0)
  #define LDA(dst,b,h) do{ _Pragma("unroll") for(int m=0;m<4;++m) _Pragma("unroll") for(int k=0;k<2;++k) dst[m][k]=*(const __attribute__((address_space(3))) bf16x8*)(lds+SA(b,h)+aoff+m*2048+k*1024);}while(0)
  #define LDB(dst,b,h) do{ _Pragma("unroll") for(int n=0;n<2;++n) _Pragma("unroll") for(int k=0;k<2;++k) dst[n][k]=*(const __attribute__((address_space(3))) bf16x8*)(lds+SB(b,h)+boff+n*2048+k*1024);}while(0)
  #define MMA(ai,bj,At_,Bt_) do{__builtin_amdgcn_s_setprio(1); _Pragma("unroll") for(int m=0;m<4;++m) _Pragma("unroll") for(int n=0;n<2;++n) _Pragma("unroll") for(int k=0;k<2;++k) \
      acc[ai][bj][m][n]=__builtin_amdgcn_mfma_f32_16x16x32_bf16(Bt_[n][k],At_[m][k],acc[ai][bj][m][n],0,0,0); \
    __builtin_amdgcn_s_setprio(0);}while(0)
  #define WAIT_V(n) asm volatile("s_waitcnt vmcnt(" #n ")":::"memory")
  #define WAIT_L(n) asm volatile("s_waitcnt lgkmcnt(" #n ")":::"memory")
  #define BAR __builtin_amdgcn_s_barrier()
  #define SCHED __builtin_amdgcn_sched_barrier(0)
  const int nwt = nM * nN, nwg = nwt * ksplit, nt = K / BK;
  for (int L = bid; L < nwg; L += nb) {
    const int ks = L % ksplit;
    int wgid = L / ksplit;
    { const int q = nwt / NXCD, r = nwt % NXCD, xcd = wgid % NXCD, off = wgid / NXCD; wgid = (xcd < r ? xcd * (q + 1) : r * (q + 1) + (xcd - r) * q) + off; }
    const int nig = WGM * nN, gid = wgid / nig, fm = gid * WGM, gsz = min(nM - fm, WGM);
    const int pm = fm + ((wgid % nig) % gsz), pn = (wgid % nig) / gsz;
    const int brow = mode == 1 ? ((((base + pm) >> 3) * 9 + 1 + ((base + pm) & 7)) * 256) : (mode == 2 ? pm * TB : base + pm * 256);
    const int bcol = pn * BM;
    f32x4 acc[2][2][4][2];
#pragma unroll
    for (int a_ = 0; a_ < 2; ++a_)
#pragma unroll
      for (int b_ = 0; b_ < 2; ++b_)
#pragma unroll
        for (int m = 0; m < 4; ++m)
#pragma unroll
          for (int n = 0; n < 2; ++n) acc[a_][b_][m][n] = (f32x4){0.f, 0.f, 0.f, 0.f};
    bf16x8 At[4][2], B0[2][2], B1[2][2];
    const char* cA = (const char*)(A + (size_t)brow * lda + (size_t)ks * K); const char* cB = (const char*)(Bt + (size_t)bcol * ldb + (size_t)ks * K);
    STAGE(SB(0,0),cB,voffB); STAGE(SA(0,0),cA,voffA); STAGE(SB(0,1),cB+hstepB,voffB); STAGE(SA(0,1),cA+hstepA,voffA);
    if(wr==1)BAR;
    WAIT_V(4); BAR;
    STAGE(SB(1,0),cB+128,voffB); STAGE(SA(1,0),cA+128,voffA); STAGE(SB(1,1),cB+hstepB+128,voffB);
    WAIT_V(6); BAR;
    for(int t=0;t<nt-2;t+=2){
      const char* a1 = cA + (size_t)(t+1)*128; const char* a2 = cA + (size_t)(t+2)*128; const char* a3 = cA + (size_t)(t+3)*128;
      const char* b2 = cB + (size_t)(t+2)*128; const char* b3 = cB + (size_t)(t+3)*128;
      LDB(B0,0,0); SCHED; LDA(At,0,0); STAGE(SA(1,1),a1+hstepA,voffA);
      WAIT_L(8); BAR; WAIT_L(0); MMA(0,0,At,B0); BAR; SCHED;
      LDB(B1,0,1); STAGE(SB(0,0),b2,voffB);
      BAR; WAIT_L(0); MMA(0,1,At,B1); BAR;
      LDA(At,0,1); STAGE(SA(0,0),a2,voffA);
      BAR; WAIT_L(0); MMA(1,0,At,B0); BAR; SCHED;
      STAGE(SB(0,1),b2+hstepB,voffB);
      WAIT_V(6); BAR; MMA(1,1,At,B1); BAR;
      LDB(B0,1,0); SCHED; LDA(At,1,0); STAGE(SA(0,1),a2+hstepA,voffA);
      WAIT_L(8); BAR; WAIT_L(0); MMA(0,0,At,B0); BAR; SCHED;
      LDB(B1,1,1); STAGE(SB(1,0),b3,voffB);
      BAR; WAIT_L(0); MMA(0,1,At,B1); BAR;
      LDA(At,1,1); STAGE(SA(1,0),a3,voffA);
      BAR; WAIT_L(0); MMA(1,0,At,B0); BAR; SCHED;
      STAGE(SB(1,1),b3+hstepB,voffB);
      WAIT_V(6); BAR; MMA(1,1,At,B1); BAR;
    }
    { LDB(B0,0,0); LDA(At,0,0); STAGE(SA(1,1),cA+(size_t)(nt-1)*128+hstepA,voffA);
      BAR; WAIT_L(0); MMA(0,0,At,B0); BAR;
      LDB(B1,0,1); BAR; WAIT_L(0); MMA(0,1,At,B1); BAR;
      LDA(At,0,1); WAIT_V(4); BAR; WAIT_L(0); MMA(1,0,At,B0); MMA(1,1,At,B1); BAR; }
    { LDB(B0,1,0); LDA(At,1,0); WAIT_V(2); BAR; WAIT_L(0); MMA(0,0,At,B0); BAR;
      LDB(B1,1,1); WAIT_V(0); BAR; WAIT_L(0); MMA(0,1,At,B1); BAR;
      LDA(At,1,1); BAR; WAIT_L(0); MMA(1,0,At,B0); MMA(1,1,At,B1); BAR; }
    if(wr==0)BAR;
#pragma unroll
    for (int ai = 0; ai < 2; ++ai)
#pragma unroll
      for (int bj = 0; bj < 2; ++bj) epi(acc[ai][bj], brow + ai * HALF + wr * 64, bcol + bj * HALF + wc * 32 + ks * 1024, fr, fq);
    epi.post(brow, pn);
  }
  #undef SA
  #undef SB
  #undef STAGE
  #undef LDA
  #undef LDB
  #undef MMA
  #undef WAIT_V
  #undef WAIT_L
  #undef BAR
  #undef SCHED
}

struct EpiWin0 {
  bf16_t* FQ; bf16_t* FKV; float* FKR; bf16_t* FRW; float* RSQ;
  template <int NN> DI void operator()(f32x4 (&acc)[4][NN], int rb, int cb, int fr, int fq) const {
    if (cb < 640) {
      const bool isq = cb < 384; bf16_t* dst = isq ? FQ : FKV; const int ld = isq ? 384 : 256; const int co = isq ? cb : cb - 384;
#pragma unroll
      for (int m = 0; m < 4; ++m) {
        const int row = rb + m * 16 + fr; float s = 0.f;
#pragma unroll
        for (int n = 0; n < NN; ++n) {
          const f32x4 v = acc[m][n]; s += v[0] * v[0] + v[1] * v[1] + v[2] * v[2] + v[3] * v[3];
          *(u32x2*)(dst + (size_t)row * ld + co + n * 16 + fq * 4) = pack4(v);
        }
        s += __shfl_xor(s, 16); s += __shfl_xor(s, 32);
        if (fq == 0) atomicAdd(&RSQ[row * 2 + (isq ? 0 : 1)], s);
      }
    } else {
#pragma unroll
      for (int m = 0; m < 4; ++m) {
        const int row = rb + m * 16 + fr;
#pragma unroll
        for (int n = 0; n < NN; ++n) {
          const int cs = cb + n * 16, c = cs + fq * 4;
          if (cs < 672) *(f32x4*)(FKR + (size_t)row * 32 + (c - 640)) = acc[m][n];
          else if (cs < 2592) *(u32x2*)(FRW + (size_t)row * 1920 + (c - 672)) = pack4(acc[m][n]);
        }
      }
    }
  }
  DI void post(int, int) const {}
};
struct EpiQ {
  bf16_t* Q; const float* RSQ; const float* ROPE;
  template <int NN> DI void operator()(f32x4 (&acc)[4][NN], int rb, int cb, int fr, int fq) const {
#pragma unroll
    for (int m = 0; m < 4; ++m) {
      const int row = rb + m * 16 + fr;
      const float rs = rsqrtf(RSQ[row * 2] * (1.f / 384.f) + 1e-6f);
      const int b = row / TB, j = row - b * TB; const bool latent = j >= NCX; const int nl = j - NCX;
#pragma unroll
      for (int n = 0; n < NN; ++n) {
        const int cs = cb + n * 16, within = cs % 96;
        f32x4 v = acc[m][n] * rs;
        if (within >= 64) {
          f32x4 pr;
#pragma unroll
          for (int e = 0; e < 4; ++e) pr[e] = __shfl_xor(v[e], 32);
          if (latent) {
            const int axis = (within - 64) >> 4; const int pos = axis ? (nl & 63) : (nl >> 6);
            const float* tb = ROPE + (pos * 8 + (fq & 1) * 4) * 2;
#pragma unroll
            for (int e = 0; e < 4; ++e) { const float c = tb[e * 2], s = tb[e * 2 + 1]; v[e] = (fq & 2) ? v[e] * c + pr[e] * s : v[e] * c - pr[e] * s; }
          }
        }
        *(u32x2*)(Q + (size_t)row * 768 + cs + fq * 4) = pack4(v);
      }
    }
  }
  DI void post(int, int) const {}
};
struct EpiKn {
  bf16_t* Kb; const float* RSQ; const float* FKR; const float* ROPE;
  template <int NN> DI void operator()(f32x4 (&acc)[4][NN], int rb, int cb, int fr, int fq) const {
#pragma unroll
    for (int m = 0; m < 4; ++m) {
      const int row = rb + m * 16 + fr;
      const float rs = rsqrtf(RSQ[row * 2 + 1] * (1.f / 256.f) + 1e-6f);
#pragma unroll
      for (int n = 0; n < NN; ++n) {
        const int cs = cb + n * 16, hh = cs >> 6, off = (cs & 63) + fq * 4;
        *(u32x2*)(Kb + (size_t)row * 768 + hh * 96 + off) = pack4(acc[m][n] * rs);
      }
    }
  }
  DI void post(int row0, int nt) const {
    if (nt != 0) return;
    const int tid = threadIdx.x, row = row0 + (tid >> 1), axis = tid & 1;
    const int b = row / TB, j = row - b * TB; const bool latent = j >= NCX; const int nl = j - NCX;
    const float* src = FKR + (size_t)row * 32 + axis * 16;
    float x[16];
#pragma unroll
    for (int e = 0; e < 4; ++e) { const f32x4 v = *(const f32x4*)(src + e * 4); x[e * 4] = v[0]; x[e * 4 + 1] = v[1]; x[e * 4 + 2] = v[2]; x[e * 4 + 3] = v[3]; }
    if (latent) {
      const int pos = axis ? (nl & 63) : (nl >> 6);
      const float* tb = ROPE + pos * 16;
#pragma unroll
      for (int f = 0; f < 8; ++f) { const float c = tb[f * 2], s = tb[f * 2 + 1], x1 = x[f], x2 = x[8 + f]; x[f] = x1 * c - x2 * s; x[8 + f] = x2 * c + x1 * s; }
    }
    u32x4 w0, w1;
    w0.x = cvtpk(x[0], x[1]); w0.y = cvtpk(x[2], x[3]); w0.z = cvtpk(x[4], x[5]); w0.w = cvtpk(x[6], x[7]);
    w1.x = cvtpk(x[8], x[9]); w1.y = cvtpk(x[10], x[11]); w1.z = cvtpk(x[12], x[13]); w1.w = cvtpk(x[14], x[15]);
#pragma unroll
    for (int hh = 0; hh < 8; ++hh) { bf16_t* d = Kb + (size_t)row * 768 + hh * 96 + 64 + axis * 16; *(u32x4*)d = w0; *(u32x4*)(d + 8) = w1; }
  }
};
struct EpiVt {
  bf16_t* VTP; const float* RSQ;
  template <int NN> DI void operator()(f32x4 (&acc)[4][NN], int rb, int cb, int fr, int fq) const {
#pragma unroll
    for (int n = 0; n < NN; ++n) {
      const int c = cb + n * 16 + fq * 4;
      f32x4 rs;
#pragma unroll
      for (int e = 0; e < 4; ++e) rs[e] = rsqrtf(RSQ[(c + e) * 2 + 1] * (1.f / 256.f) + 1e-6f);
#pragma unroll
      for (int m = 0; m < 4; ++m) { const int row = rb + m * 16 + fr; *(u32x2*)(VTP + (size_t)row * MT + c) = pack4(acc[m][n] * rs); }
    }
  }
  DI void post(int, int) const {}
};
struct EpiRes {
  const float* xin; const float* cin; float* XA; const float* mods; int goff; int from_input; float alpha;
  const float* stats; const float* lng; const float* lnb;
  template <int NN> DI void operator()(f32x4 (&acc)[4][NN], int rb, int cb, int fr, int fq) const {
#pragma unroll
    for (int m = 0; m < 4; ++m) {
      const int row = rb + m * 16 + fr;
      const float* gp = mods + modrow_of(row) * 6144 + goff;
      const int b_ = row / TB, j_ = row - b_ * TB;
      const float* src = from_input ? (j_ < NCX ? cin + (size_t)(b_ * NCX + j_) * 1024 : xin + (size_t)(b_ * 2048 + j_ - NCX) * 1024) : XA + (size_t)row * 1024;
      float mean = 0.f, rstd = 1.f;
      if (stats) { const f32x2 st = *(const f32x2*)(stats + (size_t)row * 2); mean = st[0]; rstd = st[1]; }
#pragma unroll
      for (int n = 0; n < NN; ++n) {
        const int c = cb + n * 16 + fq * 4;
        f32x4 xv = *(const f32x4*)(src + c); const f32x4 gv = *(const f32x4*)(gp + c);
        if (stats) xv = (xv - mean) * rstd * *(const f32x4*)(lng + c) + *(const f32x4*)(lnb + c);
        *(f32x4*)(XA + (size_t)row * 1024 + c) = alpha * xv + gv * acc[m][n];
      }
    }
  }
  DI void post(int, int) const {}
};
struct EpiPartial {
  float* P; int slot0; int compact;
  template <int NN> DI void operator()(f32x4 (&acc)[4][NN], int rb, int cb, int fr, int fq) const {
    const int ks = cb >> 10, c0 = cb & 1023;
#pragma unroll
    for (int m = 0; m < 4; ++m) {
      const int row = rb + m * 16 + fr, b_ = row / TB, cr = compact ? row : b_ * NCX + (row - b_ * TB);
      float* dst = P + ((size_t)(slot0 + ks) * 2048 + cr) * 1024 + c0 + fq * 4;
#pragma unroll
      for (int n = 0; n < NN; ++n) *(f32x4*)(dst + n * 16) = acc[m][n];
    }
  }
  DI void post(int, int) const {}
};
struct EpiMlp1 {
  bf16_t* H1;
  template <int NN> DI void operator()(f32x4 (&acc)[4][NN], int rb, int cb, int fr, int fq) const {
#pragma unroll
    for (int m = 0; m < 4; ++m) {
      const int row = rb + m * 16 + fr;
#pragma unroll
      for (int n = 0; n < NN; ++n) {
        f32x4 v = acc[m][n];
#pragma unroll
        for (int e = 0; e < 4; ++e) { const float r = fmaxf(v[e], 0.f); v[e] = r * r; }
        *(u32x2*)(H1 + (size_t)row * 2048 + cb + n * 16 + fq * 4) = pack4(v);
      }
    }
  }
  DI void post(int, int) const {}
};
struct EpiMlp1Ctx {
  bf16_t* H1c;
  template <int NN> DI void operator()(f32x4 (&acc)[4][NN], int rb, int cb, int fr, int fq) const {
#pragma unroll
    for (int m = 0; m < 4; ++m) {
      const int row = rb + m * 16 + fr, b_ = row / TB, cr = b_ * NCX + (row - b_ * TB);
#pragma unroll
      for (int n = 0; n < NN; ++n) {
        f32x4 v = acc[m][n];
#pragma unroll
        for (int e = 0; e < 4; ++e) { const float r = fmaxf(v[e], 0.f); v[e] = r * r; }
        *(u32x2*)(H1c + (size_t)cr * 4096 + cb + n * 16 + fq * 4) = pack4(v);
      }
    }
  }
  DI void post(int, int) const {}
};
struct EpiWin1 {
  bf16_t* GATE; bf16_t* XR;
  template <int NN> DI void operator()(f32x4 (&acc)[4][NN], int rb, int cb, int fr, int fq) const {
#pragma unroll
    for (int m = 0; m < 4; ++m) {
      const int row = rb + m * 16 + fr;
#pragma unroll
      for (int n = 0; n < NN; ++n) {
        const int c = cb + n * 16 + fq * 4;
        f32x4 v = acc[m][n];
        if (cb < 1024) {
#pragma unroll
          for (int e = 0; e < 4; ++e) v[e] = gelu_tanh(v[e]);
          *(u32x2*)(GATE + (size_t)row * 1024 + c) = pack4(v);
        } else *(u32x2*)(XR + (size_t)row * 1024 + c - 1024) = pack4(v);
      }
    }
  }
  DI void post(int, int) const {}
};

DI void attn_unit(const Params& p, int u, char* smem) {
  const int tid = VT, lane = tid & 63, wid = tid >> 6, r32 = lane & 31, hi = lane >> 5;
  int b, h, qrow0, nkeys;
  if (u < 1024) { b = u >> 7; h = (u >> 4) & 7; qrow0 = b * TB + NCX + (u & 15) * 128; nkeys = TB; }
  else { const int v = u - 1024; b = v >> 4; h = (v >> 1) & 7; qrow0 = b * TB + (v & 1) * 128; nkeys = NCX; }
  const int key0 = b * TB;
  const bf16_t* Q = (const bf16_t*)(p.ws + O_Q); const bf16_t* Kb = (const bf16_t*)(p.ws + O_K);
  const bf16_t* VTP = (const bf16_t*)((const char*)p.out + OO_VT);
  bf16_t* CAT = (bf16_t*)(p.ws + O_A);
  char* sK = smem; char* sV = smem + 64 * 208;
  const int qrow = qrow0 + wid * 32 + r32;
  bf16x8 qf[6];
  {
    const bf16_t* qp = Q + (size_t)qrow * 768 + h * 96 + hi * 8;
#pragma unroll
    for (int d0 = 0; d0 < 6; ++d0) qf[d0] = *(const bf16x8*)(qp + d0 * 16);
  }
  f32x16 o0, o1;
#pragma unroll
  for (int r = 0; r < 16; ++r) { o0[r] = 0.f; o1[r] = 0.f; }
  float mrun = -1e30f, lrun = 0.f;
  constexpr float C = 0.10206207261596575f * 1.4426950408889634f;
  const bf16_t* gk[3]; int lk[3];
#pragma unroll
  for (int i = 0; i < 3; ++i) { const int c = tid + i * 256, kr = c / 12, kc = c - kr * 12; gk[i] = Kb + (size_t)(key0 + kr) * 768 + h * 96 + kc * 8; lk[i] = kr * 208 + kc * 16; }
  const bf16_t* gv[2]; int lv[2];
#pragma unroll
  for (int i = 0; i < 2; ++i) { const int c = tid + i * 256, vr = c >> 3, vc = c & 7; gv[i] = VTP + (size_t)(h * 64 + vr) * MT + key0 + vc * 8; lv[i] = vr * 144 + vc * 16; }
  u32x4 rk[3], rv[2];
#pragma unroll
  for (int i = 0; i < 3; ++i) rk[i] = *(const u32x4*)(gk[i]);
#pragma unroll
  for (int i = 0; i < 2; ++i) rv[i] = *(const u32x4*)(gv[i]);
  for (int k0 = 0; k0 < nkeys; k0 += 64) {
    __syncthreads();
#pragma unroll
    for (int i = 0; i < 3; ++i) *(u32x4*)(sK + lk[i]) = rk[i];
#pragma unroll
    for (int i = 0; i < 2; ++i) *(u32x4*)(sV + lv[i]) = rv[i];
    __syncthreads();
    if (k0 + 64 < nkeys) {
#pragma unroll
      for (int i = 0; i < 3; ++i) rk[i] = *(const u32x4*)(gk[i] + (size_t)(k0 + 64) * 768);
#pragma unroll
      for (int i = 0; i < 2; ++i) rv[i] = *(const u32x4*)(gv[i] + k0 + 64);
    }
    f32x16 p0, p1;
#pragma unroll
    for (int r = 0; r < 16; ++r) { p0[r] = 0.f; p1[r] = 0.f; }
#pragma unroll
    for (int d0 = 0; d0 < 6; ++d0) {
      const bf16x8 k0f = *(const bf16x8*)(sK + r32 * 208 + d0 * 32 + hi * 16);
      const bf16x8 k1f = *(const bf16x8*)(sK + (32 + r32) * 208 + d0 * 32 + hi * 16);
      p0 = mfma32(k0f, qf[d0], p0); p1 = mfma32(k1f, qf[d0], p1);
    }
    float tmax = p0[0];
#pragma unroll
    for (int r = 1; r < 16; ++r) tmax = fmaxf(tmax, p0[r]);
#pragma unroll
    for (int r = 0; r < 16; ++r) tmax = fmaxf(tmax, p1[r]);
    tmax = fmaxf(tmax, __shfl_xor(tmax, 32));
    const float mn = fmaxf(mrun, tmax);
    const float alpha = exp2f((mrun - mn) * C);
    mrun = mn;
    const float mc = -mn * C;
    float ps = 0.f;
#pragma unroll
    for (int r = 0; r < 16; ++r) { p0[r] = exp2f(fmaf(p0[r], C, mc)); ps += p0[r]; }
#pragma unroll
    for (int r = 0; r < 16; ++r) { p1[r] = exp2f(fmaf(p1[r], C, mc)); ps += p1[r]; }
    ps += __shfl_xor(ps, 32);
    lrun = lrun * alpha + ps;
#pragma unroll
    for (int r = 0; r < 16; ++r) { o0[r] *= alpha; o1[r] *= alpha; }
#pragma unroll
    for (int ks = 0; ks < 4; ++ks) {
      u32x4 pw;
      if (ks == 0) { pw.x = cvtpk(p0[0], p0[1]); pw.y = cvtpk(p0[2], p0[3]); pw.z = cvtpk(p0[4], p0[5]); pw.w = cvtpk(p0[6], p0[7]); }
      else if (ks == 1) { pw.x = cvtpk(p0[8], p0[9]); pw.y = cvtpk(p0[10], p0[11]); pw.z = cvtpk(p0[12], p0[13]); pw.w = cvtpk(p0[14], p0[15]); }
      else if (ks == 2) { pw.x = cvtpk(p1[0], p1[1]); pw.y = cvtpk(p1[2], p1[3]); pw.z = cvtpk(p1[4], p1[5]); pw.w = cvtpk(p1[6], p1[7]); }
      else { pw.x = cvtpk(p1[8], p1[9]); pw.y = cvtpk(p1[10], p1[11]); pw.z = cvtpk(p1[12], p1[13]); pw.w = cvtpk(p1[14], p1[15]); }
      const bf16x8 pf = *(const bf16x8*)&pw;
      const int kb = ks * 16 + hi * 4;
      u32x4 va, vb;
      { const u32x2 a0 = *(const u32x2*)(sV + r32 * 144 + kb * 2), a1 = *(const u32x2*)(sV + r32 * 144 + (kb + 8) * 2); va.x = a0.x; va.y = a0.y; va.z = a1.x; va.w = a1.y; }
      { const u32x2 a0 = *(const u32x2*)(sV + (32 + r32) * 144 + kb * 2), a1 = *(const u32x2*)(sV + (32 + r32) * 144 + (kb + 8) * 2); vb.x = a0.x; vb.y = a0.y; vb.z = a1.x; vb.w = a1.y; }
      o0 = mfma32(*(const bf16x8*)&va, pf, o0);
      o1 = mfma32(*(const bf16x8*)&vb, pf, o1);
    }
  }
  const float inv = 1.f / lrun;
  bf16_t* op = CAT + (size_t)qrow * 1024 + h * 64 + hi * 4;
#pragma unroll
  for (int g = 0; g < 4; ++g) {
    u32x2 w; w.x = cvtpk(o0[g * 4] * inv, o0[g * 4 + 1] * inv); w.y = cvtpk(o0[g * 4 + 2] * inv, o0[g * 4 + 3] * inv);
    *(u32x2*)(op + g * 8) = w;
    w.x = cvtpk(o1[g * 4] * inv, o1[g * 4 + 1] * inv); w.y = cvtpk(o1[g * 4 + 2] * inv, o1[g * 4 + 3] * inv);
    *(u32x2*)(op + 32 + g * 8) = w;
  }
}

DI void unpack8(u32x4 w, float* f) {
  f[0] = lo_f(w.x); f[1] = hi_f(w.x); f[2] = lo_f(w.y); f[3] = hi_f(w.y); f[4] = lo_f(w.z); f[5] = hi_f(w.z); f[6] = lo_f(w.w); f[7] = hi_f(w.w);
}
DI int scan_row(int d, int gi) { return d == 0 ? gi : (gi < NCX ? NCX - 1 - gi : TB - 1 - (gi - NCX)); }
DI void scan_unit(const Params& p, int u, char* smem) {
  const int tid = VT, lane = tid & 63, wid = tid >> 6, fr = lane & 15, fq = lane >> 4;
  const int half = u & 1, d = (u >> 1) & 1, h = (u >> 2) & 7, b = u >> 5;
  float* R_ = (float*)smem; float* KD_ = R_ + 2048; float* KK_ = KD_ + 2048; float* WD_ = KK_ + 2048; float* BV_ = WD_ + 2048;
  float* V_ = BV_ + 2048; float* YO_ = V_ + 1024; char* TW_ = (char*)(YO_ + 1024); char* AL_ = TW_ + 32 * 144;
  float* NRM_ = (float*)(AL_ + 32 * 144); float* BONS_ = NRM_ + 32;
  const bf16_t* FRW = (const bf16_t*)(p.ws + O_FRW);
  const float* mu = p.in[12];
  float* Y = (float*)((char*)p.out + OO_Y);
  float* BON = (float*)(p.ws + O_BON);
  const int hc = h * 64 + wid * 16 + fr;
  bf16x8 w2f0, w2f1, a2f0, a2f1;
  {
    const bf16_t* w2t = (const bf16_t*)(p.ws + O_W2T) + (size_t)(d * 512 + hc) * 64 + fq * 8;
    const bf16_t* a2t = (const bf16_t*)(p.ws + O_A2T) + (size_t)(d * 512 + hc) * 64 + fq * 8;
    w2f0 = *(const bf16x8*)w2t; w2f1 = *(const bf16x8*)(w2t + 32);
    a2f0 = *(const bf16x8*)a2t; a2f1 = *(const bf16x8*)(a2t + 32);
  }
  const float w0c = p.in[13][d * 512 + hc], a0c = p.in[15][d * 512 + hc], kkc = p.in[18][hc], kac = p.in[19][hc], rkc = p.in[20][hc];
  const int il = tid >> 3, js = tid & 7;
  f32x2 S0 = {0.f, 0.f}, S1 = {0.f, 0.f}, S2 = {0.f, 0.f}, S3 = {0.f, 0.f};
  if (tid < 32) { NRM_[tid] = 0.f; BONS_[tid] = 0.f; }
  __syncthreads();
  for (int ci = 0; ci < 72; ++ci) {
    for (int it = tid; it < 1152; it += 256) {
      const int s = it / 36, g = it - s * 36;
      const int j = scan_row(d, ci * 32 + s);
      const size_t row = (size_t)b * TB + j;
      int col;
      if (g < 8) col = h * 64 + g * 8; else if (g < 16) col = 512 + h * 64 + (g - 8) * 8; else if (g < 20) col = 1024 + h * 64 + half * 32 + (g - 16) * 8;
      else if (g < 28) col = 1536 + d * 64 + (g - 20) * 8; else col = 1664 + d * 64 + (g - 28) * 8;
      const bool pv = (j != 0 && j != NCX), nv = (j != NCX - 1 && j != TB - 1);
      const u32x4 z4 = {0u, 0u, 0u, 0u};
      const u32x4 fc = *(const u32x4*)(FRW + row * 1920 + col);
      const u32x4 fp = pv ? *(const u32x4*)(FRW + (row - 1) * 1920 + col) : z4;
      const u32x4 fn = nv ? *(const u32x4*)(FRW + (row + 1) * 1920 + col) : z4;
      float xc[8], xp[8], xn[8], xs[8], mm[8];
      unpack8(fc, xc); unpack8(fp, xp); unpack8(fn, xn);
      { const f32x4 m0 = *(const f32x4*)(mu + col), m1 = *(const f32x4*)(mu + col + 4); mm[0] = m0[0]; mm[1] = m0[1]; mm[2] = m0[2]; mm[3] = m0[3]; mm[4] = m1[0]; mm[5] = m1[1]; mm[6] = m1[2]; mm[7] = m1[3]; }
#pragma unroll
      for (int e = 0; e < 8; ++e) xs[e] = xc[e] + mm[e] * (0.5f * (xp[e] + xn[e]) - xc[e]);
      if (g < 16) {
        float* dst = (g < 8 ? R_ + s * 64 + g * 8 : KD_ + s * 64 + (g - 8) * 8);
        *(f32x4*)dst = (f32x4){xs[0], xs[1], xs[2], xs[3]}; *(f32x4*)(dst + 4) = (f32x4){xs[4], xs[5], xs[6], xs[7]};
        if (g >= 8) {
          const float* kkp = p.in[18] + h * 64 + (g - 8) * 8; float sq = 0.f;
#pragma unroll
          for (int e = 0; e < 8; ++e) { const float t = xs[e] * kkp[e]; sq += t * t; }
          atomicAdd(&NRM_[s], sq);
        }
      } else if (g < 20) {
        float* dst = V_ + s * 32 + (g - 16) * 8;
        *(f32x4*)dst = (f32x4){xs[0], xs[1], xs[2], xs[3]}; *(f32x4*)(dst + 4) = (f32x4){xs[4], xs[5], xs[6], xs[7]};
      } else if (g < 28) {
        u32x4 w; w.x = cvtpk(tanh_fast(xs[0]), tanh_fast(xs[1])); w.y = cvtpk(tanh_fast(xs[2]), tanh_fast(xs[3])); w.z = cvtpk(tanh_fast(xs[4]), tanh_fast(xs[5])); w.w = cvtpk(tanh_fast(xs[6]), tanh_fast(xs[7]));
        *(u32x4*)(TW_ + s * 144 + (g - 20) * 16) = w;
      } else {
        u32x4 w; w.x = cvtpk(xs[0], xs[1]); w.y = cvtpk(xs[2], xs[3]); w.z = cvtpk(xs[4], xs[5]); w.w = cvtpk(xs[6], xs[7]);
        *(u32x4*)(AL_ + s * 144 + (g - 28) * 16) = w;
      }
    }
    __syncthreads();
    {
#pragma unroll
      for (int m = 0; m < 2; ++m) {
        f32x4 accw = {0.f, 0.f, 0.f, 0.f}, acca = {0.f, 0.f, 0.f, 0.f};
        const bf16x8 t0 = *(const bf16x8*)(TW_ + (m * 16 + fr) * 144 + fq * 16), t1 = *(const bf16x8*)(TW_ + (m * 16 + fr) * 144 + 64 + fq * 16);
        const bf16x8 l0 = *(const bf16x8*)(AL_ + (m * 16 + fr) * 144 + fq * 16), l1 = *(const bf16x8*)(AL_ + (m * 16 + fr) * 144 + 64 + fq * 16);
        accw = mfma16(t0, w2f0, accw); accw = mfma16(t1, w2f1, accw);
        acca = mfma16(l0, a2f0, acca); acca = mfma16(l1, a2f1, acca);
#pragma unroll
        for (int e = 0; e < 4; ++e) {
          const int s = m * 16 + fq * 4 + e, idx = s * 64 + wid * 16 + fr;
          const float sg = sigmoidf_(w0c + accw[e]);
          const float decay = __expf(-0.6065306597126334f * sg);
          const float a = sigmoidf_(a0c + acca[e]);
          const float kraw = KD_[idx];
          const float kkn = kraw * kkc * rsqrtf(NRM_[s] + 1e-12f);
          KK_[idx] = kkn; WD_[idx] = decay; BV_[idx] = kkn * a;
          const float kd = kraw * (1.f + (a - 1.f) * kac);
          KD_[idx] = kd;
          float bon = R_[idx] * kd * rkc;
          bon = red16(bon);
          if (fr == 0) atomicAdd(&BONS_[s], bon);
        }
      }
    }
    __syncthreads();
    if (tid < 32) {
      if (half == 0) { const int j = scan_row(d, ci * 32 + tid); BON[((size_t)d * MT + (size_t)b * TB + j) * 8 + h] = BONS_[tid]; }
      BONS_[tid] = 0.f; NRM_[tid] = 0.f;
    }
#pragma unroll 2
    for (int s = 0; s < 32; ++s) {
      const f32x4* pk = (const f32x4*)(KK_ + s * 64 + js * 8); const f32x4 ka = pk[0], kb = pk[1];
      const f32x4* pw = (const f32x4*)(WD_ + s * 64 + js * 8); const f32x4 wa = pw[0], wb = pw[1];
      const f32x4* pb = (const f32x4*)(BV_ + s * 64 + js * 8); const f32x4 ba = pb[0], bb = pb[1];
      const f32x4* pd = (const f32x4*)(KD_ + s * 64 + js * 8); const f32x4 da = pd[0], db = pd[1];
      const f32x4* pr = (const f32x4*)(R_ + s * 64 + js * 8); const f32x4 ra = pr[0], rb = pr[1];
      const float v = V_[s * 32 + il];
      f32x2 t = S0 * (f32x2){ka[0], ka[1]} + S1 * (f32x2){ka[2], ka[3]};
      f32x2 t2 = S2 * (f32x2){kb[0], kb[1]} + S3 * (f32x2){kb[2], kb[3]};
      t = t + t2;
      const float sa = red8(t[0] + t[1]);
      const f32x2 nsa = {-sa, -sa}, vv = {v, v};
      S0 = S0 * (f32x2){wa[0], wa[1]} + nsa * (f32x2){ba[0], ba[1]} + vv * (f32x2){da[0], da[1]};
      S1 = S1 * (f32x2){wa[2], wa[3]} + nsa * (f32x2){ba[2], ba[3]} + vv * (f32x2){da[2], da[3]};
      S2 = S2 * (f32x2){wb[0], wb[1]} + nsa * (f32x2){bb[0], bb[1]} + vv * (f32x2){db[0], db[1]};
      S3 = S3 * (f32x2){wb[2], wb[3]} + nsa * (f32x2){bb[2], bb[3]} + vv * (f32x2){db[2], db[3]};
      f32x2 y = S0 * (f32x2){ra[0], ra[1]} + S1 * (f32x2){ra[2], ra[3]};
      f32x2 y2 = S2 * (f32x2){rb[0], rb[1]} + S3 * (f32x2){rb[2], rb[3]};
      y = y + y2;
      const float yy = red8(y[0] + y[1]);
      if (js == 0) YO_[s * 32 + il] = yy;
    }
    __syncthreads();
    {
      const int s = tid >> 3, i4 = (tid & 7) * 4;
      const int j = scan_row(d, ci * 32 + s);
      float* yp = Y + ((size_t)b * TB + j) * 512 + h * 64 + half * 32 + i4;
      const f32x4 yv = *(const f32x4*)(YO_ + s * 32 + i4);
      atomicAdd(yp, yv[0]); atomicAdd(yp + 1, yv[1]); atomicAdd(yp + 2, yv[2]); atomicAdd(yp + 3, yv[3]);
    }
  }
  __syncthreads();
}

DI void scan_unit8(const Params& p, int u, char* dsm) {
  const int tid = opaque_tid(), lane = tid & 63, wid = __builtin_amdgcn_readfirstlane(tid >> 6), fr = lane & 15, fq = lane >> 4;
  const int d = u & 1, h = (u >> 1) & 7, b = u >> 4;
  const bool producer = wid >= 4;
  float* FB = (float*)dsm;
  float* YO = FB + 2 * 12288;
  char* TW_ = (char*)(YO + 2 * 2048); char* AL_ = TW_ + 32 * 144;
  float* NRM = (float*)(AL_ + 32 * 144); float* BONS = NRM + 64;
  const bf16_t* FRW = (const bf16_t*)(p.ws + O_FRW);
  const float* mu = p.in[12];
  float* Y = (float*)((char*)p.out + OO_Y);
  float* BON = (float*)(p.ws + O_BON);
  const int pt = tid & 255, pw = wid & 3;
  const int hc = h * 64 + pw * 16 + fr;
  bf16x8 w2f0, w2f1, a2f0, a2f1;
  {
    const bf16_t* w2t = (const bf16_t*)(p.ws + O_W2T) + (size_t)(d * 512 + hc) * 64 + fq * 8;
    const bf16_t* a2t = (const bf16_t*)(p.ws + O_A2T) + (size_t)(d * 512 + hc) * 64 + fq * 8;
    w2f0 = *(const bf16x8*)w2t; w2f1 = *(const bf16x8*)(w2t + 32);
    a2f0 = *(const bf16x8*)a2t; a2f1 = *(const bf16x8*)(a2t + 32);
  }
  const float w0c = p.in[13][d * 512 + hc], a0c = p.in[15][d * 512 + hc], kkc = p.in[18][hc], kac = p.in[19][hc], rkc = p.in[20][hc];
  const int rp = pt >> 3, js = pt & 7;
  f32x2 Sa0 = {0.f, 0.f}, Sa1 = {0.f, 0.f}, Sa2 = {0.f, 0.f}, Sa3 = {0.f, 0.f};
  f32x2 Sb0 = {0.f, 0.f}, Sb1 = {0.f, 0.f}, Sb2 = {0.f, 0.f}, Sb3 = {0.f, 0.f};
  __syncthreads();
  if (tid < 64) { NRM[tid] = 0.f; BONS[tid] = 0.f; }
  __syncthreads();

  auto S1 = [&](int ci) {
    float* F = FB + (ci & 1) * 12288; float* nrm = NRM + (ci & 1) * 32;
    u32x4 fc[5], fp[5], fn[5];
#pragma unroll
    for (int k = 0; k < 5; ++k) {
      const int it = pt + k * 256, s = it / 40, g = it - s * 40;
      const int j = scan_row(d, ci * 32 + s);
      const size_t row = (size_t)b * TB + j;
      const int col = (g < 24 ? (g >> 3) * 512 + h * 64 + (g & 7) * 8 : (g < 32 ? 1536 + d * 64 + (g - 24) * 8 : 1664 + d * 64 + (g - 32) * 8));
      const bool pv = (j != 0 && j != NCX), nv = (j != NCX - 1 && j != TB - 1);
      const u32x4 z4 = {0u, 0u, 0u, 0u};
      fc[k] = *(const u32x4*)(FRW + row * 1920 + col);
      fp[k] = pv ? *(const u32x4*)(FRW + (row - 1) * 1920 + col) : z4;
      fn[k] = nv ? *(const u32x4*)(FRW + (row + 1) * 1920 + col) : z4;
    }
#pragma unroll
    for (int k = 0; k < 5; ++k) {
      const int it = pt + k * 256, s = it / 40, g = it - s * 40;
      const int col = (g < 24 ? (g >> 3) * 512 + h * 64 + (g & 7) * 8 : (g < 32 ? 1536 + d * 64 + (g - 24) * 8 : 1664 + d * 64 + (g - 32) * 8));
      float xc[8], xp[8], xn[8], xs[8], mm[8];
      unpack8(fc[k], xc); unpack8(fp[k], xp); unpack8(fn[k], xn);
      { const f32x4 m0 = *(const f32x4*)(mu + col), m1 = *(const f32x4*)(mu + col + 4); mm[0] = m0[0]; mm[1] = m0[1]; mm[2] = m0[2]; mm[3] = m0[3]; mm[4] = m1[0]; mm[5] = m1[1]; mm[6] = m1[2]; mm[7] = m1[3]; }
#pragma unroll
      for (int e = 0; e < 8; ++e) xs[e] = xc[e] + mm[e] * (0.5f * (xp[e] + xn[e]) - xc[e]);
      if (g < 24) {
        float* dst = (g < 8 ? F + s * 64 + g * 8 : (g < 16 ? F + 2048 + s * 64 + (g - 8) * 8 : F + 10240 + s * 64 + (g - 16) * 8));
        *(f32x4*)dst = (f32x4){xs[0], xs[1], xs[2], xs[3]}; *(f32x4*)(dst + 4) = (f32x4){xs[4], xs[5], xs[6], xs[7]};
        if (g >= 8 && g < 16) {
          const float* kkp = p.in[18] + h * 64 + (g - 8) * 8; float sq = 0.f;
#pragma unroll
          for (int e = 0; e < 8; ++e) { const float t = xs[e] * kkp[e]; sq += t * t; }
          atomicAdd(&nrm[s], sq);
        }
      } else if (g < 32) {
        u32x4 w; w.x = cvtpk(tanh_fast(xs[0]), tanh_fast(xs[1])); w.y = cvtpk(tanh_fast(xs[2]), tanh_fast(xs[3])); w.z = cvtpk(tanh_fast(xs[4]), tanh_fast(xs[5])); w.w = cvtpk(tanh_fast(xs[6]), tanh_fast(xs[7]));
        *(u32x4*)(TW_ + s * 144 + (g - 24) * 16) = w;
      } else {
        u32x4 w; w.x = cvtpk(xs[0], xs[1]); w.y = cvtpk(xs[2], xs[3]); w.z = cvtpk(xs[4], xs[5]); w.w = cvtpk(xs[6], xs[7]);
        *(u32x4*)(AL_ + s * 144 + (g - 32) * 16) = w;
      }
    }
  };
  auto S2 = [&](int ci) {
    float* F = FB + (ci & 1) * 12288; float* R_ = F; float* KD_ = F + 2048; float* KK_ = F + 4096; float* WD_ = F + 6144; float* BV_ = F + 8192;
    const float* nrm = NRM + (ci & 1) * 32; float* bons = BONS + (ci & 1) * 32;
#pragma unroll
    for (int m = 0; m < 2; ++m) {
      f32x4 accw = {0.f, 0.f, 0.f, 0.f}, acca = {0.f, 0.f, 0.f, 0.f};
      const bf16x8 t0 = *(const bf16x8*)(TW_ + (m * 16 + fr) * 144 + fq * 16), t1 = *(const bf16x8*)(TW_ + (m * 16 + fr) * 144 + 64 + fq * 16);
      const bf16x8 l0 = *(const bf16x8*)(AL_ + (m * 16 + fr) * 144 + fq * 16), l1 = *(const bf16x8*)(AL_ + (m * 16 + fr) * 144 + 64 + fq * 16);
      accw = mfma16(t0, w2f0, accw); accw = mfma16(t1, w2f1, accw);
      acca = mfma16(l0, a2f0, acca); acca = mfma16(l1, a2f1, acca);
#pragma unroll
      for (int e = 0; e < 4; ++e) {
        const int s = m * 16 + fq * 4 + e, idx = s * 64 + pw * 16 + fr;
        const float sg = sigmoidf_(w0c + accw[e]);
        const float decay = __expf(-0.6065306597126334f * sg);
        const float a = sigmoidf_(a0c + acca[e]);
        const float kraw = KD_[idx];
        const float kkn = kraw * kkc * rsqrtf(nrm[s] + 1e-12f);
        KK_[idx] = kkn; WD_[idx] = decay; BV_[idx] = kkn * a;
        const float kd = kraw * (1.f + (a - 1.f) * kac);
        KD_[idx] = kd;
        float bon = R_[idx] * kd * rkc;
        bon = red16(bon);
        if (fr == 0) atomicAdd(&bons[s], bon);
      }
    }
    if (pt < 32) NRM[((ci & 1) ^ 1) * 32 + pt] = 0.f;
  };
  struct StepVec { f32x4 ra, rb, da, db, ka, kb, wa, wb, ba, bb; f32x2 v2; };
  auto LOADV = [&](StepVec& X, const float* F, int s) {
    const f32x4* pr = (const f32x4*)(F + s * 64 + js * 8); X.ra = pr[0]; X.rb = pr[1];
    const f32x4* pd = (const f32x4*)(F + 2048 + s * 64 + js * 8); X.da = pd[0]; X.db = pd[1];
    const f32x4* pk = (const f32x4*)(F + 4096 + s * 64 + js * 8); X.ka = pk[0]; X.kb = pk[1];
    const f32x4* pw_ = (const f32x4*)(F + 6144 + s * 64 + js * 8); X.wa = pw_[0]; X.wb = pw_[1];
    const f32x4* pb = (const f32x4*)(F + 8192 + s * 64 + js * 8); X.ba = pb[0]; X.bb = pb[1];
    X.v2 = *(const f32x2*)(F + 10240 + s * 64 + rp * 2);
  };
  auto STEP = [&](const StepVec& X, float* yo, int s) {
    const f32x2 k01 = {X.ka[0], X.ka[1]}, k23 = {X.ka[2], X.ka[3]}, k45 = {X.kb[0], X.kb[1]}, k67 = {X.kb[2], X.kb[3]};
    f32x2 ta = Sa0 * k01 + Sa1 * k23; ta = ta + (Sa2 * k45 + Sa3 * k67);
    f32x2 tb = Sb0 * k01 + Sb1 * k23; tb = tb + (Sb2 * k45 + Sb3 * k67);
    const float saa = red8(ta[0] + ta[1]), sab = red8(tb[0] + tb[1]);
    const f32x2 w01 = {X.wa[0], X.wa[1]}, w23 = {X.wa[2], X.wa[3]}, w45 = {X.wb[0], X.wb[1]}, w67 = {X.wb[2], X.wb[3]};
    const f32x2 b01 = {X.ba[0], X.ba[1]}, b23 = {X.ba[2], X.ba[3]}, b45 = {X.bb[0], X.bb[1]}, b67 = {X.bb[2], X.bb[3]};
    const f32x2 d01 = {X.da[0], X.da[1]}, d23 = {X.da[2], X.da[3]}, d45 = {X.db[0], X.db[1]}, d67 = {X.db[2], X.db[3]};
    { const f32x2 ns = {-saa, -saa}, vv = {X.v2[0], X.v2[0]};
      Sa0 = Sa0 * w01 + ns * b01 + vv * d01; Sa1 = Sa1 * w23 + ns * b23 + vv * d23; Sa2 = Sa2 * w45 + ns * b45 + vv * d45; Sa3 = Sa3 * w67 + ns * b67 + vv * d67; }
    { const f32x2 ns = {-sab, -sab}, vv = {X.v2[1], X.v2[1]};
      Sb0 = Sb0 * w01 + ns * b01 + vv * d01; Sb1 = Sb1 * w23 + ns * b23 + vv * d23; Sb2 = Sb2 * w45 + ns * b45 + vv * d45; Sb3 = Sb3 * w67 + ns * b67 + vv * d67; }
    const f32x2 r01 = {X.ra[0], X.ra[1]}, r23 = {X.ra[2], X.ra[3]}, r45 = {X.rb[0], X.rb[1]}, r67 = {X.rb[2], X.rb[3]};
    f32x2 ya = Sa0 * r01 + Sa1 * r23; ya = ya + (Sa2 * r45 + Sa3 * r67);
    f32x2 yb = Sb0 * r01 + Sb1 * r23; yb = yb + (Sb2 * r45 + Sb3 * r67);
    const float y0 = red8(ya[0] + ya[1]), y1 = red8(yb[0] + yb[1]);
    if (js == 0) *(f32x2*)(yo + s * 64 + rp * 2) = (f32x2){y0, y1};
  };
  auto SCAN = [&](int ci, int s0) {
    const float* F = FB + (ci & 1) * 12288; float* yo = YO + (ci & 1) * 2048;
    StepVec A, B;
    LOADV(A, F, s0);
#pragma unroll 1
    for (int s = s0; s < s0 + 16; s += 2) {
      LOADV(B, F, s + 1);
      STEP(A, yo, s);
      LOADV(A, F, s + 2);
      STEP(B, yo, s + 1);
    }
  };

  if (producer) S1(0);
  __syncthreads();
  if (producer) S2(0);
  __syncthreads();
  for (int ci = 0; ci < 72; ++ci) {
    if (producer) {
      if (pt < 32) { float* bons = BONS + (ci & 1) * 32; const int j = scan_row(d, ci * 32 + pt); BON[((size_t)d * MT + (size_t)b * TB + j) * 8 + h] = bons[pt]; bons[pt] = 0.f; }
      if (ci + 1 < 72) S1(ci + 1);
    } else SCAN(ci, 0);
    __syncthreads();
    if (producer) { if (ci + 1 < 72) S2(ci + 1); }
    else SCAN(ci, 16);
    __syncthreads();
    if (!producer) {
      const float* yo = YO + (ci & 1) * 2048;
      const int s = pt >> 3, i8 = (pt & 7) * 8;
      const int j = scan_row(d, ci * 32 + s);
      bf16_t* yp = (bf16_t*)((char*)p.out + OO_Y) + (size_t)d * MT * 512 + ((size_t)b * TB + j) * 512 + h * 64 + i8;
      const f32x4 y0 = *(const f32x4*)(yo + s * 64 + i8), y1 = *(const f32x4*)(yo + s * 64 + i8 + 4);
      u32x4 w; w.x = cvtpk(y0[0], y0[1]); w.y = cvtpk(y0[2], y0[3]); w.z = cvtpk(y1[0], y1[1]); w.w = cvtpk(y1[2], y1[3]);
      *(u32x4*)yp = w;
    }
  }
  __syncthreads();
}

DI unsigned sb_ld(unsigned* q) { return __hip_atomic_load(q, __ATOMIC_RELAXED, __HIP_MEMORY_SCOPE_AGENT); }
DI void qkv_work(const Params& p, char* dsm, int b3, int n3) {
  char* ws = p.ws;
  EpiQ eq{(bf16_t*)(ws + O_Q), (const float*)(ws + O_RSQ), (const float*)(ws + O_ROPE)};
  gemm8_phase((const bf16_t*)(ws + O_FQ), 384, (const bf16_t*)(ws + O_WUQ), 384, 384, 72, 3, 0, 0, eq, dsm, b3, n3);
  EpiKn ek{(bf16_t*)(ws + O_K), (const float*)(ws + O_RSQ), (const float*)(ws + O_FKR), (const float*)(ws + O_ROPE)};
  gemm8_phase((const bf16_t*)(ws + O_FKV), 256, (const bf16_t*)(ws + O_WUK), 256, 256, 72, 2, 0, 0, ek, dsm, (b3 + n3 - (216 % n3)) % n3, n3);
  EpiVt ev{(bf16_t*)((char*)p.out + OO_VT), (const float*)(ws + O_RSQ)};
  gemm8_phase((const bf16_t*)(ws + O_WUV), 256, (const bf16_t*)(ws + O_FKV), 256, 256, 2, 72, 0, 0, ev, dsm, (b3 + n3 - (104 % n3)) % n3, n3);
}
DI void phase_mixer(const Params& p, char* smem, char* dsm, int bid, int nb) {
  unsigned* cnt = (unsigned*)(p.ws + O_CNT);
  const int pbid = blockIdx.x, pnb = gridDim.x;
  const int q0 = pnb >= 192 ? 128 : 0, nq = pnb - q0;
  if (pbid >= q0) {
    qkv_work(p, dsm, pbid - q0, nq);
    asm volatile("s_waitcnt vmcnt(0)" ::: "memory");
    __syncthreads();
    if (threadIdx.x == 0) {
      __builtin_amdgcn_fence(__ATOMIC_RELEASE, "agent");
      asm volatile("s_waitcnt vmcnt(0)" ::: "memory");
      __hip_atomic_fetch_add(cnt + 8, 1u, __ATOMIC_RELAXED, __HIP_MEMORY_SCOPE_AGENT);
    }
  }
  for (int u = pbid; u < 128; u += pnb) scan_unit8(p, u, dsm);
  __syncthreads();
  if (threadIdx.x == 0) {
    unsigned sp = 0;
    while (sb_ld(cnt + 8) < (unsigned)nq) { __builtin_amdgcn_s_sleep(2); if (++sp > (1u << 23)) break; }
    __builtin_amdgcn_fence(__ATOMIC_ACQUIRE, "agent");
    asm volatile("s_waitcnt vmcnt(0)" ::: "memory");
  }
  __syncthreads();
  int* slot = (int*)(dsm + 2 * SMEM_BYTES);
  const int vb = __builtin_amdgcn_readfirstlane(opaque_tid() >> 8);
  for (;;) {
    __syncthreads();
    if (threadIdx.x == 0) *slot = (int)atomicAdd(cnt, 1u);
    __syncthreads();
    const int q = *slot;
    if (q >= 576) break;
    attn_unit(p, 2 * q + vb, smem);
  }
  for (;;) {
    __syncthreads();
    if (threadIdx.x == 0) *slot = (int)atomicAdd(cnt + 2, 1u);
    __syncthreads();
    const int t = p.ncvt_early + 2 * (*slot) + vb;
    if (t - vb >= p.ncvt) break;
    if (t < p.ncvt) p0_cvt(p, t, smem); else { __syncthreads(); __syncthreads(); }
  }
}

DI void rwkv_out_unit(const Params& p, int u, char* smem) {
  const int tid = VT, lane = tid & 63, wid = tid >> 6, wr = wid >> 1, wc = wid & 1, fr = lane & 15, fq = lane >> 4;
  const int mt = u >> 2, nt = u & 3, row0 = mt * 128;
  const bf16_t* FRW = (const bf16_t*)(p.ws + O_FRW);
  const float* mu = p.in[12];
  __syncthreads();
  for (int it = tid; it < 2048; it += 256) {
    const int r = it >> 4, c8 = (it & 15) * 8, row = row0 + r, j = row % TB, col = 1792 + c8;
    const bool pv = (j != 0 && j != NCX), nv = (j != NCX - 1 && j != TB - 1);
    const u32x4 z4 = {0u, 0u, 0u, 0u};
    const u32x4 fc = *(const u32x4*)(FRW + (size_t)row * 1920 + col);
    const u32x4 fp = pv ? *(const u32x4*)(FRW + (size_t)(row - 1) * 1920 + col) : z4;
    const u32x4 fn = nv ? *(const u32x4*)(FRW + (size_t)(row + 1) * 1920 + col) : z4;
    float xc[8], xp[8], xn[8], xs[8];
    unpack8(fc, xc); unpack8(fp, xp); unpack8(fn, xn);
#pragma unroll
    for (int e = 0; e < 8; ++e) { const float m = mu[col + e]; xs[e] = sigmoidf_(xc[e] + m * (0.5f * (xp[e] + xn[e]) - xc[e])); }
    u32x4 w; w.x = cvtpk(xs[0], xs[1]); w.y = cvtpk(xs[2], xs[3]); w.z = cvtpk(xs[4], xs[5]); w.w = cvtpk(xs[6], xs[7]);
    *(u32x4*)(smem + r * 272 + c8 * 2) = w;
  }
  __syncthreads();
  f32x4 acc[4][4];
#pragma unroll
  for (int m = 0; m < 4; ++m)
#pragma unroll
    for (int n = 0; n < 4; ++n) acc[m][n] = (f32x4){0.f, 0.f, 0.f, 0.f};
  const bf16_t* g2t = (const bf16_t*)(p.ws + O_G2T) + (size_t)(nt * 128 + wc * 64 + fr) * 128 + fq * 8;
#pragma unroll
  for (int kk = 0; kk < 4; ++kk) {
    bf16x8 af[4], bv[4];
#pragma unroll
    for (int m = 0; m < 4; ++m) af[m] = *(const bf16x8*)(smem + (wr * 64 + m * 16 + fr) * 272 + kk * 64 + fq * 16);
#pragma unroll
    for (int n = 0; n < 4; ++n) bv[n] = *(const bf16x8*)(g2t + n * 16 * 128 + kk * 32);
#pragma unroll
    for (int m = 0; m < 4; ++m)
#pragma unroll
      for (int n = 0; n < 4; ++n) acc[m][n] = mfma16(bv[n], af[m], acc[m][n]);
  }
  const int hh = nt * 2 + wc;
  const bf16_t* Yb = (const bf16_t*)((const char*)p.out + OO_Y);
  const float* BON = (const float*)(p.ws + O_BON);
  const float* gnw = p.in[21]; const float* gnb = p.in[22];
  bf16_t* CAT = (bf16_t*)(p.ws + O_A);
#pragma unroll
  for (int m = 0; m < 4; ++m) {
    const int row = row0 + wr * 64 + m * 16 + fr, j = row % TB;
    const bool pv = (j != 0 && j != NCX), nv = (j != NCX - 1 && j != TB - 1);
    f32x4 y[4]; float s = 0.f;
#pragma unroll
    for (int n = 0; n < 4; ++n) {
      const u32x2 ya = *(const u32x2*)(Yb + (size_t)row * 512 + hh * 64 + n * 16 + fq * 4), yb = *(const u32x2*)(Yb + (size_t)MT * 512 + (size_t)row * 512 + hh * 64 + n * 16 + fq * 4);
      y[n] = (f32x4){lo_f(ya.x) + lo_f(yb.x), hi_f(ya.x) + hi_f(yb.x), lo_f(ya.y) + lo_f(yb.y), hi_f(ya.y) + hi_f(yb.y)};
      s += y[n][0] + y[n][1] + y[n][2] + y[n][3];
    }
    s += __shfl_xor(s, 16); s += __shfl_xor(s, 32);
    const float mean = s * (1.f / 64.f); float q = 0.f;
#pragma unroll
    for (int n = 0; n < 4; ++n) { const f32x4 dd = y[n] - mean; q += dd[0] * dd[0] + dd[1] * dd[1] + dd[2] * dd[2] + dd[3] * dd[3]; }
    q += __shfl_xor(q, 16); q += __shfl_xor(q, 32);
    const float rstd = rsqrtf(q * (1.f / 64.f) + 64e-5f);
    const float bsum = BON[(size_t)row * 8 + hh] + BON[((size_t)MT + row) * 8 + hh];
#pragma unroll
    for (int n = 0; n < 4; ++n) {
      const int c = hh * 64 + n * 16 + fq * 4, col = 1024 + c;
      const u32x2 z2 = {0u, 0u};
      const u32x2 fc = *(const u32x2*)(FRW + (size_t)row * 1920 + col);
      const u32x2 fp = pv ? *(const u32x2*)(FRW + (size_t)(row - 1) * 1920 + col) : z2;
      const u32x2 fn = nv ? *(const u32x2*)(FRW + (size_t)(row + 1) * 1920 + col) : z2;
      const float xc[4] = {lo_f(fc.x), hi_f(fc.x), lo_f(fc.y), hi_f(fc.y)}, xp[4] = {lo_f(fp.x), hi_f(fp.x), lo_f(fp.y), hi_f(fp.y)}, xn[4] = {lo_f(fn.x), hi_f(fn.x), lo_f(fn.y), hi_f(fn.y)};
      const f32x4 mm = *(const f32x4*)(mu + col), gw = *(const f32x4*)(gnw + c), gb = *(const f32x4*)(gnb + c);
      f32x4 o;
#pragma unroll
      for (int e = 0; e < 4; ++e) {
        const float v = xc[e] + mm[e] * (0.5f * (xp[e] + xn[e]) - xc[e]);
        const float yn = (y[n][e] - mean) * rstd * gw[e] + gb[e];
        o[e] = (yn + bsum * v) * acc[m][n][e];
      }
      *(u32x2*)(CAT + (size_t)row * 1024 + 512 + c) = pack4(o);
    }
  }
}

DI float wave_sum(float v) {
#pragma unroll
  for (int o = 1; o < 64; o <<= 1) v += __shfl_xor(v, o);
  return v;
}
DI void phase_ln(const Params& p, const float* g, const float* bt, const float* mods, int sh_off, int sc_off, int latent_only, int is_final, int bid, int nb, int ctx_comb = 0) {
  const int lane = VT & 63, wid = VT >> 6;
  float* XA = (float*)(p.ws + O_X); bf16_t* H = (bf16_t*)(p.ws + O_A);
  const int nrows = latent_only ? 16384 : MT;
  f32x4 gv[4], bv[4];
#pragma unroll
  for (int i = 0; i < 4; ++i) { gv[i] = *(const f32x4*)(g + i * 256 + lane * 4); bv[i] = *(const f32x4*)(bt + i * 256 + lane * 4); }
  for (int ri = bid * 4 + wid; ri < nrows; ri += nb * 4) {
    const int row = latent_only ? (ri >> 11) * TB + NCX + (ri & 2047) : ri;
    float* xr = XA + (size_t)row * 1024;
    f32x4 v[4]; float s = 0.f;
    const float* mp = mods + modrow_of(row) * 6144;
    f32x4 scv[4], shv[4];
#pragma unroll
    for (int i = 0; i < 4; ++i) v[i] = *(const f32x4*)(xr + i * 256 + lane * 4);
    if (!is_final) {
#pragma unroll
      for (int i = 0; i < 4; ++i) { scv[i] = *(const f32x4*)(mp + sc_off + i * 256 + lane * 4); shv[i] = *(const f32x4*)(mp + sh_off + i * 256 + lane * 4); }
    }
    if (ctx_comb && (row % TB) < NCX) {
      const f32x2 st1 = *(const f32x2*)((const float*)(p.ws + O_STATS) + (size_t)row * 2);
      const float* g2p = (const float*)(p.ws + O_MODS) + 8 * 6144 + 5120;
      const int cr = (row / TB) * NCX + (row % TB);
      const float* P = p.out;
#pragma unroll
      for (int i = 0; i < 4; ++i) {
        const int c = i * 256 + lane * 4;
        f32x4 acc = *(const f32x4*)(P + (size_t)cr * 1024 + c);
#pragma unroll
        for (int sp_ = 1; sp_ < 8; ++sp_) acc += *(const f32x4*)(P + ((size_t)sp_ * 2048 + cr) * 1024 + c);
        v[i] = ALPHA * ((v[i] - st1[0]) * st1[1] * *(const f32x4*)(p.in[24] + c) + *(const f32x4*)(p.in[25] + c)) + *(const f32x4*)(g2p + c) * acc;
      }
    }
#pragma unroll
    for (int i = 0; i < 4; ++i) s += v[i][0] + v[i][1] + v[i][2] + v[i][3];
    const float mean = wave_sum(s) * (1.f / 1024.f);
    float q = 0.f;
#pragma unroll
    for (int i = 0; i < 4; ++i) { const f32x4 dd = v[i] - mean; q += dd[0] * dd[0] + dd[1] * dd[1] + dd[2] * dd[2] + dd[3] * dd[3]; }
    const float rstd = rsqrtf(wave_sum(q) * (1.f / 1024.f) + 1e-5f);
    if (!is_final && lane == 0) *(f32x2*)((float*)(p.ws + O_STATS) + (size_t)row * 2) = (f32x2){mean, rstd};
#pragma unroll
    for (int i = 0; i < 4; ++i) {
      const int c = i * 256 + lane * 4;
      const f32x4 o = (v[i] - mean) * rstd * gv[i] + bv[i];
      if (is_final) *(f32x4*)(p.out + (size_t)ri * 1024 + c) = o;
      else {
        const f32x4 hm = o * (1.f + scv[i]) + shv[i];
        *(u32x2*)(H + (size_t)row * 1024 + c) = pack4(hm);
      }
    }
  }
}

DI void lru_unit(const Params& p, int u, int pass, char* smem) {
  const int tid = VT, lane = tid & 63, wid = tid >> 6, fr = lane & 15, fq = lane >> 4;
  const int ci = u % 72, k = (u / 72) & 7, b = u / 576;
  if (pass == 2 && ci < 8) return;
  float* XC_ = (float*)smem; char* At_ = smem + 16384; float* A_ = (float*)(smem + 16384 + 8704); float* U_ = A_ + 4096;
  const bf16_t* XR = (const bf16_t*)(p.ws + O_XR);
  const int j0 = ci * 32, row0 = b * TB + j0, seg_lo = ci < 8 ? 0 : NCX, seg_hi = ci < 8 ? NCX - 1 : TB - 1;
  const float* cw = p.in[33]; const float* cb = p.in[34];
  bf16x8 bga[2][4], bgx[2][4];
  float gabv[2][2], gxbv[2][2], lamv[2][2];
  {
    const bf16_t* ga = (const bf16_t*)(p.ws + O_GAT) + (size_t)(k * 128 + wid * 32 + fr) * 128 + fq * 8;
    const bf16_t* gx = (const bf16_t*)(p.ws + O_GXT) + (size_t)(k * 128 + wid * 32 + fr) * 128 + fq * 8;
#pragma unroll
    for (int n = 0; n < 2; ++n)
#pragma unroll
      for (int kk = 0; kk < 4; ++kk) { bga[n][kk] = *(const bf16x8*)(ga + n * 2048 + kk * 32); bgx[n][kk] = *(const bf16x8*)(gx + n * 2048 + kk * 32); }
#pragma unroll
    for (int d = 0; d < 2; ++d)
#pragma unroll
      for (int n = 0; n < 2; ++n) { const int ch = d * 1024 + k * 128 + wid * 32 + n * 16 + fr; gabv[d][n] = p.in[36][ch]; gxbv[d][n] = p.in[38][ch]; lamv[d][n] = ((const float*)(p.ws + O_SP))[ch]; }
  }
  __syncthreads();
  for (int it = tid; it < 512; it += 256) {
    const int t = it >> 4, c8 = (it & 15) * 8, j = j0 + t, ch = k * 128 + c8;
    float a[8];
#pragma unroll
    for (int e = 0; e < 8; ++e) a[e] = cb[ch + e];
#pragma unroll
    for (int i = 0; i < 4; ++i) {
      const int jj = j + i - 2;
      if (jj >= seg_lo && jj <= seg_hi) {
        float x[8]; unpack8(*(const u32x4*)(XR + (size_t)(b * TB + jj) * 1024 + ch), x);
#pragma unroll
        for (int e = 0; e < 8; ++e) a[e] += x[e] * cw[i * 1024 + ch + e];
      }
    }
    *(f32x4*)(XC_ + t * 128 + c8) = (f32x4){a[0], a[1], a[2], a[3]}; *(f32x4*)(XC_ + t * 128 + c8 + 4) = (f32x4){a[4], a[5], a[6], a[7]};
    u32x4 w; w.x = cvtpk(a[0], a[1]); w.y = cvtpk(a[2], a[3]); w.z = cvtpk(a[4], a[5]); w.w = cvtpk(a[6], a[7]);
    *(u32x4*)(At_ + t * 272 + c8 * 2) = w;
  }
  __syncthreads();
  float hs[32];
#pragma unroll
  for (int t = 0; t < 32; ++t) hs[t] = 0.f;
  f32x2* CARRY = (f32x2*)(p.ws + O_CARRY); const float* HIN = (const float*)(p.ws + O_HIN);
#pragma unroll
  for (int d = 0; d < 2; ++d) {
    f32x4 aa[2][2], ax[2][2];
#pragma unroll
    for (int m = 0; m < 2; ++m)
#pragma unroll
      for (int n = 0; n < 2; ++n) { aa[m][n] = (f32x4){0.f, 0.f, 0.f, 0.f}; ax[m][n] = (f32x4){0.f, 0.f, 0.f, 0.f}; }
#pragma unroll
    for (int kk = 0; kk < 4; ++kk) {
      bf16x8 af[2];
#pragma unroll
      for (int m = 0; m < 2; ++m) af[m] = *(const bf16x8*)(At_ + (m * 16 + fr) * 272 + kk * 64 + fq * 16);
#pragma unroll
      for (int n = 0; n < 2; ++n)
#pragma unroll
        for (int m = 0; m < 2; ++m) { aa[m][n] = mfma16(af[m], bga[n][kk], aa[m][n]); ax[m][n] = mfma16(af[m], bgx[n][kk], ax[m][n]); }
    }
    if (d == 0) {
      const bf16_t* ga = (const bf16_t*)(p.ws + O_GAT) + (size_t)((8 + k) * 128 + wid * 32 + fr) * 128 + fq * 8;
      const bf16_t* gx = (const bf16_t*)(p.ws + O_GXT) + (size_t)((8 + k) * 128 + wid * 32 + fr) * 128 + fq * 8;
#pragma unroll
      for (int n = 0; n < 2; ++n)
#pragma unroll
        for (int kk = 0; kk < 4; ++kk) { bga[n][kk] = *(const bf16x8*)(ga + n * 2048 + kk * 32); bgx[n][kk] = *(const bf16x8*)(gx + n * 2048 + kk * 32); }
    }
    const size_t cidx = ((size_t)((b * 2 + d) * 72 + ci)) * 1024 + k * 128 + (tid & 127);
    float hin = 0.f;
    if (pass == 2 && tid < 128) hin = HIN[cidx];
#pragma unroll
    for (int n = 0; n < 2; ++n) {
      const int cc = wid * 32 + n * 16 + fr;
      const float gab = gabv[d][n], gxb = gxbv[d][n];
      const float sp = lamv[d][n];
#pragma unroll
      for (int m = 0; m < 2; ++m)
#pragma unroll
        for (int e = 0; e < 4; ++e) {
          const int t = m * 16 + fq * 4 + e;
          const float e1 = 1.f + __expf(-(aa[m][n][e] + gab)), e2 = 1.f + __expf(-(ax[m][n][e] + gxb));
          const float inv = __builtin_amdgcn_rcpf(e1 * e2);
          const float r = e2 * inv, ig = e1 * inv;
          const float av = __expf(-sp * r);
          A_[t * 128 + cc] = av;
          U_[t * 128 + cc] = __builtin_amdgcn_sqrtf(fmaxf(fmaf(-av, av, 1.f), 0.f)) * ig * XC_[t * 128 + cc];
        }
    }
    __syncthreads();
    if (tid < 128) {
      if (pass == 1) {
        float hcur = 0.f, P = 1.f;
#pragma unroll
        for (int tt = 0; tt < 32; ++tt) { const int t = d ? 31 - tt : tt; const float a = A_[t * 128 + tid]; hcur = a * hcur + U_[t * 128 + tid]; P *= a; }
        CARRY[cidx] = (f32x2){P, hcur};
      } else {
        float hcur = hin;
#pragma unroll
        for (int tt = 0; tt < 32; ++tt) { const int t = d ? 31 - tt : tt; hcur = A_[t * 128 + tid] * hcur + U_[t * 128 + tid]; hs[t] += hcur; }
      }
    }
    __syncthreads();
  }
  if (pass == 2) {
    if (tid < 128) {
#pragma unroll
      for (int t = 0; t < 32; ++t) A_[t * 128 + tid] = hs[t];
    }
    __syncthreads();
    const bf16_t* GATE = (const bf16_t*)(p.ws + O_GATE); bf16_t* Pout = (bf16_t*)(p.ws + O_A);
#pragma unroll
    for (int i = 0; i < 2; ++i) {
      const int it = tid + i * 256, t = it >> 4, c8 = (it & 15) * 8;
      const size_t idx = (size_t)(row0 + t) * 1024 + k * 128 + c8;
      float g8[8]; unpack8(*(const u32x4*)(GATE + idx), g8);
      const f32x4 h0 = *(const f32x4*)(A_ + t * 128 + c8), h1 = *(const f32x4*)(A_ + t * 128 + c8 + 4);
      u32x4 w; w.x = cvtpk(g8[0] * h0[0], g8[1] * h0[1]); w.y = cvtpk(g8[2] * h0[2], g8[3] * h0[3]); w.z = cvtpk(g8[4] * h1[0], g8[5] * h1[1]); w.w = cvtpk(g8[6] * h1[2], g8[7] * h1[3]);
      *(u32x4*)(Pout + idx) = w;
    }
  }
}
DI void phase_lru_carry(const Params& p, int bid, int nb) {
  const f32x2* CARRY = (const f32x2*)(p.ws + O_CARRY); float* HIN = (float*)(p.ws + O_HIN);
  for (int gid = bid * 256 + VT; gid < 16384; gid += nb * 256) {
    const int b = gid >> 11, d = (gid >> 10) & 1, ch = gid & 1023;
    const size_t base = ((size_t)((b * 2 + d) * 72)) * 1024 + ch;
    float hcur = 0.f;
#pragma unroll 1
    for (int ob = 0; ob < 72; ob += 24) {
      f32x2 c[24];
#pragma unroll
      for (int q = 0; q < 24; ++q) { const int oi = ob + q; const int ci = d == 0 ? oi : (oi < 8 ? 7 - oi : 71 - (oi - 8)); c[q] = CARRY[base + (size_t)ci * 1024]; }
#pragma unroll
      for (int q = 0; q < 24; ++q) { const int oi = ob + q; const int ci = d == 0 ? oi : (oi < 8 ? 7 - oi : 71 - (oi - 8)); HIN[base + (size_t)ci * 1024] = hcur; hcur = c[q][0] * hcur + c[q][1]; }
    }
  }
}

#define XB_TMO      128
#define XB_XCNT(j)  (256  + 64 * (j))
#define XB_XSUB(j)  (1280 + 64 * (j))
#define XB_XGEN(j)  (2304 + 64 * (j))
#define XB_TOP      3328
#define XB_TOPGEN   3392
#define XCD_BAR_WORDS 3456
#define XB_SPIN_CAP (1u << 22)
#define LAS __attribute__((address_space(3)))
DI unsigned xb_ld(unsigned* p) { return __hip_atomic_load(p, __ATOMIC_RELAXED, __HIP_MEMORY_SCOPE_AGENT); }
DI unsigned xb_add(unsigned* p, unsigned v) { return __hip_atomic_fetch_add(p, v, __ATOMIC_RELAXED, __HIP_MEMORY_SCOPE_AGENT); }
DI unsigned xb_xcc_id() { return (unsigned)__builtin_amdgcn_s_getreg((3 << 11) | 20) & 0xFu; }
#define XB_SPIN(cond, bar) do { unsigned _sp = 0; while (cond) { __builtin_amdgcn_s_sleep(1); \
    if ((++_sp & 255u) == 0u) { if (xb_ld(&(bar)[XB_TMO])) break; if (_sp > XB_SPIN_CAP) { atomicAdd(&(bar)[XB_TMO], 1u); break; } } } } while (0)
struct XcdBarrier { unsigned* bar; unsigned x; volatile LAS unsigned* st; };
DI XcdBarrier xcd_barrier_post(unsigned* bar, volatile LAS unsigned* st) {
  XcdBarrier b; b.bar = bar; b.x = xb_xcc_id(); b.st = st;
  if (threadIdx.x == 0) (void)xb_add(&bar[XB_XCNT(b.x)], 1u);
  return b;
}
DI void xcd_barrier_complete(unsigned* bar, unsigned x, unsigned& nloc, unsigned& nx) {
  const unsigned G = gridDim.x * gridDim.y * gridDim.z;
  unsigned sum, cnt, mine, sp = 0u;
  for (;;) {
    sum = 0u; cnt = 0u; mine = 0u;
#pragma unroll
    for (unsigned j = 0; j < 16; ++j) { const unsigned c = xb_ld(&bar[XB_XCNT(j)]); sum += c; cnt += (c > 0u) ? 1u : 0u; mine = (j == x) ? c : mine; }
    if (sum == G) break;
    __builtin_amdgcn_s_sleep(1);
    if ((++sp & 255u) == 0u) { if (xb_ld(&bar[XB_TMO])) break; if (sp > XB_SPIN_CAP) { atomicAdd(&bar[XB_TMO], 1u); break; } }
  }
  nloc = mine > 0u ? mine : 1u; nx = cnt > 0u ? cnt : 1u;
}
DI void xcd_barrier(const XcdBarrier& b) {
  asm volatile("s_waitcnt vmcnt(0)" ::: "memory");
  __syncthreads();
  if (threadIdx.x == 0) {
    unsigned* bar = b.bar;
    __builtin_amdgcn_s_waitcnt(0);
    unsigned nloc = b.st[0], nx = b.st[1];
    if (nloc == 0u) { xcd_barrier_complete(bar, b.x, nloc, nx); b.st[0] = nloc; b.st[1] = nx; }
    const unsigned old = xb_add(&bar[XB_XSUB(b.x)], 1u);
    const unsigned gen = old / nloc;
    if (old + 1u == (gen + 1u) * nloc) {
      __builtin_amdgcn_fence(__ATOMIC_RELEASE, "agent");
      asm volatile("s_waitcnt vmcnt(0)" ::: "memory");
      const unsigned og = xb_add(&bar[XB_TOP], 1u);
      const unsigned tg = og / nx;
      if (og + 1u == (tg + 1u) * nx) xb_add(&bar[XB_TOPGEN], 1u);
      else XB_SPIN(xb_ld(&bar[XB_TOPGEN]) == tg, bar);
      __builtin_amdgcn_fence(__ATOMIC_ACQUIRE, "agent");
      xb_add(&bar[XB_XGEN(b.x)], 1u);
      asm volatile("s_waitcnt vmcnt(0)" ::: "memory");
    } else {
      XB_SPIN(xb_ld(&bar[XB_XGEN(b.x)]) == gen, bar);
      __builtin_amdgcn_fence(__ATOMIC_ACQUIRE, "agent");
      asm volatile("s_waitcnt vmcnt(0)" ::: "memory");
    }
  }
  __syncthreads();
}

constexpr int N_PHASES = 24;
template <int ph>
DI void run_phase(const Params& p, char* smem, char* dsm, int bid, int nb, int pbid, int pnb) {
  char* ws = p.ws;
  const float* mods0 = (const float*)(ws + O_MODS); const float* mods1 = mods0 + 9 * 6144;
  bf16_t* HA = (bf16_t*)(ws + O_A); float* XA = (float*)(ws + O_X);
  bf16_t* H1 = (bf16_t*)(ws + O_B);
  if constexpr (ph == 0) phase0(p, smem, bid, nb);
  else if constexpr (ph == 1) phase_prep_a0(p, bid, nb);
  else if constexpr (ph == 2) { EpiWin0 e{(bf16_t*)(ws + O_FQ), (bf16_t*)(ws + O_FKV), (float*)(ws + O_FKR), (bf16_t*)(ws + O_FRW), (float*)(ws + O_RSQ)};
      gemm8_phase(HA, 1024, (const bf16_t*)(ws + O_WIN0), 1024, 1024, 72, 11, 0, 0, e, dsm, pbid, pnb); }
  else if constexpr (ph == 3) {}
  else if constexpr (ph == 4) phase_mixer(p, smem, dsm, bid, nb);
  else if constexpr (ph == 5) { for (int u = bid; u < 576; u += nb) rwkv_out_unit(p, u, smem); }
  else if constexpr (ph == 6) { EpiRes e{p.in[0], p.in[2], XA, mods0, 2048, 1, ALPHA, nullptr, nullptr, nullptr};
      gemm8_phase(HA, 1024, (const bf16_t*)(ws + O_WOUT0), 1024, 1024, 72, 4, 0, 0, e, dsm, pbid, pnb); }
  else if constexpr (ph == 7) phase_ln(p, p.in[24], p.in[25], mods0, 3072, 4096, 0, 0, bid, nb);
  else if constexpr (ph == 8 || ph == 10) { constexpr int hf = (ph - 8) >> 1; EpiMlp1 e{H1};
      gemm8_phase(HA, 1024, (const bf16_t*)(ws + O_W1_0) + (size_t)hf * 2048 * 1024, 1024, 1024, 64, 8, 1, 0, e, dsm, pbid, pnb);
      if constexpr (hf == 0) { EpiMlp1Ctx ec{(bf16_t*)(ws + O_B + 72 * MiB)};
        gemm8_phase(HA, 1024, (const bf16_t*)(ws + O_W1_0), 1024, 1024, 8, 16, 2, 0, ec, dsm, pbid, pnb); } }
  else if constexpr (ph == 9 || ph == 11) { constexpr int hf = (ph - 9) >> 1;
      EpiRes e{p.in[0], p.in[2], XA, mods0, 5120, 0, hf ? 1.f : ALPHA, hf ? nullptr : (const float*)(ws + O_STATS), p.in[24], p.in[25]};
      gemm8_phase(H1, 2048, (const bf16_t*)(ws + O_W2_0) + (size_t)hf * 2048, 4096, 2048, 64, 4, 1, 0, e, dsm, pbid, pnb);
      if constexpr (hf == 0) { EpiPartial ep{p.out, 0, 1};
        gemm8_phase((const bf16_t*)(ws + O_B + 72 * MiB), 4096, (const bf16_t*)(ws + O_W2_0), 4096, 512, 8, 4, 3, 0, ep, dsm, pbid, pnb, 8); } }
  else if constexpr (ph == 12) phase_ln(p, p.in[28], p.in[29], mods1, 0, 1024, 0, 0, bid, nb, 1);
  else if constexpr (ph == 13) { EpiWin1 e{(bf16_t*)(ws + O_GATE), (bf16_t*)(ws + O_XR)};
      gemm8_phase(HA, 1024, (const bf16_t*)(ws + O_WIN1), 1024, 1024, 72, 8, 0, 0, e, dsm, pbid, pnb); }
  else if constexpr (ph == 14) { for (int u = bid; u < 4608; u += nb) lru_unit(p, u, 1, smem); }
  else if constexpr (ph == 15) phase_lru_carry(p, bid, nb);
  else if constexpr (ph == 16) { for (int u = bid; u < 4608; u += nb) lru_unit(p, u, 2, smem); }
  else if constexpr (ph == 17) { EpiRes e{p.in[0], p.in[2], XA, mods1, 2048, 0, ALPHA, (const float*)(ws + O_STATS), p.in[28], p.in[29]};
      gemm8_phase(HA, 1024, (const bf16_t*)(ws + O_WOUT1), 1024, 1024, 64, 4, 1, 0, e, dsm, pbid, pnb); }
  else if constexpr (ph == 18) phase_ln(p, p.in[41], p.in[42], mods1, 3072, 4096, 1, 0, bid, nb);
  else if constexpr (ph == 19 || ph == 21) { constexpr int hf = (ph - 19) >> 1; EpiMlp1 e{H1};
      gemm8_phase(HA, 1024, (const bf16_t*)(ws + O_W1_1) + (size_t)hf * 2048 * 1024, 1024, 1024, 64, 8, 1, 0, e, dsm, pbid, pnb); }
  else if constexpr (ph == 20 || ph == 22) { constexpr int hf = (ph - 20) >> 1; EpiRes e{p.in[0], p.in[2], XA, mods1, 5120, 0, hf ? 1.f : ALPHA, hf ? nullptr : (const float*)(ws + O_STATS), p.in[41], p.in[42]};
      gemm8_phase(H1, 2048, (const bf16_t*)(ws + O_W2_1) + (size_t)hf * 2048, 4096, 2048, 64, 4, 1, 0, e, dsm, pbid, pnb); }
  else if constexpr (ph == 23) phase_ln(p, p.in[45], p.in[46], mods1, 0, 0, 1, 1, bid, nb);
}

template <int PH, int HI>
DI void run_range(const Params& p, char* smem, char* dsm, int bid, int nb, int pbid, int pnb, const XcdBarrier& xb) {
  run_phase<PH>(p, smem, dsm, bid, nb, pbid, pnb);
  if constexpr (PH < HI) { if constexpr (PH != 3) xcd_barrier(xb); run_range<PH + 1, HI>(p, smem, dsm, bid, nb, pbid, pnb, xb); }
}
constexpr int DYN_LDS = 131072;
template <int LO, int HI>
__global__ void __launch_bounds__(512, 2) mega(Params p) {
  extern __shared__ __attribute__((aligned(16))) char dsm[];
  __shared__ uint4 xb_words;
  XcdBarrier xb; xb.bar = (unsigned*)(p.ws + O_BAR); xb.x = 0; xb.st = (volatile LAS unsigned*)&xb_words;
  if constexpr (LO < HI) {
    if (threadIdx.x == 0) xb_words = make_uint4(0u, 0u, 0u, 0u);
    __syncthreads();
    xb = xcd_barrier_post((unsigned*)(p.ws + O_BAR), (volatile LAS unsigned*)&xb_words);
    if (p.njobs < 0) cg::this_grid().sync();
  }
  const int vb = __builtin_amdgcn_readfirstlane(threadIdx.x >> 8);
  run_range<LO, HI>(p, dsm + vb * SMEM_BYTES, dsm, blockIdx.x * 2 + vb, gridDim.x * 2, blockIdx.x, gridDim.x, xb);
}
template <int PH>
static void launch_split(const Params& p, int grid, hipStream_t stream) {
  (void)hipFuncSetAttribute((const void*)mega<PH, PH>, hipFuncAttributeMaxDynamicSharedMemorySize, DYN_LDS);
  hipLaunchKernelGGL((mega<PH, PH>), dim3(grid), dim3(512), DYN_LDS, stream, p);
  if constexpr (PH + 1 < N_PHASES) launch_split<PH + 1>(p, grid, stream);
}

extern "C" void kernel_launch(void* const* d_in, const int* in_sizes, int n_in, void* d_out, int out_size, void* d_ws, size_t ws_size, hipStream_t stream) {
  static int grid_blocks = 0;
  if (!grid_blocks) {
    int dev = 0, cus = 0, per_cu = 0;
    (void)hipGetDevice(&dev);
    (void)hipDeviceGetAttribute(&cus, hipDeviceAttributeMultiprocessorCount, dev);
    (void)hipFuncSetAttribute((const void*)mega<0, N_PHASES - 1>, hipFuncAttributeMaxDynamicSharedMemorySize, DYN_LDS);
    (void)hipOccupancyMaxActiveBlocksPerMultiprocessor(&per_cu, mega<0, N_PHASES - 1>, 512, DYN_LDS);
    if (per_cu > 1) per_cu = 1;
    if (per_cu < 1) per_cu = 1;
    grid_blocks = cus * per_cu;
  }
  if (n_in != 47 || ws_size < 256 * MiB) { fprintf(stderr, "kernel_launch: bad args n_in %d ws %zu\n", n_in, ws_size); return; }
  Params p; memset(&p, 0, sizeof(p));
  for (int i = 0; i < 47; ++i) p.in[i] = (const float*)d_in[i];
  p.out = (float*)d_out; p.ws = (char*)d_ws;
  char* ws = (char*)d_ws;
  int nj = 0, tiles = 0;
  auto add = [&](int src, size_t soff, size_t dst, int K, int N, int Npad, int nbatch, int scale) {
    CvtJob& J = p.jobs[nj++];
    J.src = (const float*)d_in[src] + soff; J.dst = (bf16_t*)(ws + dst); J.scale = scale >= 0 ? (const float*)d_in[scale] : nullptr;
    J.K = K; J.N = N; J.Npad = Npad; J.nbatch = nbatch; J.tile0 = tiles; J.pad_ = 0;
    tiles += nbatch * (K / 64) * (Npad / 64);
  };
  add(6, 0, O_WIN0, 1024, 2592, 2816, 1, -1);
  add(8, 0, O_WUQ, 384, 768, 768, 1, 7);
  add(10, 0, O_WUK, 256, 512, 512, 1, 9);
  add(11, 0, O_WUV, 256, 512, 512, 1, 9);
  add(14, 0, O_W2T, 64, 512, 512, 2, -1);
  add(16, 0, O_A2T, 64, 512, 512, 2, -1);
  add(17, 0, O_G2T, 128, 512, 512, 1, -1);
  p.ncvt_early = tiles;
  add(23, 0, O_WOUT0, 1024, 1024, 1024, 1, -1);
  add(26, 0, O_W1_0, 1024, 4096, 4096, 1, -1);
  add(27, 0, O_W2_0, 4096, 1024, 1024, 1, -1);
  add(32, 0, O_WIN1, 1024, 2048, 2048, 1, -1);
  add(35, 0, O_GAT, 128, 128, 128, 16, -1);
  add(37, 0, O_GXT, 128, 128, 128, 16, -1);
  add(40, 0, O_WOUT1, 1024, 1024, 1024, 1, -1);
  add(43, 0, O_W1_1, 1024, 4096, 4096, 1, -1);
  add(44, 0, O_W2_1, 4096, 1024, 1024, 1, -1);
  p.njobs = nj; p.ncvt = tiles;
#if N_LAUNCH_SPLIT
  launch_split<0>(p, grid_blocks, stream);
#else
  (void)hipMemsetAsync(ws + O_BAR, 0, XCD_BAR_WORDS * 4, stream);
  void* args[] = {&p};
  hipError_t e = hipLaunchCooperativeKernel((void*)mega<0, N_PHASES - 1>, dim3(grid_blocks), dim3(512), args, DYN_LDS, stream);
  if (e != hipSuccess) fprintf(stderr, "cooperative launch failed: %s (grid %d)\n", hipGetErrorString(e), grid_blocks);
#endif
}
```

```cpp
#include <hip/hip_runtime.h>
#include <hip/hip_cooperative_groups.h>
#include <cstdint>
#include <cstdio>
#include <cstring>
namespace cg = cooperative_groups;

typedef unsigned short bf16_t;
typedef short bf16x8 __attribute__((ext_vector_type(8)));
typedef float f32x2 __attribute__((ext_vector_type(2)));
typedef float f32x4 __attribute__((ext_vector_type(4)));
typedef float f32x16 __attribute__((ext_vector_type(16)));
typedef unsigned u32x2 __attribute__((ext_vector_type(2)));
typedef unsigned u32x4 __attribute__((ext_vector_type(4)));
#define DI __device__ __forceinline__

constexpr int MT = 18432, TB = 2304, NCX = 256;
constexpr size_t MiB = 1u << 20;
constexpr float ALPHA = 1.41421356237f;
constexpr int SMEM_BYTES = 59392;
#ifndef N_LAUNCH_SPLIT
#define N_LAUNCH_SPLIT 0
#endif

constexpr size_t O_WIN0 = 0;
constexpr size_t O_WTAIL = O_WIN0 + (size_t)2560 * 1024 * 2;
constexpr size_t O_WUQ = O_WTAIL + (size_t)256 * 1024 * 2;
constexpr size_t O_WUK = O_WUQ + (size_t)768 * 384 * 2;
constexpr size_t O_WUV = O_WUK + (size_t)512 * 256 * 2;
constexpr size_t O_W2T = O_WUV + (size_t)512 * 256 * 2;
constexpr size_t O_A2T = O_W2T + (size_t)2 * 512 * 64 * 2;
constexpr size_t O_G2T = O_A2T + (size_t)2 * 512 * 64 * 2;
constexpr size_t O_WOUT0 = O_G2T + (size_t)512 * 128 * 2;
constexpr size_t O_W1_0 = O_WOUT0 + (size_t)1024 * 1024 * 2;
constexpr size_t O_W2_0 = O_W1_0 + (size_t)4096 * 1024 * 2;
constexpr size_t O_WIN1 = O_W2_0 + (size_t)4096 * 1024 * 2;
constexpr size_t O_GAT = O_WIN1 + (size_t)2048 * 1024 * 2;
constexpr size_t O_GXT = O_GAT + (size_t)16 * 128 * 128 * 2;
constexpr size_t O_WOUT1 = O_GXT + (size_t)16 * 128 * 128 * 2;
constexpr size_t O_W1_1 = O_WOUT1 + (size_t)1024 * 1024 * 2;
constexpr size_t O_W2_1 = O_W1_1 + (size_t)4096 * 1024 * 2;
constexpr size_t O_MODS = O_W2_1 + (size_t)4096 * 1024 * 2;
constexpr size_t O_ROPE = O_MODS + (size_t)2 * 9 * 6144 * 4;
constexpr size_t O_RSQ = O_ROPE + 4096;
constexpr size_t O_CNT = O_RSQ + (size_t)MT * 2 * 4;
constexpr size_t O_BAR = O_CNT + 256;
constexpr size_t O_STATS = O_BAR + 3456 * 4;
constexpr size_t O_SP = O_STATS + (size_t)MT * 2 * 4;
constexpr size_t O_GLT = O_SP + 2048 * 4;
constexpr size_t O_WEND = O_GLT + (size_t)MT * 32 * 2;
static_assert(O_WEND <= 52 * MiB, "weight region overflow");
constexpr size_t O_A = 52 * MiB;
constexpr size_t O_X = 88 * MiB;
constexpr size_t O_B = 160 * MiB;
constexpr size_t O_FRW = O_X;
constexpr size_t O_FQ = O_FRW + (size_t)MT * 1920 * 2;
constexpr size_t O_FKV = O_FQ + (size_t)MT * 384 * 2;
constexpr size_t O_Q = O_FKV + (size_t)MT * 256 * 2;
constexpr size_t O_K = O_Q + (size_t)MT * 768 * 2;
constexpr size_t O_FKR = O_K + (size_t)MT * 768 * 2;
constexpr size_t O_BON = O_FKR + (size_t)MT * 32 * 4;
static_assert(O_BON + (size_t)2 * MT * 8 * 4 <= 256 * MiB, "mixer region overflow");
constexpr size_t O_GATE = O_B;
constexpr size_t O_XR = O_B + 36 * MiB;
constexpr size_t O_CARRY = O_B + 72 * MiB;
constexpr size_t O_HIN = O_CARRY + 9 * MiB;
constexpr size_t OO_Y = 0;
constexpr size_t OO_VT = 36 * MiB;

struct CvtJob { const float* src; bf16_t* dst; const float* scale; int K, N, Npad, nbatch, tile0, lds; };
struct Params {
  const float* in[47];
  float* out; char* ws;
  CvtJob jobs[20];
  int njobs, ncvt, ncvt_early, pad2_;
};

DI int opaque_tid() { int t = threadIdx.x; asm volatile("" : "+v"(t)); return t; }
#define VT (opaque_tid() & 255)
DI unsigned cvtpk(float lo, float hi) { unsigned r; asm("v_cvt_pk_bf16_f32 %0, %1, %2" : "=v"(r) : "v"(lo), "v"(hi)); return r; }
DI float bf2f(bf16_t b) { return __uint_as_float((unsigned)b << 16); }
DI float lo_f(unsigned w) { return __uint_as_float(w << 16); }
DI float hi_f(unsigned w) { return __uint_as_float(w & 0xffff0000u); }
DI u32x2 pack4(f32x4 v) { u32x2 r; r.x = cvtpk(v[0], v[1]); r.y = cvtpk(v[2], v[3]); return r; }
DI float sigmoidf_(float x) { return __builtin_amdgcn_rcpf(1.f + __expf(-x)); }
DI float tanh_fast(float x) { x = fminf(fmaxf(x, -15.f), 15.f); float t = __expf(2.f * x); return (t - 1.f) * __builtin_amdgcn_rcpf(t + 1.f); }
DI float one_minus_exp(float x) { const float ps = -x * (1.f + x * (0.5f + x * (0.16666667f + x * (0.041666668f + x * (0.0083333338f + x * 0.0013888889f))))); return x > -0.35f ? ps : 1.f - __expf(x); }
DI float gelu_tanh(float x) { float u = 0.7978845608f * (x + 0.044715f * x * x * x); return 0.5f * x * (1.f + tanh_fast(u)); }
template <int CTRL> DI float dppf(float v) { return __int_as_float(__builtin_amdgcn_update_dpp(0, __float_as_int(v), CTRL, 0xF, 0xF, true)); }
DI float red8(float v) { v += dppf<0xB1>(v); v += dppf<0x4E>(v); v += dppf<0x141>(v); return v; }
DI float red16(float v) { v = red8(v); v += dppf<0x140>(v); return v; }
DI f32x4 mfma16(bf16x8 a, bf16x8 b, f32x4 c) { return __builtin_amdgcn_mfma_f32_16x16x32_bf16(a, b, c, 0, 0, 0); }
DI f32x16 mfma32(bf16x8 a, bf16x8 b, f32x16 c) { return __builtin_amdgcn_mfma_f32_32x32x16_bf16(a, b, c, 0, 0, 0); }
DI const float* xrow_in(const Params& p, int row) {
  const int b = row / TB, j = row - b * TB;
  return j < NCX ? p.in[2] + (size_t)(b * NCX + j) * 1024 : p.in[0] + (size_t)(b * 2048 + j - NCX) * 1024;
}
DI int modrow_of(int row) { const int b = row / TB, j = row - b * TB; return j < NCX ? 8 : b; }

DI void p0_misc(const Params& p) {
  const int tid = VT;
  float* rsq = (float*)(p.ws + O_RSQ);
  for (int i = tid; i < MT * 2; i += 256) rsq[i] = 0.f;
  unsigned* cnt = (unsigned*)(p.ws + O_CNT);
  if (tid < 64) cnt[tid] = 0u;
  { float* spt = (float*)(p.ws + O_SP); for (int i = tid; i < 2048; i += 256) spt[i] = 8.f * log1pf(__expf(-p.in[39][i])); }
  float* rope = (float*)(p.ws + O_ROPE);
  for (int i = tid; i < 512; i += 256) {
    const int pos = i >> 3, f = i & 7;
    const float inv = powf(10000.f, -(float)(2 * f) / 16.f);
    const float ang = (float)pos * inv;
    rope[i * 2] = cosf(ang); rope[i * 2 + 1] = sinf(ang);
  }
}
DI void p0_zero_y(const Params& p, int u) {
  f32x4* y = (f32x4*)((char*)p.out + OO_Y) + (size_t)u * 4096;
  const f32x4 z = {0.f, 0.f, 0.f, 0.f};
  for (int i = VT; i < 4096; i += 256) y[i] = z;
}
DI void p0_mods(const Params& p, int u, char* smem) {
  const int tid = VT, layer = u / 192, n0 = (u % 192) * 32;
  float* sl = (float*)smem;
  float* red = sl + 9216;
  const float* c = p.in[1]; const float* cc = p.in[3];
  __syncthreads();
  for (int i = tid; i < 9216; i += 256) { const float v = i < 8192 ? c[i] : cc[i - 8192]; sl[i] = v / (1.f + __expf(-v)); }
  __syncthreads();
  const float* W = p.in[layer ? 30 : 4]; const float* bias = p.in[layer ? 31 : 5];
  const int kg = tid >> 5, cn = tid & 31;
  float acc[9];
#pragma unroll
  for (int r = 0; r < 9; ++r) acc[r] = 0.f;
  const float* wp = W + (size_t)(kg * 128) * 6144 + n0 + cn;
#pragma unroll 1
  for (int k0 = 0; k0 < 128; k0 += 16) {
    float w[16];
#pragma unroll
    for (int q = 0; q < 16; ++q) w[q] = wp[(size_t)(k0 + q) * 6144];
#pragma unroll
    for (int q = 0; q < 16; ++q) {
#pragma unroll
      for (int r = 0; r < 9; ++r) acc[r] += sl[r * 1024 + kg * 128 + k0 + q] * w[q];
    }
  }
#pragma unroll
  for (int r = 0; r < 9; ++r) red[(kg * 9 + r) * 32 + cn] = acc[r];
  __syncthreads();
  float* mods = (float*)(p.ws + O_MODS) + (size_t)layer * 9 * 6144;
  for (int i = tid; i < 288; i += 256) {
    const int r = i >> 5, n = i & 31;
    float sacc = bias[n0 + n];
#pragma unroll
    for (int g = 0; g < 8; ++g) sacc += red[(g * 9 + r) * 32 + n];
    mods[r * 6144 + n0 + n] = sacc;
  }
}
DI void p0_cvt(const Params& p, int t, char* smem) {
  int ji = 0;
  for (int q = 1; q < p.njobs; ++q) if (t >= p.jobs[q].tile0) ji = q;
  const CvtJob& J = p.jobs[ji];
  int lt = t - J.tile0;
  const int tk = J.K >> 6, tn = J.Npad >> 6;
  const int bi = lt / (tk * tn); lt -= bi * tk * tn;
  const int k0 = (lt / tn) * 64, n0 = (lt % tn) * 64;
  const float* src = J.src + (size_t)bi * J.K * J.N;
  bf16_t* dst = J.dst + (size_t)bi * J.Npad * J.K;
  float* tile = (float*)smem;
  const int tid = VT, a = tid >> 6, l = tid & 63;
  __syncthreads();
#pragma unroll 4
  for (int i = 0; i < 16; ++i) {
    const int kk = i * 4 + a, n = n0 + l;
    float v = 0.f;
    if (n < J.N) { v = src[(size_t)(k0 + kk) * J.lds + n]; if (J.scale) v *= J.scale[k0 + kk]; }
    tile[kk * 65 + l] = v;
  }
  __syncthreads();
#pragma unroll 4
  for (int i = 0; i < 16; ++i) {
    const int nn = i * 4 + a;
    dst[(size_t)(n0 + nn) * J.K + k0 + l] = (bf16_t)(cvtpk(tile[l * 65 + nn], 0.f) & 0xffffu);
  }
}
DI void phase0(const Params& p, char* smem, int bid, int nb) {
  const int ncp = (p.ncvt_early + 1) & ~1;
  const int total = 384 + ncp + 2;
  for (int t = bid; t < total; t += nb) {
    if (t < 384) p0_mods(p, t, smem);
    else if (t - 384 < ncp) { if (t - 384 < p.ncvt_early) p0_cvt(p, t - 384, smem); else { __syncthreads(); __syncthreads(); } }
    else { const int z = t - 384 - ncp; if (z == 0) p0_misc(p); }
  }
}

DI void phase_prep_a0(const Params& p, int bid, int nb) {
  const float* mods = (const float*)(p.ws + O_MODS);
  bf16_t* H = (bf16_t*)(p.ws + O_A);
  const int stride = nb * 256;
  for (int i0 = bid * 256 + VT; i0 < MT * 128; i0 += 3 * stride) {
    f32x4 x0[3], x1[3], sh0[3], sh1[3], sc0[3], sc1[3];
#pragma unroll
    for (int q = 0; q < 3; ++q) {
      const int i = i0 + q * stride;
      if (i < MT * 128) {
        const int row = i >> 7, c = (i & 127) * 8;
        const float* src = xrow_in(p, row) + c;
        const float* mp = mods + modrow_of(row) * 6144 + c;
        x0[q] = *(const f32x4*)src; x1[q] = *(const f32x4*)(src + 4);
        sh0[q] = *(const f32x4*)mp; sh1[q] = *(const f32x4*)(mp + 4);
        sc0[q] = *(const f32x4*)(mp + 1024); sc1[q] = *(const f32x4*)(mp + 1028);
      }
    }
#pragma unroll
    for (int q = 0; q < 3; ++q) {
      const int i = i0 + q * stride;
      if (i < MT * 128) {
        const int row = i >> 7, c = (i & 127) * 8;
        const f32x4 y0 = x0[q] * (1.f + sc0[q]) + sh0[q], y1 = x1[q] * (1.f + sc1[q]) + sh1[q];
        u32x4 w; w.x = cvtpk(y0[0], y0[1]); w.y = cvtpk(y0[2], y0[3]); w.z = cvtpk(y1[0], y1[1]); w.w = cvtpk(y1[2], y1[3]);
        *(u32x4*)(H + (size_t)row * 1024 + c) = w;
      }
    }
  }
}

namespace g8 {
constexpr int BM = 256, BK = 64, HALF = 128, HT = HALF * BK, NXCD = 8, WGM = 8;
DI int lds_byte(int r, int c) { const int st = (r >> 4) * 2 + (c >> 5), rr = r & 15, cc = c & 31, ob = rr * 64 + cc * 2; return st * 1024 + (ob ^ (((ob >> 9) & 1) << 5)); }
DI void stage_rc(int b, int& R, int& C) { const int st = b / 1024, sb = b % 1024, swz = sb ^ (((sb >> 9) & 1) << 5); R = (st >> 1) * 16 + swz / 64; C = (st & 1) * 32 + (swz % 64) / 2; }
}
typedef __attribute__((address_space(3))) unsigned char lds_u8;
template <class Epi>
DI void gemm8_phase(const bf16_t* __restrict__ A, int lda, const bf16_t* __restrict__ Bt, int ldb, int K,
                    int nM, int nN, int mode, int base, const Epi& epi, char* dsm, int bid, int nb, int ksplit = 1) {
  using namespace g8;
  constexpr int HTB = HALF * BK * 2;
  lds_u8* lds = (lds_u8*)dsm;
  const int tid = opaque_tid(), wid = __builtin_amdgcn_readfirstlane(tid >> 6), lane = tid & 63, wr = wid >> 2, wc = wid & 3, fr = lane & 15, fq = lane >> 4;
  unsigned voffA[2], voffB[2];
#pragma unroll
  for (int i = 0; i < 2; ++i) { int R, C; stage_rc(tid * 16 + i * 8192, R, C); voffA[i] = (unsigned)(R * lda + C) * 2u; voffB[i] = (unsigned)(R * ldb + C) * 2u; }
  const size_t hstepA = (size_t)HALF * lda * 2, hstepB = (size_t)HALF * ldb * 2;
  const unsigned ldsw = (unsigned)wid * 1024u;
  const int aoff = lds_byte(wr * 64 + fr, fq * 8), boff = lds_byte(wc * 32 + fr, fq * 8);
  #define SA(b,h) (((b)*2+(h))*HTB)
  #define SB(b,h) ((4+(b)*2+(h))*HTB)
  #define STAGE(bufoff,gbase,voff) do{ _Pragma("unroll") for(int _i=0;_i<2;++_i) \
    __builtin_amdgcn_global_load_lds((const unsigned*)((const char*)(gbase)+(voff)[_i]),(__attribute__((address_space(3))) unsigned*)(lds+(bufoff)+ldsw+_i*8192),16,0,0);}while(0)
  #define LDA(dst,b,h) do{ _Pragma("unroll") for(int m=0;m<4;++m) _Pragma("unroll") for(int k=0;k<2;++k) dst[m][k]=*(const __attribute__((address_space(3))) bf16x8*)(lds+SA(b,h)+aoff+m*2048+k*1024);}while(0)
  #define LDB(dst,b,h) do{ _Pragma("unroll") for(int n=0;n<2;++n) _Pragma("unroll") for(int k=0;k<2;++k) dst[n][k]=*(const __attribute__((address_space(3))) bf16x8*)(lds+SB(b,h)+boff+n*2048+k*1024);}while(0)
  #define MMA(ai,bj,At_,Bt_) do{__builtin_amdgcn_s_setprio(1); _Pragma("unroll") for(int m=0;m<4;++m) _Pragma("unroll") for(int n=0;n<2;++n) _Pragma("unroll") for(int k=0;k<2;++k) \
      acc[ai][bj][m][n]=__builtin_amdgcn_mfma_f32_16x16x32_bf16(Bt_[n][k],At_[m][k],acc[ai][bj][m][n],0,0,0); \
    __builtin_amdgcn_s_setprio(0);}while(0)
  #define WAIT_V(n) asm volatile("s_waitcnt vmcnt(" #n ")":::"memory")
  #define WAIT_L(n) asm volatile("s_waitcnt lgkmcnt(" #n ")":::"memory")
  #define BAR __builtin_amdgcn_s_barrier()
  #define SCHED __builtin_amdgcn_sched_barrier(0)
  const int nwt = nM * nN, nwg = nwt * ksplit, nt = K / BK;
  for (int L = bid; L < nwg; L += nb) {
    const int ks = L % ksplit;
    int wgid = L / ksplit;
    { const int q = nwt / NXCD, r = nwt % NXCD, xcd = wgid % NXCD, off = wgid / NXCD; wgid = (xcd < r ? xcd * (q + 1) : r * (q + 1) + (xcd - r) * q) + off; }
    const int nig = WGM * nN, gid = wgid / nig, fm = gid * WGM, gsz = min(nM - fm, WGM);
    const int pm = fm + ((wgid % nig) % gsz), pn = (wgid % nig) / gsz;
    const int brow = mode == 1 ? ((((base + pm) >> 3) * 9 + 1 + ((base + pm) & 7)) * 256) : (mode == 2 ? pm * TB : base + pm * 256);
    const int bcol = pn * BM;
    f32x4 acc[2][2][4][2];
#pragma unroll
    for (int a_ = 0; a_ < 2; ++a_)
#pragma unroll
      for (int b_ = 0; b_ < 2; ++b_)
#pragma unroll
        for (int m = 0; m < 4; ++m)
#pragma unroll
          for (int n = 0; n < 2; ++n) acc[a_][b_][m][n] = (f32x4){0.f, 0.f, 0.f, 0.f};
    bf16x8 At[4][2], B0[2][2], B1[2][2];
    const char* cA = (const char*)(A + (size_t)brow * lda + (size_t)ks * K); const char* cB = (const char*)(Bt + (size_t)bcol * ldb + (size_t)ks * K);
    STAGE(SB(0,0),cB,voffB); STAGE(SA(0,0),cA,voffA); STAGE(SB(0,1),cB+hstepB,voffB); STAGE(SA(0,1),cA+hstepA,voffA);
    if(wr==1)BAR;
    WAIT_V(4); BAR;
    STAGE(SB(1,0),cB+128,voffB); STAGE(SA(1,0),cA+128,voffA); STAGE(SB(1,1),cB+hstepB+128,voffB);
    WAIT_V(6); BAR;
    for(int t=0;t<nt-2;t+=2){
      const char* a1 = cA + (size_t)(t+1)*128; const char* a2 = cA + (size_t)(t+2)*128; const char* a3 = cA + (size_t)(t+3)*128;
      const char* b2 = cB + (size_t)(t+2)*128; const char* b3 = cB + (size_t)(t+3)*128;
      LDB(B0,0,0); SCHED; LDA(At,0,0); STAGE(SA(1,1),a1+hstepA,voffA);
      WAIT_L(8); BAR; WAIT_L(0); MMA(0,0,At,B0); BAR; SCHED;
      LDB(B1,0,1); STAGE(SB(0,0),b2,voffB);
      BAR; WAIT_L(0); MMA(0,1,At,B1); BAR;
      LDA(At,0,1); STAGE(SA(0,0),a2,voffA);
      BAR; WAIT_L(0); MMA(1,0,At,B0); BAR; SCHED;
      STAGE(SB(0,1),b2+hstepB,voffB);
      WAIT_V(6); BAR; MMA(1,1,At,B1); BAR;
      LDB(B0,1,0); SCHED; LDA(At,1,0); STAGE(SA(0,1),a2+hstepA,voffA);
      WAIT_L(8); BAR; WAIT_L(0); MMA(0,0,At,B0); BAR; SCHED;
      LDB(B1,1,1); STAGE(SB(1,0),b3,voffB);
      BAR; WAIT_L(0); MMA(0,1,At,B1); BAR;
      LDA(At,1,1); STAGE(SA(1,0),a3,voffA);
      BAR; WAIT_L(0); MMA(1,0,At,B0); BAR; SCHED;
      STAGE(SB(1,1),b3+hstepB,voffB);
      WAIT_V(6); BAR; MMA(1,1,At,B1); BAR;
    }
    { LDB(B0,0,0); LDA(At,0,0); STAGE(SA(1,1),cA+(size_t)(nt-1)*128+hstepA,voffA);
      BAR; WAIT_L(0); MMA(0,0,At,B0); BAR;
      LDB(B1,0,1); BAR; WAIT_L(0); MMA(0,1,At,B1); BAR;
      LDA(At,0,1); WAIT_V(4); BAR; WAIT_L(0); MMA(1,0,At,B0); MMA(1,1,At,B1); BAR; }
    { LDB(B0,1,0); LDA(At,1,0); WAIT_V(2); BAR; WAIT_L(0); MMA(0,0,At,B0); BAR;
      LDB(B1,1,1); WAIT_V(0); BAR; WAIT_L(0); MMA(0,1,At,B1); BAR;
      LDA(At,1,1); BAR; WAIT_L(0); MMA(1,0,At,B0); MMA(1,1,At,B1); BAR; }
    if(wr==0)BAR;
#pragma unroll
    for (int ai = 0; ai < 2; ++ai)
#pragma unroll
      for (int bj = 0; bj < 2; ++bj) epi(acc[ai][bj], brow + ai * HALF + wr * 64, bcol + bj * HALF + wc * 32 + ks * 1024, fr, fq);
    epi.post(brow, pn);
  }
  #undef SA
  #undef SB
  #undef STAGE
  #undef LDA
  #undef LDB
  #undef MMA
  #undef WAIT_V
  #undef WAIT_L
  #undef BAR
  #undef SCHED
}

struct EpiWin0 {
  bf16_t* FQ; bf16_t* FKV; float* FKR; bf16_t* FRW; float* RSQ;
  template <int NN> DI void operator()(f32x4 (&acc)[4][NN], int rb, int cb, int fr, int fq) const {
    if (cb < 640) {
      const bool isq = cb < 384; bf16_t* dst = isq ? FQ : FKV; const int ld = isq ? 384 : 256; const int co = isq ? cb : cb - 384;
#pragma unroll
      for (int m = 0; m < 4; ++m) {
        const int row = rb + m * 16 + fr; float s = 0.f;
#pragma unroll
        for (int n = 0; n < NN; ++n) {
          const f32x4 v = acc[m][n]; s += v[0] * v[0] + v[1] * v[1] + v[2] * v[2] + v[3] * v[3];
          *(u32x2*)(dst + (size_t)row * ld + co + n * 16 + fq * 4) = pack4(v);
        }
        s += __shfl_xor(s, 16); s += __shfl_xor(s, 32);
        if (fq == 0) atomicAdd(&RSQ[row * 2 + (isq ? 0 : 1)], s);
      }
    } else {
#pragma unroll
      for (int m = 0; m < 4; ++m) {
        const int row = rb + m * 16 + fr;
#pragma unroll
        for (int n = 0; n < NN; ++n) {
          const int cs = cb + n * 16, c = cs + fq * 4;
          if (cs < 672) *(f32x4*)(FKR + (size_t)row * 32 + (c - 640)) = acc[m][n];
          else if (cs < 2592) *(u32x2*)(FRW + (size_t)row * 1920 + (c - 672)) = pack4(acc[m][n]);
        }
      }
    }
  }
  DI void post(int, int) const {}
};
struct EpiQ {
  bf16_t* Q; const float* RSQ; const float* ROPE;
  template <int NN> DI void operator()(f32x4 (&acc)[4][NN], int rb, int cb, int fr, int fq) const {
#pragma unroll
    for (int m = 0; m < 4; ++m) {
      const int row = rb + m * 16 + fr;
      const float rs = rsqrtf(RSQ[row * 2] * (1.f / 384.f) + 1e-6f);
      const int b = row / TB, j = row - b * TB; const bool latent = j >= NCX; const int nl = j - NCX;
#pragma unroll
      for (int n = 0; n < NN; ++n) {
        const int cs = cb + n * 16, within = cs % 96;
        f32x4 v = acc[m][n] * rs;
        if (within >= 64) {
          f32x4 pr;
#pragma unroll
          for (int e = 0; e < 4; ++e) pr[e] = __shfl_xor(v[e], 32);
          if (latent) {
            const int axis = (within - 64) >> 4; const int pos = axis ? (nl & 63) : (nl >> 6);
            const float* tb = ROPE + (pos * 8 + (fq & 1) * 4) * 2;
#pragma unroll
            for (int e = 0; e < 4; ++e) { const float c = tb[e * 2], s = tb[e * 2 + 1]; v[e] = (fq & 2) ? v[e] * c + pr[e] * s : v[e] * c - pr[e] * s; }
          }
        }
        *(u32x2*)(Q + (size_t)row * 768 + cs + fq * 4) = pack4(v);
      }
    }
  }
  DI void post(int, int) const {}
};
struct EpiKn {
  bf16_t* Kb; const float* RSQ; const float* FKR; const float* ROPE;
  template <int NN> DI void operator()(f32x4 (&acc)[4][NN], int rb, int cb, int fr, int fq) const {
#pragma unroll
    for (int m = 0; m < 4; ++m) {
      const int row = rb + m * 16 + fr;
      const float rs = rsqrtf(RSQ[row * 2 + 1] * (1.f / 256.f) + 1e-6f);
#pragma unroll
      for (int n = 0; n < NN; ++n) {
        const int cs = cb + n * 16, hh = cs >> 6, off = (cs & 63) + fq * 4;
        *(u32x2*)(Kb + (size_t)row * 768 + hh * 96 + off) = pack4(acc[m][n] * rs);
      }
    }
  }
  DI void post(int row0, int nt) const {
    if (nt != 0) return;
    const int tid = threadIdx.x, row = row0 + (tid >> 1), axis = tid & 1;
    const int b = row / TB, j = row - b * TB; const bool latent = j >= NCX; const int nl = j - NCX;
    const float* src = FKR + (size_t)row * 32 + axis * 16;
    float x[16];
#pragma unroll
    for (int e = 0; e < 4; ++e) { const f32x4 v = *(const f32x4*)(src + e * 4); x[e * 4] = v[0]; x[e * 4 + 1] = v[1]; x[e * 4 + 2] = v[2]; x[e * 4 + 3] = v[3]; }
    if (latent) {
      const int pos = axis ? (nl & 63) : (nl >> 6);
      const float* tb = ROPE + pos * 16;
#pragma unroll
      for (int f = 0; f < 8; ++f) { const float c = tb[f * 2], s = tb[f * 2 + 1], x1 = x[f], x2 = x[8 + f]; x[f] = x1 * c - x2 * s; x[8 + f] = x2 * c + x1 * s; }
    }
    u32x4 w0, w1;
    w0.x = cvtpk(x[0], x[1]); w0.y = cvtpk(x[2], x[3]); w0.z = cvtpk(x[4], x[5]); w0.w = cvtpk(x[6], x[7]);
    w1.x = cvtpk(x[8], x[9]); w1.y = cvtpk(x[10], x[11]); w1.z = cvtpk(x[12], x[13]); w1.w = cvtpk(x[14], x[15]);
#pragma unroll
    for (int hh = 0; hh < 8; ++hh) { bf16_t* d = Kb + (size_t)row * 768 + hh * 96 + 64 + axis * 16; *(u32x4*)d = w0; *(u32x4*)(d + 8) = w1; }
  }
};
struct EpiVt {
  bf16_t* VTP; const float* RSQ;
  template <int NN> DI void operator()(f32x4 (&acc)[4][NN], int rb, int cb, int fr, int fq) const {
#pragma unroll
    for (int n = 0; n < NN; ++n) {
      const int c = cb + n * 16 + fq * 4;
      f32x4 rs;
#pragma unroll
      for (int e = 0; e < 4; ++e) rs[e] = rsqrtf(RSQ[(c + e) * 2 + 1] * (1.f / 256.f) + 1e-6f);
#pragma unroll
      for (int m = 0; m < 4; ++m) { const int row = rb + m * 16 + fr; *(u32x2*)(VTP + (size_t)row * MT + c) = pack4(acc[m][n] * rs); }
    }
  }
  DI void post(int, int) const {}
};
struct EpiRes {
  const float* xin; const float* cin; float* XA; const float* mods; int goff; int from_input; float alpha;
  const float* stats; const float* lng; const float* lnb;
  template <int NN> DI void operator()(f32x4 (&acc)[4][NN], int rb, int cb, int fr, int fq) const {
#pragma unroll
    for (int m = 0; m < 4; ++m) {
      const int row = rb + m * 16 + fr;
      const float* gp = mods + modrow_of(row) * 6144 + goff;
      const int b_ = row / TB, j_ = row - b_ * TB;
      const float* src = from_input ? (j_ < NCX ? cin + (size_t)(b_ * NCX + j_) * 1024 : xin + (size_t)(b_ * 2048 + j_ - NCX) * 1024) : XA + (size_t)row * 1024;
      float mean = 0.f, rstd = 1.f;
      if (stats) { const f32x2 st = *(const f32x2*)(stats + (size_t)row * 2); mean = st[0]; rstd = st[1]; }
#pragma unroll
      for (int n = 0; n < NN; ++n) {
        const int c = cb + n * 16 + fq * 4;
        f32x4 xv = *(const f32x4*)(src + c); const f32x4 gv = *(const f32x4*)(gp + c);
        if (stats) xv = (xv - mean) * rstd * *(const f32x4*)(lng + c) + *(const f32x4*)(lnb + c);
        *(f32x4*)(XA + (size_t)row * 1024 + c) = alpha * xv + gv * acc[m][n];
      }
    }
  }
  DI void post(int, int) const {}
};
struct EpiPartial {
  float* P; int slot0; int compact;
  template <int NN> DI void operator()(f32x4 (&acc)[4][NN], int rb, int cb, int fr, int fq) const {
    const int ks = cb >> 10, c0 = cb & 1023;
#pragma unroll
    for (int m = 0; m < 4; ++m) {
      const int row = rb + m * 16 + fr, b_ = row / TB, cr = compact ? row : b_ * NCX + (row - b_ * TB);
      float* dst = P + ((size_t)(slot0 + ks) * 2048 + cr) * 1024 + c0 + fq * 4;
#pragma unroll
      for (int n = 0; n < NN; ++n) *(f32x4*)(dst + n * 16) = acc[m][n];
    }
  }
  DI void post(int, int) const {}
};
struct EpiGlt {
  bf16_t* GLT;
  template <int NN> DI void operator()(f32x4 (&acc)[4][NN], int rb, int cb, int fr, int fq) const {
    if (cb >= 32) return;
#pragma unroll
    for (int m = 0; m < 4; ++m) {
      const int row = rb + m * 16 + fr;
#pragma unroll
      for (int n = 0; n < NN; ++n) *(u32x2*)(GLT + (size_t)row * 32 + cb + n * 16 + fq * 4) = pack4(acc[m][n]);
    }
  }
  DI void post(int, int) const {}
};
struct EpiMlp1 {
  bf16_t* H1;
  template <int NN> DI void operator()(f32x4 (&acc)[4][NN], int rb, int cb, int fr, int fq) const {
#pragma unroll
    for (int m = 0; m < 4; ++m) {
      const int row = rb + m * 16 + fr;
#pragma unroll
      for (int n = 0; n < NN; ++n) {
        f32x4 v = acc[m][n];
#pragma unroll
        for (int e = 0; e < 4; ++e) { const float r = fmaxf(v[e], 0.f); v[e] = r * r; }
        *(u32x2*)(H1 + (size_t)row * 2048 + cb + n * 16 + fq * 4) = pack4(v);
      }
    }
  }
  DI void post(int, int) const {}
};
struct EpiMlp1Ctx {
  bf16_t* H1c;
  template <int NN> DI void operator()(f32x4 (&acc)[4][NN], int rb, int cb, int fr, int fq) const {
#pragma unroll
    for (int m = 0; m < 4; ++m) {
      const int row = rb + m * 16 + fr, b_ = row / TB, cr = b_ * NCX + (row - b_ * TB);
#pragma unroll
      for (int n = 0; n < NN; ++n) {
        f32x4 v = acc[m][n];
#pragma unroll
        for (int e = 0; e < 4; ++e) { const float r = fmaxf(v[e], 0.f); v[e] = r * r; }
        *(u32x2*)(H1c + (size_t)cr * 4096 + cb + n * 16 + fq * 4) = pack4(v);
      }
    }
  }
  DI void post(int, int) const {}
};
struct EpiWin1 {
  bf16_t* GATE; bf16_t* XR;
  template <int NN> DI void operator()(f32x4 (&acc)[4][NN], int rb, int cb, int fr, int fq) const {
#pragma unroll
    for (int m = 0; m < 4; ++m) {
      const int row = rb + m * 16 + fr;
#pragma unroll
      for (int n = 0; n < NN; ++n) {
        const int c = cb + n * 16 + fq * 4;
        f32x4 v = acc[m][n];
        if (cb < 1024) {
#pragma unroll
          for (int e = 0; e < 4; ++e) v[e] = gelu_tanh(v[e]);
          *(u32x2*)(GATE + (size_t)row * 1024 + c) = pack4(v);
        } else *(u32x2*)(XR + (size_t)row * 1024 + c - 1024) = pack4(v);
      }
    }
  }
  DI void post(int, int) const {}
};

DI void attn_unit(const Params& p, int u, char* smem) {
  const int tid = VT, lane = tid & 63, wid = tid >> 6, r32 = lane & 31, hi = lane >> 5;
  int b, h, qrow0, nkeys;
  if (u < 1024) { b = u >> 7; h = (u >> 4) & 7; qrow0 = b * TB + NCX + (u & 15) * 128; nkeys = TB; }
  else { const int v = u - 1024; b = v >> 4; h = (v >> 1) & 7; qrow0 = b * TB + (v & 1) * 128; nkeys = NCX; }
  const int key0 = b * TB;
  const bf16_t* Q = (const bf16_t*)(p.ws + O_Q); const bf16_t* Kb = (const bf16_t*)(p.ws + O_K);
  const bf16_t* VTP = (const bf16_t*)((const char*)p.out + OO_VT);
  bf16_t* CAT = (bf16_t*)(p.ws + O_A);
  char* sK = smem; char* sV = smem + 64 * 208;
  const int qrow = qrow0 + wid * 32 + r32;
  bf16x8 qf[6];
  {
    const bf16_t* qp = Q + (size_t)qrow * 768 + h * 96 + hi * 8;
#pragma unroll
    for (int d0 = 0; d0 < 6; ++d0) qf[d0] = *(const bf16x8*)(qp + d0 * 16);
  }
  f32x16 o0, o1;
#pragma unroll
  for (int r = 0; r < 16; ++r) { o0[r] = 0.f; o1[r] = 0.f; }
  float mrun = -1e30f, lrun = 0.f;
  constexpr float C = 0.10206207261596575f * 1.4426950408889634f;
  const bf16_t* gk[3]; int lk[3];
#pragma unroll
  for (int i = 0; i < 3; ++i) { const int c = tid + i * 256, kr = c / 12, kc = c - kr * 12; gk[i] = Kb + (size_t)(key0 + kr) * 768 + h * 96 + kc * 8; lk[i] = kr * 208 + kc * 16; }
  const bf16_t* gv[2]; int lv[2];
#pragma unroll
  for (int i = 0; i < 2; ++i) { const int c = tid + i * 256, vr = c >> 3, vc = c & 7; gv[i] = VTP + (size_t)(h * 64 + vr) * MT + key0 + vc * 8; lv[i] = vr * 144 + vc * 16; }
  u32x4 rk[3], rv[2];
#pragma unroll
  for (int i = 0; i < 3; ++i) rk[i] = *(const u32x4*)(gk[i]);
#pragma unroll
  for (int i = 0; i < 2; ++i) rv[i] = *(const u32x4*)(gv[i]);
  for (int k0 = 0; k0 < nkeys; k0 += 64) {
    __syncthreads();
#pragma unroll
    for (int i = 0; i < 3; ++i) *(u32x4*)(sK + lk[i]) = rk[i];
#pragma unroll
    for (int i = 0; i < 2; ++i) *(u32x4*)(sV + lv[i]) = rv[i];
    __syncthreads();
    if (k0 + 64 < nkeys) {
#pragma unroll
      for (int i = 0; i < 3; ++i) rk[i] = *(const u32x4*)(gk[i] + (size_t)(k0 + 64) * 768);
#pragma unroll
      for (int i = 0; i < 2; ++i) rv[i] = *(const u32x4*)(gv[i] + k0 + 64);
    }
    f32x16 p0, p1;
#pragma unroll
    for (int r = 0; r < 16; ++r) { p0[r] = 0.f; p1[r] = 0.f; }
#pragma unroll
    for (int d0 = 0; d0 < 6; ++d0) {
      const bf16x8 k0f = *(const bf16x8*)(sK + r32 * 208 + d0 * 32 + hi * 16);
      const bf16x8 k1f = *(const bf16x8*)(sK + (32 + r32) * 208 + d0 * 32 + hi * 16);
      p0 = mfma32(k0f, qf[d0], p0); p1 = mfma32(k1f, qf[d0], p1);
    }
    float tmax = p0[0];
#pragma unroll
    for (int r = 1; r < 16; ++r) tmax = fmaxf(tmax, p0[r]);
#pragma unroll
    for (int r = 0; r < 16; ++r) tmax = fmaxf(tmax, p1[r]);
    tmax = fmaxf(tmax, __shfl_xor(tmax, 32));
    const float mn = fmaxf(mrun, tmax);
    const float alpha = exp2f((mrun - mn) * C);
    mrun = mn;
    const float mc = -mn * C;
    float ps = 0.f;
#pragma unroll
    for (int r = 0; r < 16; ++r) { p0[r] = exp2f(fmaf(p0[r], C, mc)); ps += p0[r]; }
#pragma unroll
    for (int r = 0; r < 16; ++r) { p1[r] = exp2f(fmaf(p1[r], C, mc)); ps += p1[r]; }
    ps += __shfl_xor(ps, 32);
    lrun = lrun * alpha + ps;
#pragma unroll
    for (int r = 0; r < 16; ++r) { o0[r] *= alpha; o1[r] *= alpha; }
#pragma unroll
    for (int ks = 0; ks < 4; ++ks) {
      u32x4 pw;
      if (ks == 0) { pw.x = cvtpk(p0[0], p0[1]); pw.y = cvtpk(p0[2], p0[3]); pw.z = cvtpk(p0[4], p0[5]); pw.w = cvtpk(p0[6], p0[7]); }
      else if (ks == 1) { pw.x = cvtpk(p0[8], p0[9]); pw.y = cvtpk(p0[10], p0[11]); pw.z = cvtpk(p0[12], p0[13]); pw.w = cvtpk(p0[14], p0[15]); }
      else if (ks == 2) { pw.x = cvtpk(p1[0], p1[1]); pw.y = cvtpk(p1[2], p1[3]); pw.z = cvtpk(p1[4], p1[5]); pw.w = cvtpk(p1[6], p1[7]); }
      else { pw.x = cvtpk(p1[8], p1[9]); pw.y = cvtpk(p1[10], p1[11]); pw.z = cvtpk(p1[12], p1[13]); pw.w = cvtpk(p1[14], p1[15]); }
      const bf16x8 pf = *(const bf16x8*)&pw;
      const int kb = ks * 16 + hi * 4;
      u32x4 va, vb;
      { const u32x2 a0 = *(const u32x2*)(sV + r32 * 144 + kb * 2), a1 = *(const u32x2*)(sV + r32 * 144 + (kb + 8) * 2); va.x = a0.x; va.y = a0.y; va.z = a1.x; va.w = a1.y; }
      { const u32x2 a0 = *(const u32x2*)(sV + (32 + r32) * 144 + kb * 2), a1 = *(const u32x2*)(sV + (32 + r32) * 144 + (kb + 8) * 2); vb.x = a0.x; vb.y = a0.y; vb.z = a1.x; vb.w = a1.y; }
      o0 = mfma32(*(const bf16x8*)&va, pf, o0);
      o1 = mfma32(*(const bf16x8*)&vb, pf, o1);
    }
  }
  const float inv = 1.f / lrun;
  bf16_t* op = CAT + (size_t)qrow * 1024 + h * 64 + hi * 4;
#pragma unroll
  for (int g = 0; g < 4; ++g) {
    u32x2 w; w.x = cvtpk(o0[g * 4] * inv, o0[g * 4 + 1] * inv); w.y = cvtpk(o0[g * 4 + 2] * inv, o0[g * 4 + 3] * inv);
    *(u32x2*)(op + g * 8) = w;
    w.x = cvtpk(o1[g * 4] * inv, o1[g * 4 + 1] * inv); w.y = cvtpk(o1[g * 4 + 2] * inv, o1[g * 4 + 3] * inv);
    *(u32x2*)(op + 32 + g * 8) = w;
  }
}

DI void unpack8(u32x4 w, float* f) {
  f[0] = lo_f(w.x); f[1] = hi_f(w.x); f[2] = lo_f(w.y); f[3] = hi_f(w.y); f[4] = lo_f(w.z); f[5] = hi_f(w.z); f[6] = lo_f(w.w); f[7] = hi_f(w.w);
}
DI int scan_row(int d, int gi) { return d == 0 ? gi : (gi < NCX ? NCX - 1 - gi : TB - 1 - (gi - NCX)); }
DI void scan_unit(const Params& p, int u, char* smem) {
  const int tid = VT, lane = tid & 63, wid = tid >> 6, fr = lane & 15, fq = lane >> 4;
  const int half = u & 1, d = (u >> 1) & 1, h = (u >> 2) & 7, b = u >> 5;
  float* R_ = (float*)smem; float* KD_ = R_ + 2048; float* KK_ = KD_ + 2048; float* WD_ = KK_ + 2048; float* BV_ = WD_ + 2048;
  float* V_ = BV_ + 2048; float* YO_ = V_ + 1024; char* TW_ = (char*)(YO_ + 1024); char* AL_ = TW_ + 32 * 144;
  float* NRM_ = (float*)(AL_ + 32 * 144); float* BONS_ = NRM_ + 32;
  const bf16_t* FRW = (const bf16_t*)(p.ws + O_FRW);
  const float* mu = p.in[12];
  float* Y = (float*)((char*)p.out + OO_Y);
  float* BON = (float*)(p.ws + O_BON);
  const int hc = h * 64 + wid * 16 + fr;
  bf16x8 w2f0, w2f1, a2f0, a2f1;
  {
    const bf16_t* w2t = (const bf16_t*)(p.ws + O_W2T) + (size_t)(d * 512 + hc) * 64 + fq * 8;
    const bf16_t* a2t = (const bf16_t*)(p.ws + O_A2T) + (size_t)(d * 512 + hc) * 64 + fq * 8;
    w2f0 = *(const bf16x8*)w2t; w2f1 = *(const bf16x8*)(w2t + 32);
    a2f0 = *(const bf16x8*)a2t; a2f1 = *(const bf16x8*)(a2t + 32);
  }
  const float w0c = p.in[13][d * 512 + hc], a0c = p.in[15][d * 512 + hc], kkc = p.in[18][hc], kac = p.in[19][hc], rkc = p.in[20][hc];
  const int il = tid >> 3, js = tid & 7;
  f32x2 S0 = {0.f, 0.f}, S1 = {0.f, 0.f}, S2 = {0.f, 0.f}, S3 = {0.f, 0.f};
  if (tid < 32) { NRM_[tid] = 0.f; BONS_[tid] = 0.f; }
  __syncthreads();
  for (int ci = 0; ci < 72; ++ci) {
    for (int it = tid; it < 1152; it += 256) {
      const int s = it / 36, g = it - s * 36;
      const int j = scan_row(d, ci * 32 + s);
      const size_t row = (size_t)b * TB + j;
      int col;
      if (g < 8) col = h * 64 + g * 8; else if (g < 16) col = 512 + h * 64 + (g - 8) * 8; else if (g < 20) col = 1024 + h * 64 + half * 32 + (g - 16) * 8;
      else if (g < 28) col = 1536 + d * 64 + (g - 20) * 8; else col = 1664 + d * 64 + (g - 28) * 8;
      const bool pv = (j != 0 && j != NCX), nv = (j != NCX - 1 && j != TB - 1);
      const u32x4 z4 = {0u, 0u, 0u, 0u};
      const u32x4 fc = *(const u32x4*)(FRW + row * 1920 + col);
      const u32x4 fp = pv ? *(const u32x4*)(FRW + (row - 1) * 1920 + col) : z4;
      const u32x4 fn = nv ? *(const u32x4*)(FRW + (row + 1) * 1920 + col) : z4;
      float xc[8], xp[8], xn[8], xs[8], mm[8];
      unpack8(fc, xc); unpack8(fp, xp); unpack8(fn, xn);
      { const f32x4 m0 = *(const f32x4*)(mu + col), m1 = *(const f32x4*)(mu + col + 4); mm[0] = m0[0]; mm[1] = m0[1]; mm[2] = m0[2]; mm[3] = m0[3]; mm[4] = m1[0]; mm[5] = m1[1]; mm[6] = m1[2]; mm[7] = m1[3]; }
#pragma unroll
      for (int e = 0; e < 8; ++e) xs[e] = xc[e] + mm[e] * (0.5f * (xp[e] + xn[e]) - xc[e]);
      if (g < 16) {
        float* dst = (g < 8 ? R_ + s * 64 + g * 8 : KD_ + s * 64 + (g - 8) * 8);
        *(f32x4*)dst = (f32x4){xs[0], xs[1], xs[2], xs[3]}; *(f32x4*)(dst + 4) = (f32x4){xs[4], xs[5], xs[6], xs[7]};
        if (g >= 8) {
          const float* kkp = p.in[18] + h * 64 + (g - 8) * 8; float sq = 0.f;
#pragma unroll
          for (int e = 0; e < 8; ++e) { const float t = xs[e] * kkp[e]; sq += t * t; }
          atomicAdd(&NRM_[s], sq);
        }
      } else if (g < 20) {
        float* dst = V_ + s * 32 + (g - 16) * 8;
        *(f32x4*)dst = (f32x4){xs[0], xs[1], xs[2], xs[3]}; *(f32x4*)(dst + 4) = (f32x4){xs[4], xs[5], xs[6], xs[7]};
      } else if (g < 28) {
        u32x4 w; w.x = cvtpk(tanh_fast(xs[0]), tanh_fast(xs[1])); w.y = cvtpk(tanh_fast(xs[2]), tanh_fast(xs[3])); w.z = cvtpk(tanh_fast(xs[4]), tanh_fast(xs[5])); w.w = cvtpk(tanh_fast(xs[6]), tanh_fast(xs[7]));
        *(u32x4*)(TW_ + s * 144 + (g - 20) * 16) = w;
      } else {
        u32x4 w; w.x = cvtpk(xs[0], xs[1]); w.y = cvtpk(xs[2], xs[3]); w.z = cvtpk(xs[4], xs[5]); w.w = cvtpk(xs[6], xs[7]);
        *(u32x4*)(AL_ + s * 144 + (g - 28) * 16) = w;
      }
    }
    __syncthreads();
    {
#pragma unroll
      for (int m = 0; m < 2; ++m) {
        f32x4 accw = {0.f, 0.f, 0.f, 0.f}, acca = {0.f, 0.f, 0.f, 0.f};
        const bf16x8 t0 = *(const bf16x8*)(TW_ + (m * 16 + fr) * 144 + fq * 16), t1 = *(const bf16x8*)(TW_ + (m * 16 + fr) * 144 + 64 + fq * 16);
        const bf16x8 l0 = *(const bf16x8*)(AL_ + (m * 16 + fr) * 144 + fq * 16), l1 = *(const bf16x8*)(AL_ + (m * 16 + fr) * 144 + 64 + fq * 16);
        accw = mfma16(t0, w2f0, accw); accw = mfma16(t1, w2f1, accw);
        acca = mfma16(l0, a2f0, acca); acca = mfma16(l1, a2f1, acca);
#pragma unroll
        for (int e = 0; e < 4; ++e) {
          const int s = m * 16 + fq * 4 + e, idx = s * 64 + wid * 16 + fr;
          const float sg = sigmoidf_(w0c + accw[e]);
          const float decay = __expf(-0.6065306597126334f * sg);
          const float a = sigmoidf_(a0c + acca[e]);
          const float kraw = KD_[idx];
          const float kkn = kraw * kkc * rsqrtf(NRM_[s] + 1e-12f);
          KK_[idx] = kkn; WD_[idx] = decay; BV_[idx] = kkn * a;
          const float kd = kraw * (1.f + (a - 1.f) * kac);
          KD_[idx] = kd;
          float bon = R_[idx] * kd * rkc;
          bon = red16(bon);
          if (fr == 0) atomicAdd(&BONS_[s], bon);
        }
      }
    }
    __syncthreads();
    if (tid < 32) {
      if (half == 0) { const int j = scan_row(d, ci * 32 + tid); BON[((size_t)d * MT + (size_t)b * TB + j) * 8 + h] = BONS_[tid]; }
      BONS_[tid] = 0.f; NRM_[tid] = 0.f;
    }
#pragma unroll 2
    for (int s = 0; s < 32; ++s) {
      const f32x4* pk = (const f32x4*)(KK_ + s * 64 + js * 8); const f32x4 ka = pk[0], kb = pk[1];
      const f32x4* pw = (const f32x4*)(WD_ + s * 64 + js * 8); const f32x4 wa = pw[0], wb = pw[1];
      const f32x4* pb = (const f32x4*)(BV_ + s * 64 + js * 8); const f32x4 ba = pb[0], bb = pb[1];
      const f32x4* pd = (const f32x4*)(KD_ + s * 64 + js * 8); const f32x4 da = pd[0], db = pd[1];
      const f32x4* pr = (const f32x4*)(R_ + s * 64 + js * 8); const f32x4 ra = pr[0], rb = pr[1];
      const float v = V_[s * 32 + il];
      f32x2 t = S0 * (f32x2){ka[0], ka[1]} + S1 * (f32x2){ka[2], ka[3]};
      f32x2 t2 = S2 * (f32x2){kb[0], kb[1]} + S3 * (f32x2){kb[2], kb[3]};
      t = t + t2;
      const float sa = red8(t[0] + t[1]);
      const f32x2 nsa = {-sa, -sa}, vv = {v, v};
      S0 = S0 * (f32x2){wa[0], wa[1]} + nsa * (f32x2){ba[0], ba[1]} + vv * (f32x2){da[0], da[1]};
      S1 = S1 * (f32x2){wa[2], wa[3]} + nsa * (f32x2){ba[2], ba[3]} + vv * (f32x2){da[2], da[3]};
      S2 = S2 * (f32x2){wb[0], wb[1]} + nsa * (f32x2){bb[0], bb[1]} + vv * (f32x2){db[0], db[1]};
      S3 = S3 * (f32x2){wb[2], wb[3]} + nsa * (f32x2){bb[2], bb[3]} + vv * (f32x2){db[2], db[3]};
      f32x2 y = S0 * (f32x2){ra[0], ra[1]} + S1 * (f32x2){ra[2], ra[3]};
      f32x2 y2 = S2 * (f32x2){rb[0], rb[1]} + S3 * (f32x2){rb[2], rb[3]};
      y = y + y2;
      const float yy = red8(y[0] + y[1]);
      if (js == 0) YO_[s * 32 + il] = yy;
    }
    __syncthreads();
    {
      const int s = tid >> 3, i4 = (tid & 7) * 4;
      const int j = scan_row(d, ci * 32 + s);
      float* yp = Y + ((size_t)b * TB + j) * 512 + h * 64 + half * 32 + i4;
      const f32x4 yv = *(const f32x4*)(YO_ + s * 32 + i4);
      atomicAdd(yp, yv[0]); atomicAdd(yp + 1, yv[1]); atomicAdd(yp + 2, yv[2]); atomicAdd(yp + 3, yv[3]);
    }
  }
  __syncthreads();
}

DI void scan_unit8(const Params& p, int u, char* dsm) {
  const int tid = opaque_tid(), lane = tid & 63, wid = __builtin_amdgcn_readfirstlane(tid >> 6), fr = lane & 15, fq = lane >> 4;
  const int d = u & 1, h = (u >> 1) & 7, b = u >> 4;
  const bool producer = wid >= 4;
  float* FB = (float*)dsm;
  float* YO = FB + 2 * 12288;
  char* TW_ = (char*)(YO + 2 * 2048); char* AL_ = TW_ + 32 * 144;
  float* NRM = (float*)(AL_ + 32 * 144); float* BONS = NRM + 64;
  const bf16_t* FRW = (const bf16_t*)(p.ws + O_FRW);
  const float* mu = p.in[12];
  float* Y = (float*)((char*)p.out + OO_Y);
  float* BON = (float*)(p.ws + O_BON);
  const int pt = tid & 255, pw = wid & 3;
  const int hc = h * 64 + pw * 16 + fr;
  bf16x8 w2f0, w2f1, a2f0, a2f1;
  {
    const bf16_t* w2t = (const bf16_t*)(p.ws + O_W2T) + (size_t)(d * 512 + hc) * 64 + fq * 8;
    const bf16_t* a2t = (const bf16_t*)(p.ws + O_A2T) + (size_t)(d * 512 + hc) * 64 + fq * 8;
    w2f0 = *(const bf16x8*)w2t; w2f1 = *(const bf16x8*)(w2t + 32);
    a2f0 = *(const bf16x8*)a2t; a2f1 = *(const bf16x8*)(a2t + 32);
  }
  const float w0c = p.in[13][d * 512 + hc], a0c = p.in[15][d * 512 + hc], kkc = p.in[18][hc], kac = p.in[19][hc], rkc = p.in[20][hc];
  const int rp = pt >> 3, js = pt & 7;
  f32x2 Sa0 = {0.f, 0.f}, Sa1 = {0.f, 0.f}, Sa2 = {0.f, 0.f}, Sa3 = {0.f, 0.f};
  f32x2 Sb0 = {0.f, 0.f}, Sb1 = {0.f, 0.f}, Sb2 = {0.f, 0.f}, Sb3 = {0.f, 0.f};
  __syncthreads();
  if (tid < 64) { NRM[tid] = 0.f; BONS[tid] = 0.f; }
  __syncthreads();

  auto S1 = [&](int ci) {
    float* F = FB + (ci & 1) * 12288; float* nrm = NRM + (ci & 1) * 32;
    u32x4 fc[5], fp[5], fn[5];
#pragma unroll
    for (int k = 0; k < 5; ++k) {
      const int it = pt + k * 256, s = it / 40, g = it - s * 40;
      const int j = scan_row(d, ci * 32 + s);
      const size_t row = (size_t)b * TB + j;
      const int col = (g < 24 ? (g >> 3) * 512 + h * 64 + (g & 7) * 8 : (g < 32 ? 1536 + d * 64 + (g - 24) * 8 : 1664 + d * 64 + (g - 32) * 8));
      const bool pv = (j != 0 && j != NCX), nv = (j != NCX - 1 && j != TB - 1);
      const u32x4 z4 = {0u, 0u, 0u, 0u};
      fc[k] = *(const u32x4*)(FRW + row * 1920 + col);
      fp[k] = pv ? *(const u32x4*)(FRW + (row - 1) * 1920 + col) : z4;
      fn[k] = nv ? *(const u32x4*)(FRW + (row + 1) * 1920 + col) : z4;
    }
#pragma unroll
    for (int k = 0; k < 5; ++k) {
      const int it = pt + k * 256, s = it / 40, g = it - s * 40;
      const int col = (g < 24 ? (g >> 3) * 512 + h * 64 + (g & 7) * 8 : (g < 32 ? 1536 + d * 64 + (g - 24) * 8 : 1664 + d * 64 + (g - 32) * 8));
      float xc[8], xp[8], xn[8], xs[8], mm[8];
      unpack8(fc[k], xc); unpack8(fp[k], xp); unpack8(fn[k], xn);
      { const f32x4 m0 = *(const f32x4*)(mu + col), m1 = *(const f32x4*)(mu + col + 4); mm[0] = m0[0]; mm[1] = m0[1]; mm[2] = m0[2]; mm[3] = m0[3]; mm[4] = m1[0]; mm[5] = m1[1]; mm[6] = m1[2]; mm[7] = m1[3]; }
#pragma unroll
      for (int e = 0; e < 8; ++e) xs[e] = xc[e] + mm[e] * (0.5f * (xp[e] + xn[e]) - xc[e]);
      if (g < 24) {
        float* dst = (g < 8 ? F + s * 64 + g * 8 : (g < 16 ? F + 2048 + s * 64 + (g - 8) * 8 : F + 10240 + s * 64 + (g - 16) * 8));
        *(f32x4*)dst = (f32x4){xs[0], xs[1], xs[2], xs[3]}; *(f32x4*)(dst + 4) = (f32x4){xs[4], xs[5], xs[6], xs[7]};
        if (g >= 8 && g < 16) {
          const float* kkp = p.in[18] + h * 64 + (g - 8) * 8; float sq = 0.f;
#pragma unroll
          for (int e = 0; e < 8; ++e) { const float t = xs[e] * kkp[e]; sq += t * t; }
          atomicAdd(&nrm[s], sq);
        }
      } else if (g < 32) {
        u32x4 w; w.x = cvtpk(tanh_fast(xs[0]), tanh_fast(xs[1])); w.y = cvtpk(tanh_fast(xs[2]), tanh_fast(xs[3])); w.z = cvtpk(tanh_fast(xs[4]), tanh_fast(xs[5])); w.w = cvtpk(tanh_fast(xs[6]), tanh_fast(xs[7]));
        *(u32x4*)(TW_ + s * 144 + (g - 24) * 16) = w;
      } else {
        u32x4 w; w.x = cvtpk(xs[0], xs[1]); w.y = cvtpk(xs[2], xs[3]); w.z = cvtpk(xs[4], xs[5]); w.w = cvtpk(xs[6], xs[7]);
        *(u32x4*)(AL_ + s * 144 + (g - 32) * 16) = w;
      }
    }
  };
  auto S2 = [&](int ci) {
    float* F = FB + (ci & 1) * 12288; float* R_ = F; float* KD_ = F + 2048; float* KK_ = F + 4096; float* WD_ = F + 6144; float* BV_ = F + 8192;
    const float* nrm = NRM + (ci & 1) * 32; float* bons = BONS + (ci & 1) * 32;
#pragma unroll
    for (int m = 0; m < 2; ++m) {
      f32x4 accw = {0.f, 0.f, 0.f, 0.f}, acca = {0.f, 0.f, 0.f, 0.f};
      const bf16x8 t0 = *(const bf16x8*)(TW_ + (m * 16 + fr) * 144 + fq * 16), t1 = *(const bf16x8*)(TW_ + (m * 16 + fr) * 144 + 64 + fq * 16);
      const bf16x8 l0 = *(const bf16x8*)(AL_ + (m * 16 + fr) * 144 + fq * 16), l1 = *(const bf16x8*)(AL_ + (m * 16 + fr) * 144 + 64 + fq * 16);
      accw = mfma16(t0, w2f0, accw); accw = mfma16(t1, w2f1, accw);
      acca = mfma16(l0, a2f0, acca); acca = mfma16(l1, a2f1, acca);
#pragma unroll
      for (int e = 0; e < 4; ++e) {
        const int s = m * 16 + fq * 4 + e, idx = s * 64 + pw * 16 + fr;
        const float sg = sigmoidf_(w0c + accw[e]);
        const float decay = __expf(-0.6065306597126334f * sg);
        const float a = sigmoidf_(a0c + acca[e]);
        const float kraw = KD_[idx];
        const float kkn = kraw * kkc * rsqrtf(nrm[s] + 1e-12f);
        KK_[idx] = kkn; WD_[idx] = decay; BV_[idx] = kkn * a;
        const float kd = kraw * (1.f + (a - 1.f) * kac);
        KD_[idx] = kd;
        float bon = R_[idx] * kd * rkc;
        bon = red16(bon);
        if (fr == 0) atomicAdd(&bons[s], bon);
      }
    }
    if (pt < 32) NRM[((ci & 1) ^ 1) * 32 + pt] = 0.f;
  };
  struct StepVec { f32x4 ra, rb, da, db, ka, kb, wa, wb, ba, bb; f32x2 v2; };
  auto LOADV = [&](StepVec& X, const float* F, int s) {
    const f32x4* pr = (const f32x4*)(F + s * 64 + js * 8); X.ra = pr[0]; X.rb = pr[1];
    const f32x4* pd = (const f32x4*)(F + 2048 + s * 64 + js * 8); X.da = pd[0]; X.db = pd[1];
    const f32x4* pk = (const f32x4*)(F + 4096 + s * 64 + js * 8); X.ka = pk[0]; X.kb = pk[1];
    const f32x4* pw_ = (const f32x4*)(F + 6144 + s * 64 + js * 8); X.wa = pw_[0]; X.wb = pw_[1];
    const f32x4* pb = (const f32x4*)(F + 8192 + s * 64 + js * 8); X.ba = pb[0]; X.bb = pb[1];
    X.v2 = *(const f32x2*)(F + 10240 + s * 64 + rp * 2);
  };
  auto STEP = [&](const StepVec& X, float* yo, int s) {
    const f32x2 k01 = {X.ka[0], X.ka[1]}, k23 = {X.ka[2], X.ka[3]}, k45 = {X.kb[0], X.kb[1]}, k67 = {X.kb[2], X.kb[3]};
    f32x2 ta = Sa0 * k01 + Sa1 * k23; ta = ta + (Sa2 * k45 + Sa3 * k67);
    f32x2 tb = Sb0 * k01 + Sb1 * k23; tb = tb + (Sb2 * k45 + Sb3 * k67);
    const float saa = red8(ta[0] + ta[1]), sab = red8(tb[0] + tb[1]);
    const f32x2 w01 = {X.wa[0], X.wa[1]}, w23 = {X.wa[2], X.wa[3]}, w45 = {X.wb[0], X.wb[1]}, w67 = {X.wb[2], X.wb[3]};
    const f32x2 b01 = {X.ba[0], X.ba[1]}, b23 = {X.ba[2], X.ba[3]}, b45 = {X.bb[0], X.bb[1]}, b67 = {X.bb[2], X.bb[3]};
    const f32x2 d01 = {X.da[0], X.da[1]}, d23 = {X.da[2], X.da[3]}, d45 = {X.db[0], X.db[1]}, d67 = {X.db[2], X.db[3]};
    { const f32x2 ns = {-saa, -saa}, vv = {X.v2[0], X.v2[0]};
      Sa0 = Sa0 * w01 + ns * b01 + vv * d01; Sa1 = Sa1 * w23 + ns * b23 + vv * d23; Sa2 = Sa2 * w45 + ns * b45 + vv * d45; Sa3 = Sa3 * w67 + ns * b67 + vv * d67; }
    { const f32x2 ns = {-sab, -sab}, vv = {X.v2[1], X.v2[1]};
      Sb0 = Sb0 * w01 + ns * b01 + vv * d01; Sb1 = Sb1 * w23 + ns * b23 + vv * d23; Sb2 = Sb2 * w45 + ns * b45 + vv * d45; Sb3 = Sb3 * w67 + ns * b67 + vv * d67; }
    const f32x2 r01 = {X.ra[0], X.ra[1]}, r23 = {X.ra[2], X.ra[3]}, r45 = {X.rb[0], X.rb[1]}, r67 = {X.rb[2], X.rb[3]};
    f32x2 ya = Sa0 * r01 + Sa1 * r23; ya = ya + (Sa2 * r45 + Sa3 * r67);
    f32x2 yb = Sb0 * r01 + Sb1 * r23; yb = yb + (Sb2 * r45 + Sb3 * r67);
    const float y0 = red8(ya[0] + ya[1]), y1 = red8(yb[0] + yb[1]);
    if (js == 0) *(f32x2*)(yo + s * 64 + rp * 2) = (f32x2){y0, y1};
  };
  auto SCAN = [&](int ci, int s0) {
    const float* F = FB + (ci & 1) * 12288; float* yo = YO + (ci & 1) * 2048;
    StepVec A, B;
    LOADV(A, F, s0);
#pragma unroll 1
    for (int s = s0; s < s0 + 16; s += 2) {
      LOADV(B, F, s + 1);
      STEP(A, yo, s);
      LOADV(A, F, s + 2);
      STEP(B, yo, s + 1);
    }
  };

  if (producer) S1(0);
  __syncthreads();
  if (producer) S2(0);
  __syncthreads();
  for (int ci = 0; ci < 72; ++ci) {
    if (producer) {
      if (pt < 32) { float* bons = BONS + (ci & 1) * 32; const int j = scan_row(d, ci * 32 + pt); BON[((size_t)d * MT + (size_t)b * TB + j) * 8 + h] = bons[pt]; bons[pt] = 0.f; }
      if (ci + 1 < 72) S1(ci + 1);
    } else SCAN(ci, 0);
    __syncthreads();
    if (producer) { if (ci + 1 < 72) S2(ci + 1); }
    else SCAN(ci, 16);
    __syncthreads();
    if (!producer) {
      const float* yo = YO + (ci & 1) * 2048;
      const int s = pt >> 3, i8 = (pt & 7) * 8;
      const int j = scan_row(d, ci * 32 + s);
      bf16_t* yp = (bf16_t*)((char*)p.out + OO_Y) + (size_t)d * MT * 512 + ((size_t)b * TB + j) * 512 + h * 64 + i8;
      const f32x4 y0 = *(const f32x4*)(yo + s * 64 + i8), y1 = *(const f32x4*)(yo + s * 64 + i8 + 4);
      u32x4 w; w.x = cvtpk(y0[0], y0[1]); w.y = cvtpk(y0[2], y0[3]); w.z = cvtpk(y1[0], y1[1]); w.w = cvtpk(y1[2], y1[3]);
      *(u32x4*)yp = w;
    }
  }
  __syncthreads();
}

DI unsigned sb_ld(unsigned* q) { return __hip_atomic_load(q, __ATOMIC_RELAXED, __HIP_MEMORY_SCOPE_AGENT); }
DI void qkv_work(const Params& p, char* dsm, int b3, int n3) {
  char* ws = p.ws;
  EpiQ eq{(bf16_t*)(ws + O_Q), (const float*)(ws + O_RSQ), (const float*)(ws + O_ROPE)};
  gemm8_phase((const bf16_t*)(ws + O_FQ), 384, (const bf16_t*)(ws + O_WUQ), 384, 384, 72, 3, 0, 0, eq, dsm, b3, n3);
  EpiKn ek{(bf16_t*)(ws + O_K), (const float*)(ws + O_RSQ), (const float*)(ws + O_FKR), (const float*)(ws + O_ROPE)};
  gemm8_phase((const bf16_t*)(ws + O_FKV), 256, (const bf16_t*)(ws + O_WUK), 256, 256, 72, 2, 0, 0, ek, dsm, (b3 + n3 - (216 % n3)) % n3, n3);
  EpiVt ev{(bf16_t*)((char*)p.out + OO_VT), (const float*)(ws + O_RSQ)};
  gemm8_phase((const bf16_t*)(ws + O_WUV), 256, (const bf16_t*)(ws + O_FKV), 256, 256, 2, 72, 0, 0, ev, dsm, (b3 + n3 - (104 % n3)) % n3, n3);
  EpiGlt eg{(bf16_t*)(ws + O_GLT)};
  gemm8_phase((const bf16_t*)(ws + O_A), 1024, (const bf16_t*)(ws + O_WTAIL), 1024, 1024, 72, 1, 0, 0, eg, dsm, (b3 + n3 - (16 % n3)) % n3, n3);
}
DI void phase_mixer(const Params& p, char* smem, char* dsm, int bid, int nb) {
  unsigned* cnt = (unsigned*)(p.ws + O_CNT);
  const int pbid = blockIdx.x, pnb = gridDim.x;
  const int q0 = pnb >= 192 ? 128 : 0, nq = pnb - q0;
  if (pbid >= q0) {
    qkv_work(p, dsm, pbid - q0, nq);
    asm volatile("s_waitcnt vmcnt(0)" ::: "memory");
    __syncthreads();
    if (threadIdx.x == 0) {
      __builtin_amdgcn_fence(__ATOMIC_RELEASE, "agent");
      asm volatile("s_waitcnt vmcnt(0)" ::: "memory");
      __hip_atomic_fetch_add(cnt + 8, 1u, __ATOMIC_RELAXED, __HIP_MEMORY_SCOPE_AGENT);
    }
  }
  for (int u = pbid; u < 128; u += pnb) scan_unit8(p, u, dsm);
  __syncthreads();
  if (threadIdx.x == 0) {
    unsigned sp = 0;
    while (sb_ld(cnt + 8) < (unsigned)nq) { __builtin_amdgcn_s_sleep(2); if (++sp > (1u << 23)) break; }
    __builtin_amdgcn_fence(__ATOMIC_ACQUIRE, "agent");
    asm volatile("s_waitcnt vmcnt(0)" ::: "memory");
  }
  __syncthreads();
  int* slot = (int*)(dsm + 2 * SMEM_BYTES);
  const int vb = __builtin_amdgcn_readfirstlane(opaque_tid() >> 8);
  for (;;) {
    __syncthreads();
    if (threadIdx.x == 0) *slot = (int)atomicAdd(cnt, 1u);
    __syncthreads();
    const int q = *slot;
    if (q >= 576) break;
    attn_unit(p, 2 * q + vb, smem);
  }
  for (;;) {
    __syncthreads();
    if (threadIdx.x == 0) *slot = (int)atomicAdd(cnt + 2, 1u);
    __syncthreads();
    const int t = p.ncvt_early + 2 * (*slot) + vb;
    if (t - vb >= p.ncvt) break;
    if (t < p.ncvt) p0_cvt(p, t, smem); else { __syncthreads(); __syncthreads(); }
  }
}

DI void rwkv_out_unit(const Params& p, int u, char* smem) {
  const int tid = VT, lane = tid & 63, wid = tid >> 6, wr = wid >> 1, wc = wid & 1, fr = lane & 15, fq = lane >> 4;
  const int mt = u >> 2, nt = u & 3, row0 = mt * 128;
  const bf16_t* FRW = (const bf16_t*)(p.ws + O_FRW);
  const float* mu = p.in[12];
  __syncthreads();
  for (int it = tid; it < 2048; it += 256) {
    const int r = it >> 4, c8 = (it & 15) * 8, row = row0 + r, j = row % TB, col = 1792 + c8;
    const bool pv = (j != 0 && j != NCX), nv = (j != NCX - 1 && j != TB - 1);
    const u32x4 z4 = {0u, 0u, 0u, 0u};
    const bool tail = c8 >= 96;
    const bf16_t* sp_ = tail ? (const bf16_t*)(p.ws + O_GLT) + (size_t)row * 32 + (c8 - 96) : FRW + (size_t)row * 1920 + col;
    const int rs_ = tail ? 32 : 1920;
    const u32x4 fc = *(const u32x4*)sp_;
    const u32x4 fp = pv ? *(const u32x4*)(sp_ - rs_) : z4;
    const u32x4 fn = nv ? *(const u32x4*)(sp_ + rs_) : z4;
    float xc[8], xp[8], xn[8], xs[8];
    unpack8(fc, xc); unpack8(fp, xp); unpack8(fn, xn);
#pragma unroll
    for (int e = 0; e < 8; ++e) { const float m = mu[col + e]; xs[e] = sigmoidf_(xc[e] + m * (0.5f * (xp[e] + xn[e]) - xc[e])); }
    u32x4 w; w.x = cvtpk(xs[0], xs[1]); w.y = cvtpk(xs[2], xs[3]); w.z = cvtpk(xs[4], xs[5]); w.w = cvtpk(xs[6], xs[7]);
    *(u32x4*)(smem + r * 272 + c8 * 2) = w;
  }
  __syncthreads();
  f32x4 acc[4][4];
#pragma unroll
  for (int m = 0; m < 4; ++m)
#pragma unroll
    for (int n = 0; n < 4; ++n) acc[m][n] = (f32x4){0.f, 0.f, 0.f, 0.f};
  const bf16_t* g2t = (const bf16_t*)(p.ws + O_G2T) + (size_t)(nt * 128 + wc * 64 + fr) * 128 + fq * 8;
#pragma unroll
  for (int kk = 0; kk < 4; ++kk) {
    bf16x8 af[4], bv[4];
#pragma unroll
    for (int m = 0; m < 4; ++m) af[m] = *(const bf16x8*)(smem + (wr * 64 + m * 16 + fr) * 272 + kk * 64 + fq * 16);
#pragma unroll
    for (int n = 0; n < 4; ++n) bv[n] = *(const bf16x8*)(g2t + n * 16 * 128 + kk * 32);
#pragma unroll
    for (int m = 0; m < 4; ++m)
#pragma unroll
      for (int n = 0; n < 4; ++n) acc[m][n] = mfma16(bv[n], af[m], acc[m][n]);
  }
  const int hh = nt * 2 + wc;
  const bf16_t* Yb = (const bf16_t*)((const char*)p.out + OO_Y);
  const float* BON = (const float*)(p.ws + O_BON);
  const float* gnw = p.in[21]; const float* gnb = p.in[22];
  bf16_t* CAT = (bf16_t*)(p.ws + O_A);
#pragma unroll
  for (int m = 0; m < 4; ++m) {
    const int row = row0 + wr * 64 + m * 16 + fr, j = row % TB;
    const bool pv = (j != 0 && j != NCX), nv = (j != NCX - 1 && j != TB - 1);
    f32x4 y[4]; float s = 0.f;
#pragma unroll
    for (int n = 0; n < 4; ++n) {
      const u32x2 ya = *(const u32x2*)(Yb + (size_t)row * 512 + hh * 64 + n * 16 + fq * 4), yb = *(const u32x2*)(Yb + (size_t)MT * 512 + (size_t)row * 512 + hh * 64 + n * 16 + fq * 4);
      y[n] = (f32x4){lo_f(ya.x) + lo_f(yb.x), hi_f(ya.x) + hi_f(yb.x), lo_f(ya.y) + lo_f(yb.y), hi_f(ya.y) + hi_f(yb.y)};
      s += y[n][0] + y[n][1] + y[n][2] + y[n][3];
    }
    s += __shfl_xor(s, 16); s += __shfl_xor(s, 32);
    const float mean = s * (1.f / 64.f); float q = 0.f;
#pragma unroll
    for (int n = 0; n < 4; ++n) { const f32x4 dd = y[n] - mean; q += dd[0] * dd[0] + dd[1] * dd[1] + dd[2] * dd[2] + dd[3] * dd[3]; }
    q += __shfl_xor(q, 16); q += __shfl_xor(q, 32);
    const float rstd = rsqrtf(q * (1.f / 64.f) + 64e-5f);
    const float bsum = BON[(size_t)row * 8 + hh] + BON[((size_t)MT + row) * 8 + hh];
#pragma unroll
    for (int n = 0; n < 4; ++n) {
      const int c = hh * 64 + n * 16 + fq * 4, col = 1024 + c;
      const u32x2 z2 = {0u, 0u};
      const u32x2 fc = *(const u32x2*)(FRW + (size_t)row * 1920 + col);
      const u32x2 fp = pv ? *(const u32x2*)(FRW + (size_t)(row - 1) * 1920 + col) : z2;
      const u32x2 fn = nv ? *(const u32x2*)(FRW + (size_t)(row + 1) * 1920 + col) : z2;
      const float xc[4] = {lo_f(fc.x), hi_f(fc.x), lo_f(fc.y), hi_f(fc.y)}, xp[4] = {lo_f(fp.x), hi_f(fp.x), lo_f(fp.y), hi_f(fp.y)}, xn[4] = {lo_f(fn.x), hi_f(fn.x), lo_f(fn.y), hi_f(fn.y)};
      const f32x4 mm = *(const f32x4*)(mu + col), gw = *(const f32x4*)(gnw + c), gb = *(const f32x4*)(gnb + c);
      f32x4 o;
#pragma unroll
      for (int e = 0; e < 4; ++e) {
        const float v = xc[e] + mm[e] * (0.5f * (xp[e] + xn[e]) - xc[e]);
        const float yn = (y[n][e] - mean) * rstd * gw[e] + gb[e];
        o[e] = (yn + bsum * v) * acc[m][n][e];
      }
      *(u32x2*)(CAT + (size_t)row * 1024 + 512 + c) = pack4(o);
    }
  }
}

DI float wave_sum(float v) {
#pragma unroll
  for (int o = 1; o < 64; o <<= 1) v += __shfl_xor(v, o);
  return v;
}
DI void phase_ln(const Params& p, const float* g, const float* bt, const float* mods, int sh_off, int sc_off, int latent_only, int is_final, int bid, int nb, int ctx_comb = 0) {
  const int lane = VT & 63, wid = VT >> 6;
  float* XA = (float*)(p.ws + O_X); bf16_t* H = (bf16_t*)(p.ws + O_A);
  const int nrows = latent_only ? 16384 : MT;
  f32x4 gv[4], bv[4];
#pragma unroll
  for (int i = 0; i < 4; ++i) { gv[i] = *(const f32x4*)(g + i * 256 + lane * 4); bv[i] = *(const f32x4*)(bt + i * 256 + lane * 4); }
  for (int ri = bid * 4 + wid; ri < nrows; ri += nb * 4) {
    const int row = latent_only ? (ri >> 11) * TB + NCX + (ri & 2047) : ri;
    float* xr = XA + (size_t)row * 1024;
    f32x4 v[4]; float s = 0.f;
    const float* mp = mods + modrow_of(row) * 6144;
    f32x4 scv[4], shv[4];
#pragma unroll
    for (int i = 0; i < 4; ++i) v[i] = *(const f32x4*)(xr + i * 256 + lane * 4);
    if (!is_final) {
#pragma unroll
      for (int i = 0; i < 4; ++i) { scv[i] = *(const f32x4*)(mp + sc_off + i * 256 + lane * 4); shv[i] = *(const f32x4*)(mp + sh_off + i * 256 + lane * 4); }
    }
    if (ctx_comb && (row % TB) < NCX) {
      const f32x2 st1 = *(const f32x2*)((const float*)(p.ws + O_STATS) + (size_t)row * 2);
      const float* g2p = (const float*)(p.ws + O_MODS) + 8 * 6144 + 5120;
      const int cr = (row / TB) * NCX + (row % TB);
      const float* P = p.out;
#pragma unroll
      for (int i = 0; i < 4; ++i) {
        const int c = i * 256 + lane * 4;
        f32x4 acc = *(const f32x4*)(P + (size_t)cr * 1024 + c);
#pragma unroll
        for (int sp_ = 1; sp_ < 8; ++sp_) acc += *(const f32x4*)(P + ((size_t)sp_ * 2048 + cr) * 1024 + c);
        v[i] = ALPHA * ((v[i] - st1[0]) * st1[1] * *(const f32x4*)(p.in[24] + c) + *(const f32x4*)(p.in[25] + c)) + *(const f32x4*)(g2p + c) * acc;
      }
    }
#pragma unroll
    for (int i = 0; i < 4; ++i) s += v[i][0] + v[i][1] + v[i][2] + v[i][3];
    const float mean = wave_sum(s) * (1.f / 1024.f);
    float q = 0.f;
#pragma unroll
    for (int i = 0; i < 4; ++i) { const f32x4 dd = v[i] - mean; q += dd[0] * dd[0] + dd[1] * dd[1] + dd[2] * dd[2] + dd[3] * dd[3]; }
    const float rstd = rsqrtf(wave_sum(q) * (1.f / 1024.f) + 1e-5f);
    if (!is_final && lane == 0) *(f32x2*)((float*)(p.ws + O_STATS) + (size_t)row * 2) = (f32x2){mean, rstd};
#pragma unroll
    for (int i = 0; i < 4; ++i) {
      const int c = i * 256 + lane * 4;
      const f32x4 o = (v[i] - mean) * rstd * gv[i] + bv[i];
      if (is_final) *(f32x4*)(p.out + (size_t)ri * 1024 + c) = o;
      else {
        const f32x4 hm = o * (1.f + scv[i]) + shv[i];
        *(u32x2*)(H + (size_t)row * 1024 + c) = pack4(hm);
      }
    }
  }
}

DI void lru_unit(const Params& p, int u, int pass, char* smem) {
  const int tid = VT, lane = tid & 63, wid = tid >> 6, fr = lane & 15, fq = lane >> 4;
  const int ci = u % 72, k = (u / 72) & 7, b = u / 576;
  if (pass == 2 && ci < 8) return;
  float* XC_ = (float*)smem; char* At_ = smem + 16384; float* A_ = (float*)(smem + 16384 + 8704); float* U_ = A_ + 4096;
  const bf16_t* XR = (const bf16_t*)(p.ws + O_XR);
  const int j0 = ci * 32, row0 = b * TB + j0, seg_lo = ci < 8 ? 0 : NCX, seg_hi = ci < 8 ? NCX - 1 : TB - 1;
  const float* cw = p.in[33]; const float* cb = p.in[34];
  bf16x8 bga[2][4], bgx[2][4];
  float gabv[2][2], gxbv[2][2], lamv[2][2];
  {
    const bf16_t* ga = (const bf16_t*)(p.ws + O_GAT) + (size_t)(k * 128 + wid * 32 + fr) * 128 + fq * 8;
    const bf16_t* gx = (const bf16_t*)(p.ws + O_GXT) + (size_t)(k * 128 + wid * 32 + fr) * 128 + fq * 8;
#pragma unroll
    for (int n = 0; n < 2; ++n)
#pragma unroll
      for (int kk = 0; kk < 4; ++kk) { bga[n][kk] = *(const bf16x8*)(ga + n * 2048 + kk * 32); bgx[n][kk] = *(const bf16x8*)(gx + n * 2048 + kk * 32); }
#pragma unroll
    for (int d = 0; d < 2; ++d)
#pragma unroll
      for (int n = 0; n < 2; ++n) { const int ch = d * 1024 + k * 128 + wid * 32 + n * 16 + fr; gabv[d][n] = p.in[36][ch]; gxbv[d][n] = p.in[38][ch]; lamv[d][n] = ((const float*)(p.ws + O_SP))[ch]; }
  }
  __syncthreads();
  for (int it = tid; it < 512; it += 256) {
    const int t = it >> 4, c8 = (it & 15) * 8, j = j0 + t, ch = k * 128 + c8;
    float a[8];
#pragma unroll
    for (int e = 0; e < 8; ++e) a[e] = cb[ch + e];
#pragma unroll
    for (int i = 0; i < 4; ++i) {
      const int jj = j + i - 2;
      if (jj >= seg_lo && jj <= seg_hi) {
        float x[8]; unpack8(*(const u32x4*)(XR + (size_t)(b * TB + jj) * 1024 + ch), x);
#pragma unroll
        for (int e = 0; e < 8; ++e) a[e] += x[e] * cw[i * 1024 + ch + e];
      }
    }
    *(f32x4*)(XC_ + t * 128 + c8) = (f32x4){a[0], a[1], a[2], a[3]}; *(f32x4*)(XC_ + t * 128 + c8 + 4) = (f32x4){a[4], a[5], a[6], a[7]};
    u32x4 w; w.x = cvtpk(a[0], a[1]); w.y = cvtpk(a[2], a[3]); w.z = cvtpk(a[4], a[5]); w.w = cvtpk(a[6], a[7]);
    *(u32x4*)(At_ + t * 272 + c8 * 2) = w;
  }
  __syncthreads();
  float hs[32];
#pragma unroll
  for (int t = 0; t < 32; ++t) hs[t] = 0.f;
  f32x2* CARRY = (f32x2*)(p.ws + O_CARRY); const float* HIN = (const float*)(p.ws + O_HIN);
#pragma unroll
  for (int d = 0; d < 2; ++d) {
    f32x4 aa[2][2], ax[2][2];
#pragma unroll
    for (int m = 0; m < 2; ++m)
#pragma unroll
      for (int n = 0; n < 2; ++n) { aa[m][n] = (f32x4){0.f, 0.f, 0.f, 0.f}; ax[m][n] = (f32x4){0.f, 0.f, 0.f, 0.f}; }
#pragma unroll
    for (int kk = 0; kk < 4; ++kk) {
      bf16x8 af[2];
#pragma unroll
      for (int m = 0; m < 2; ++m) af[m] = *(const bf16x8*)(At_ + (m * 16 + fr) * 272 + kk * 64 + fq * 16);
#pragma unroll
      for (int n = 0; n < 2; ++n)
#pragma unroll
        for (int m = 0; m < 2; ++m) { aa[m][n] = mfma16(af[m], bga[n][kk], aa[m][n]); ax[m][n] = mfma16(af[m], bgx[n][kk], ax[m][n]); }
    }
    if (d == 0) {
      const bf16_t* ga = (const bf16_t*)(p.ws + O_GAT) + (size_t)((8 + k) * 128 + wid * 32 + fr) * 128 + fq * 8;
      const bf16_t* gx = (const bf16_t*)(p.ws + O_GXT) + (size_t)((8 + k) * 128 + wid * 32 + fr) * 128 + fq * 8;
#pragma unroll
      for (int n = 0; n < 2; ++n)
#pragma unroll
        for (int kk = 0; kk < 4; ++kk) { bga[n][kk] = *(const bf16x8*)(ga + n * 2048 + kk * 32); bgx[n][kk] = *(const bf16x8*)(gx + n * 2048 + kk * 32); }
    }
    const size_t cidx = ((size_t)((b * 2 + d) * 72 + ci)) * 1024 + k * 128 + (tid & 127);
    float hin = 0.f;
    if (pass == 2 && tid < 128) hin = HIN[cidx];
#pragma unroll
    for (int n = 0; n < 2; ++n) {
      const int cc = wid * 32 + n * 16 + fr;
      const float gab = gabv[d][n], gxb = gxbv[d][n];
      const float sp = lamv[d][n];
#pragma unroll
      for (int m = 0; m < 2; ++m)
#pragma unroll
        for (int e = 0; e < 4; ++e) {
          const int t = m * 16 + fq * 4 + e;
          const float e1 = 1.f + __expf(-(aa[m][n][e] + gab)), e2 = 1.f + __expf(-(ax[m][n][e] + gxb));
          const float inv = __builtin_amdgcn_rcpf(e1 * e2);
          const float r = e2 * inv, ig = e1 * inv;
          const float av = __expf(-sp * r);
          A_[t * 128 + cc] = av;
          U_[t * 128 + cc] = __builtin_amdgcn_sqrtf(fmaxf(fmaf(-av, av, 1.f), 0.f)) * ig * XC_[t * 128 + cc];
        }
    }
    __syncthreads();
    if (tid < 128) {
      if (pass == 1) {
        float hcur = 0.f, P = 1.f;
#pragma unroll
        for (int tt = 0; tt < 32; ++tt) { const int t = d ? 31 - tt : tt; const float a = A_[t * 128 + tid]; hcur = a * hcur + U_[t * 128 + tid]; P *= a; }
        CARRY[cidx] = (f32x2){P, hcur};
      } else {
        float hcur = hin;
#pragma unroll
        for (int tt = 0; tt < 32; ++tt) { const int t = d ? 31 - tt : tt; hcur = A_[t * 128 + tid] * hcur + U_[t * 128 + tid]; hs[t] += hcur; }
      }
    }
    __syncthreads();
  }
  if (pass == 2) {
    if (tid < 128) {
#pragma unroll
      for (int t = 0; t < 32; ++t) A_[t * 128 + tid] = hs[t];
    }
    __syncthreads();
    const bf16_t* GATE = (const bf16_t*)(p.ws + O_GATE); bf16_t* Pout = (bf16_t*)(p.ws + O_A);
#pragma unroll
    for (int i = 0; i < 2; ++i) {
      const int it = tid + i * 256, t = it >> 4, c8 = (it & 15) * 8;
      const size_t idx = (size_t)(row0 + t) * 1024 + k * 128 + c8;
      float g8[8]; unpack8(*(const u32x4*)(GATE + idx), g8);
      const f32x4 h0 = *(const f32x4*)(A_ + t * 128 + c8), h1 = *(const f32x4*)(A_ + t * 128 + c8 + 4);
      u32x4 w; w.x = cvtpk(g8[0] * h0[0], g8[1] * h0[1]); w.y = cvtpk(g8[2] * h0[2], g8[3] * h0[3]); w.z = cvtpk(g8[4] * h1[0], g8[5] * h1[1]); w.w = cvtpk(g8[6] * h1[2], g8[7] * h1[3]);
      *(u32x4*)(Pout + idx) = w;
    }
  }
}
DI void phase_lru_carry(const Params& p, int bid, int nb) {
  const f32x2* CARRY = (const f32x2*)(p.ws + O_CARRY); float* HIN = (float*)(p.ws + O_HIN);
  for (int gid = bid * 256 + VT; gid < 16384; gid += nb * 256) {
    const int b = gid >> 11, d = (gid >> 10) & 1, ch = gid & 1023;
    const size_t base = ((size_t)((b * 2 + d) * 72)) * 1024 + ch;
    float hcur = 0.f;
#pragma unroll 1
    for (int ob = 0; ob < 72; ob += 24) {
      f32x2 c[24];
#pragma unroll
      for (int q = 0; q < 24; ++q) { const int oi = ob + q; const int ci = d == 0 ? oi : (oi < 8 ? 7 - oi : 71 - (oi - 8)); c[q] = CARRY[base + (size_t)ci * 1024]; }
#pragma unroll
      for (int q = 0; q < 24; ++q) { const int oi = ob + q; const int ci = d == 0 ? oi : (oi < 8 ? 7 - oi : 71 - (oi - 8)); HIN[base + (size_t)ci * 1024] = hcur; hcur = c[q][0] * hcur + c[q][1]; }
    }
  }
}

#define XB_TMO      128
#define XB_XCNT(j)  (256  + 64 * (j))
#define XB_XSUB(j)  (1280 + 64 * (j))
#define XB_XGEN(j)  (2304 + 64 * (j))
#define XB_TOP      3328
#define XB_TOPGEN   3392
#define XCD_BAR_WORDS 3456
#define XB_SPIN_CAP (1u << 22)
#define LAS __attribute__((address_space(3)))
DI unsigned xb_ld(unsigned* p) { return __hip_atomic_load(p, __ATOMIC_RELAXED, __HIP_MEMORY_SCOPE_AGENT); }
DI unsigned xb_add(unsigned* p, unsigned v) { return __hip_atomic_fetch_add(p, v, __ATOMIC_RELAXED, __HIP_MEMORY_SCOPE_AGENT); }
DI unsigned xb_xcc_id() { return (unsigned)__builtin_amdgcn_s_getreg((3 << 11) | 20) & 0xFu; }
#define XB_SPIN(cond, bar) do { unsigned _sp = 0; while (cond) { __builtin_amdgcn_s_sleep(1); \
    if ((++_sp & 255u) == 0u) { if (xb_ld(&(bar)[XB_TMO])) break; if (_sp > XB_SPIN_CAP) { atomicAdd(&(bar)[XB_TMO], 1u); break; } } } } while (0)
struct XcdBarrier { unsigned* bar; unsigned x; volatile LAS unsigned* st; };
DI XcdBarrier xcd_barrier_post(unsigned* bar, volatile LAS unsigned* st) {
  XcdBarrier b; b.bar = bar; b.x = xb_xcc_id(); b.st = st;
  if (threadIdx.x == 0) (void)xb_add(&bar[XB_XCNT(b.x)], 1u);
  return b;
}
DI void xcd_barrier_complete(unsigned* bar, unsigned x, unsigned& nloc, unsigned& nx) {
  const unsigned G = gridDim.x * gridDim.y * gridDim.z;
  unsigned sum, cnt, mine, sp = 0u;
  for (;;) {
    sum = 0u; cnt = 0u; mine = 0u;
#pragma unroll
    for (unsigned j = 0; j < 16; ++j) { const unsigned c = xb_ld(&bar[XB_XCNT(j)]); sum += c; cnt += (c > 0u) ? 1u : 0u; mine = (j == x) ? c : mine; }
    if (sum == G) break;
    __builtin_amdgcn_s_sleep(1);
    if ((++sp & 255u) == 0u) { if (xb_ld(&bar[XB_TMO])) break; if (sp > XB_SPIN_CAP) { atomicAdd(&bar[XB_TMO], 1u); break; } }
  }
  nloc = mine > 0u ? mine : 1u; nx = cnt > 0u ? cnt : 1u;
}
DI void xcd_barrier(const XcdBarrier& b) {
  asm volatile("s_waitcnt vmcnt(0)" ::: "memory");
  __syncthreads();
  if (threadIdx.x == 0) {
    unsigned* bar = b.bar;
    __builtin_amdgcn_s_waitcnt(0);
    unsigned nloc = b.st[0], nx = b.st[1];
    if (nloc == 0u) { xcd_barrier_complete(bar, b.x, nloc, nx); b.st[0] = nloc; b.st[1] = nx; }
    const unsigned old = xb_add(&bar[XB_XSUB(b.x)], 1u);
    const unsigned gen = old / nloc;
    if (old + 1u == (gen + 1u) * nloc) {
      __builtin_amdgcn_fence(__ATOMIC_RELEASE, "agent");
      asm volatile("s_waitcnt vmcnt(0)" ::: "memory");
      const unsigned og = xb_add(&bar[XB_TOP], 1u);
      const unsigned tg = og / nx;
      if (og + 1u == (tg + 1u) * nx) xb_add(&bar[XB_TOPGEN], 1u);
      else XB_SPIN(xb_ld(&bar[XB_TOPGEN]) == tg, bar);
      __builtin_amdgcn_fence(__ATOMIC_ACQUIRE, "agent");
      xb_add(&bar[XB_XGEN(b.x)], 1u);
      asm volatile("s_waitcnt vmcnt(0)" ::: "memory");
    } else {
      XB_SPIN(xb_ld(&bar[XB_XGEN(b.x)]) == gen, bar);
      __builtin_amdgcn_fence(__ATOMIC_ACQUIRE, "agent");
      asm volatile("s_waitcnt vmcnt(0)" ::: "memory");
    }
  }
  __syncthreads();
}

constexpr int N_PHASES = 24;
template <int ph>
DI void run_phase(const Params& p, char* smem, char* dsm, int bid, int nb, int pbid, int pnb) {
  char* ws = p.ws;
  const float* mods0 = (const float*)(ws + O_MODS); const float* mods1 = mods0 + 9 * 6144;
  bf16_t* HA = (bf16_t*)(ws + O_A); float* XA = (float*)(ws + O_X);
  bf16_t* H1 = (bf16_t*)(ws + O_B);
  if constexpr (ph == 0) phase0(p, smem, bid, nb);
  else if constexpr (ph == 1) phase_prep_a0(p, bid, nb);
  else if constexpr (ph == 2) { EpiWin0 e{(bf16_t*)(ws + O_FQ), (bf16_t*)(ws + O_FKV), (float*)(ws + O_FKR), (bf16_t*)(ws + O_FRW), (float*)(ws + O_RSQ)};
      gemm8_phase(HA, 1024, (const bf16_t*)(ws + O_WIN0), 1024, 1024, 72, 10, 0, 0, e, dsm, pbid, pnb); }
  else if constexpr (ph == 3) {}
  else if constexpr (ph == 4) phase_mixer(p, smem, dsm, bid, nb);
  else if constexpr (ph == 5) { for (int u = bid; u < 576; u += nb) rwkv_out_unit(p, u, smem); }
  else if constexpr (ph == 6) { EpiRes e{p.in[0], p.in[2], XA, mods0, 2048, 1, ALPHA, nullptr, nullptr, nullptr};
      gemm8_phase(HA, 1024, (const bf16_t*)(ws + O_WOUT0), 1024, 1024, 72, 4, 0, 0, e, dsm, pbid, pnb); }
  else if constexpr (ph == 7) phase_ln(p, p.in[24], p.in[25], mods0, 3072, 4096, 0, 0, bid, nb);
  else if constexpr (ph == 8 || ph == 10) { constexpr int hf = (ph - 8) >> 1; EpiMlp1 e{H1};
      gemm8_phase(HA, 1024, (const bf16_t*)(ws + O_W1_0) + (size_t)hf * 2048 * 1024, 1024, 1024, 64, 8, 1, 0, e, dsm, pbid, pnb);
      if constexpr (hf == 0) { EpiMlp1Ctx ec{(bf16_t*)(ws + O_B + 72 * MiB)};
        gemm8_phase(HA, 1024, (const bf16_t*)(ws + O_W1_0), 1024, 1024, 8, 16, 2, 0, ec, dsm, pbid, pnb); } }
  else if constexpr (ph == 9 || ph == 11) { constexpr int hf = (ph - 9) >> 1;
      EpiRes e{p.in[0], p.in[2], XA, mods0, 5120, 0, hf ? 1.f : ALPHA, hf ? nullptr : (const float*)(ws + O_STATS), p.in[24], p.in[25]};
      gemm8_phase(H1, 2048, (const bf16_t*)(ws + O_W2_0) + (size_t)hf * 2048, 4096, 2048, 64, 4, 1, 0, e, dsm, pbid, pnb);
      if constexpr (hf == 0) { EpiPartial ep{p.out, 0, 1};
        gemm8_phase((const bf16_t*)(ws + O_B + 72 * MiB), 4096, (const bf16_t*)(ws + O_W2_0), 4096, 512, 8, 4, 3, 0, ep, dsm, pbid, pnb, 8); } }
  else if constexpr (ph == 12) phase_ln(p, p.in[28], p.in[29], mods1, 0, 1024, 0, 0, bid, nb, 1);
  else if constexpr (ph == 13) { EpiWin1 e{(bf16_t*)(ws + O_GATE), (bf16_t*)(ws + O_XR)};
      gemm8_phase(HA, 1024, (const bf16_t*)(ws + O_WIN1), 1024, 1024, 72, 8, 0, 0, e, dsm, pbid, pnb); }
  else if constexpr (ph == 14) { for (int u = bid; u < 4608; u += nb) lru_unit(p, u, 1, smem); }
  else if constexpr (ph == 15) phase_lru_carry(p, bid, nb);
  else if constexpr (ph == 16) { for (int u = bid; u < 4608; u += nb) lru_unit(p, u, 2, smem); }
  else if constexpr (ph == 17) { EpiRes e{p.in[0], p.in[2], XA, mods1, 2048, 0, ALPHA, (const float*)(ws + O_STATS), p.in[28], p.in[29]};
      gemm8_phase(HA, 1024, (const bf16_t*)(ws + O_WOUT1), 1024, 1024, 64, 4, 1, 0, e, dsm, pbid, pnb); }
  else if constexpr (ph == 18) phase_ln(p, p.in[41], p.in[42], mods1, 3072, 4096, 1, 0, bid, nb);
  else if constexpr (ph == 19 || ph == 21) { constexpr int hf = (ph - 19) >> 1; EpiMlp1 e{H1};
      gemm8_phase(HA, 1024, (const bf16_t*)(ws + O_W1_1) + (size_t)hf * 2048 * 1024, 1024, 1024, 64, 8, 1, 0, e, dsm, pbid, pnb); }
  else if constexpr (ph == 20 || ph == 22) { constexpr int hf = (ph - 20) >> 1; EpiRes e{p.in[0], p.in[2], XA, mods1, 5120, 0, hf ? 1.f : ALPHA, hf ? nullptr : (const float*)(ws + O_STATS), p.in[41], p.in[42]};
      gemm8_phase(H1, 2048, (const bf16_t*)(ws + O_W2_1) + (size_t)hf * 2048, 4096, 2048, 64, 4, 1, 0, e, dsm, pbid, pnb); }
  else if constexpr (ph == 23) phase_ln(p, p.in[45], p.in[46], mods1, 0, 0, 1, 1, bid, nb);
}

template <int PH, int HI>
DI void run_range(const Params& p, char* smem, char* dsm, int bid, int nb, int pbid, int pnb, const XcdBarrier& xb) {
  run_phase<PH>(p, smem, dsm, bid, nb, pbid, pnb);
  if constexpr (PH < HI) { if constexpr (PH != 3) xcd_barrier(xb); run_range<PH + 1, HI>(p, smem, dsm, bid, nb, pbid, pnb, xb); }
}
constexpr int DYN_LDS = 131072;
template <int LO, int HI>
__global__ void __launch_bounds__(512, 2) mega(Params p) {
  extern __shared__ __attribute__((aligned(16))) char dsm[];
  __shared__ uint4 xb_words;
  XcdBarrier xb; xb.bar = (unsigned*)(p.ws + O_BAR); xb.x = 0; xb.st = (volatile LAS unsigned*)&xb_words;
  if constexpr (LO < HI) {
    if (threadIdx.x == 0) xb_words = make_uint4(0u, 0u, 0u, 0u);
    __syncthreads();
    xb = xcd_barrier_post((unsigned*)(p.ws + O_BAR), (volatile LAS unsigned*)&xb_words);
    if (p.njobs < 0) cg::this_grid().sync();
  }
  const int vb = __builtin_amdgcn_readfirstlane(threadIdx.x >> 8);
  run_range<LO, HI>(p, dsm + vb * SMEM_BYTES, dsm, blockIdx.x * 2 + vb, gridDim.x * 2, blockIdx.x, gridDim.x, xb);
}
template <int PH>
static void launch_split(const Params& p, int grid, hipStream_t stream) {
  (void)hipFuncSetAttribute((const void*)mega<PH, PH>, hipFuncAttributeMaxDynamicSharedMemorySize, DYN_LDS);
  hipLaunchKernelGGL((mega<PH, PH>), dim3(grid), dim3(512), DYN_LDS, stream, p);
  if constexpr (PH + 1 < N_PHASES) launch_split<PH + 1>(p, grid, stream);
}

extern "C" void kernel_launch(void* const* d_in, const int* in_sizes, int n_in, void* d_out, int out_size, void* d_ws, size_t ws_size, hipStream_t stream) {
  static int grid_blocks = 0;
  if (!grid_blocks) {
    int dev = 0, cus = 0, per_cu = 0;
    (void)hipGetDevice(&dev);
    (void)hipDeviceGetAttribute(&cus, hipDeviceAttributeMultiprocessorCount, dev);
    (void)hipFuncSetAttribute((const void*)mega<0, N_PHASES - 1>, hipFuncAttributeMaxDynamicSharedMemorySize, DYN_LDS);
    (void)hipOccupancyMaxActiveBlocksPerMultiprocessor(&per_cu, mega<0, N_PHASES - 1>, 512, DYN_LDS);
    if (per_cu > 1) per_cu = 1;
    if (per_cu < 1) per_cu = 1;
    grid_blocks = cus * per_cu;
  }
  if (n_in != 47 || ws_size < 256 * MiB) { fprintf(stderr, "kernel_launch: bad args n_in %d ws %zu\n", n_in, ws_size); return; }
  Params p; memset(&p, 0, sizeof(p));
  for (int i = 0; i < 47; ++i) p.in[i] = (const float*)d_in[i];
  p.out = (float*)d_out; p.ws = (char*)d_ws;
  char* ws = (char*)d_ws;
  int nj = 0, tiles = 0;
  auto add = [&](int src, size_t soff, size_t dst, int K, int N, int Npad, int nbatch, int scale) {
    CvtJob& J = p.jobs[nj++];
    J.src = (const float*)d_in[src] + soff; J.dst = (bf16_t*)(ws + dst); J.scale = scale >= 0 ? (const float*)d_in[scale] : nullptr;
    J.K = K; J.N = N; J.Npad = Npad; J.nbatch = nbatch; J.tile0 = tiles; J.lds = N;
    tiles += nbatch * (K / 64) * (Npad / 64);
  };
  add(6, 0, O_WIN0, 1024, 2560, 2560, 1, -1); p.jobs[nj - 1].lds = 2592;
  add(6, 2560, O_WTAIL, 1024, 32, 256, 1, -1); p.jobs[nj - 1].lds = 2592;
  add(8, 0, O_WUQ, 384, 768, 768, 1, 7);
  add(10, 0, O_WUK, 256, 512, 512, 1, 9);
  add(11, 0, O_WUV, 256, 512, 512, 1, 9);
  add(14, 0, O_W2T, 64, 512, 512, 2, -1);
  add(16, 0, O_A2T, 64, 512, 512, 2, -1);
  add(17, 0, O_G2T, 128, 512, 512, 1, -1);
  p.ncvt_early = tiles;
  add(23, 0, O_WOUT0, 1024, 1024, 1024, 1, -1);
  add(26, 0, O_W1_0, 1024, 4096, 4096, 1, -1);
  add(27, 0, O_W2_0, 4096, 1024, 1024, 1, -1);
  add(32, 0, O_WIN1, 1024, 2048, 2048, 1, -1);
  add(35, 0, O_GAT, 128, 128, 128, 16, -1);
  add(37, 0, O_GXT, 128, 128, 128, 16, -1);
  add(40, 0, O_WOUT1, 1024, 1024, 1024, 1, -1);
  add(43, 0, O_W1_1, 1024, 4096, 4096, 1, -1);
  add(44, 0, O_W2_1, 4096, 1024, 1024, 1, -1);
  p.njobs = nj; p.ncvt = tiles;
#if N_LAUNCH_SPLIT
  launch_split<0>(p, grid_blocks, stream);
#else
  (void)hipMemsetAsync(ws + O_BAR, 0, XCD_BAR_WORDS * 4, stream);
  void* args[] = {&p};
  hipError_t e = hipLaunchCooperativeKernel((void*)mega<0, N_PHASES - 1>, dim3(grid_blocks), dim3(512), args, DYN_LDS, stream);
  if (e != hipSuccess) fprintf(stderr, "cooperative launch failed: %s (grid %d)\n", hipGetErrorString(e), grid_blocks);
#endif
}
```

```cpp
#include <hip/hip_runtime.h>
#include <hip/hip_cooperative_groups.h>
#include <cstdint>
#include <cstdio>
#include <cstring>
namespace cg = cooperative_groups;

typedef unsigned short bf16_t;
typedef short bf16x8 __attribute__((ext_vector_type(8)));
typedef float f32x2 __attribute__((ext_vector_type(2)));
typedef float f32x4 __attribute__((ext_vector_type(4)));
typedef float f32x16 __attribute__((ext_vector_type(16)));
typedef unsigned u32x2 __attribute__((ext_vector_type(2)));
typedef unsigned u32x4 __attribute__((ext_vector_type(4)));
#define DI __device__ __forceinline__

constexpr int MT = 18432, TB = 2304, NCX = 256;
constexpr size_t MiB = 1u << 20;
constexpr float ALPHA = 1.41421356237f;
constexpr int SMEM_BYTES = 59392;
#ifndef N_LAUNCH_SPLIT
#define N_LAUNCH_SPLIT 0
#endif

constexpr size_t O_WIN0 = 0;
constexpr size_t O_WTAIL = O_WIN0 + (size_t)2560 * 1024 * 2;
constexpr size_t O_WUQ = O_WTAIL + (size_t)256 * 1024 * 2;
constexpr size_t O_WUK = O_WUQ + (size_t)768 * 384 * 2;
constexpr size_t O_WUV = O_WUK + (size_t)512 * 256 * 2;
constexpr size_t O_W2T = O_WUV + (size_t)512 * 256 * 2;
constexpr size_t O_A2T = O_W2T + (size_t)2 * 512 * 64 * 2;
constexpr size_t O_G2T = O_A2T + (size_t)2 * 512 * 64 * 2;
constexpr size_t O_WOUT0 = O_G2T + (size_t)512 * 128 * 2;
constexpr size_t O_W1_0 = O_WOUT0 + (size_t)1024 * 1024 * 2;
constexpr size_t O_W2_0 = O_W1_0 + (size_t)4096 * 1024 * 2;
constexpr size_t O_WIN1 = O_W2_0 + (size_t)4096 * 1024 * 2;
constexpr size_t O_GAT = O_WIN1 + (size_t)2048 * 1024 * 2;
constexpr size_t O_GXT = O_GAT + (size_t)16 * 128 * 128 * 2;
constexpr size_t O_WOUT1 = O_GXT + (size_t)16 * 128 * 128 * 2;
constexpr size_t O_W1_1 = O_WOUT1 + (size_t)1024 * 1024 * 2;
constexpr size_t O_W2_1 = O_W1_1 + (size_t)4096 * 1024 * 2;
constexpr size_t O_MODS = O_W2_1 + (size_t)4096 * 1024 * 2;
constexpr size_t O_ROPE = O_MODS + (size_t)2 * 9 * 6144 * 4;
constexpr size_t O_RSQ = O_ROPE + 4096;
constexpr size_t O_CNT = O_RSQ + (size_t)MT * 2 * 4;
constexpr size_t O_BAR = O_CNT + 256;
constexpr size_t O_STATS = O_BAR + 3456 * 4;
constexpr size_t O_SP = O_STATS + (size_t)MT * 2 * 4;
constexpr size_t O_GLT = O_SP + 2048 * 4;
constexpr size_t O_WEND = O_GLT + (size_t)MT * 32 * 2;
static_assert(O_WEND <= 52 * MiB, "weight region overflow");
constexpr size_t O_A = 52 * MiB;
constexpr size_t O_X = 88 * MiB;
constexpr size_t O_B = 160 * MiB;
constexpr size_t O_FRW = O_X;
constexpr size_t O_FQ = O_FRW + (size_t)MT * 1920 * 2;
constexpr size_t O_FKV = O_FQ + (size_t)MT * 384 * 2;
constexpr size_t O_Q = O_FKV + (size_t)MT * 256 * 2;
constexpr size_t O_K = O_Q + (size_t)MT * 768 * 2;
constexpr size_t O_FKR = O_K + (size_t)MT * 768 * 2;
constexpr size_t O_BON = O_FKR + (size_t)MT * 32 * 4;
static_assert(O_BON + (size_t)2 * MT * 8 * 4 <= 256 * MiB, "mixer region overflow");
constexpr size_t O_GATE = O_B;
constexpr size_t O_XR = O_B + 36 * MiB;
constexpr size_t O_CARRY = O_B + 72 * MiB;
constexpr size_t O_HIN = O_CARRY + 9 * MiB;
constexpr size_t OO_Y = 0;
constexpr size_t OO_VT = 36 * MiB;

struct CvtJob { const float* src; bf16_t* dst; const float* scale; int K, N, Npad, nbatch, tile0, lds; };
struct Params {
  const float* in[47];
  float* out; char* ws;
  CvtJob jobs[20];
  int njobs, ncvt, ncvt_early, pad2_;
};

DI int opaque_tid() { int t = threadIdx.x; asm volatile("" : "+v"(t)); return t; }
#define VT (opaque_tid() & 255)
DI unsigned cvtpk(float lo, float hi) { unsigned r; asm("v_cvt_pk_bf16_f32 %0, %1, %2" : "=v"(r) : "v"(lo), "v"(hi)); return r; }
DI float bf2f(bf16_t b) { return __uint_as_float((unsigned)b << 16); }
DI float lo_f(unsigned w) { return __uint_as_float(w << 16); }
DI float hi_f(unsigned w) { return __uint_as_float(w & 0xffff0000u); }
DI u32x2 pack4(f32x4 v) { u32x2 r; r.x = cvtpk(v[0], v[1]); r.y = cvtpk(v[2], v[3]); return r; }
DI float sigmoidf_(float x) { return __builtin_amdgcn_rcpf(1.f + __expf(-x)); }
DI float tanh_fast(float x) { x = fminf(fmaxf(x, -15.f), 15.f); float t = __expf(2.f * x); return (t - 1.f) * __builtin_amdgcn_rcpf(t + 1.f); }
DI float one_minus_exp(float x) { const float ps = -x * (1.f + x * (0.5f + x * (0.16666667f + x * (0.041666668f + x * (0.0083333338f + x * 0.0013888889f))))); return x > -0.35f ? ps : 1.f - __expf(x); }
DI float gelu_tanh(float x) { float u = 0.7978845608f * (x + 0.044715f * x * x * x); return 0.5f * x * (1.f + tanh_fast(u)); }
template <int CTRL> DI float dppf(float v) { return __int_as_float(__builtin_amdgcn_update_dpp(0, __float_as_int(v), CTRL, 0xF, 0xF, true)); }
DI float red8(float v) { v += dppf<0xB1>(v); v += dppf<0x4E>(v); v += dppf<0x141>(v); return v; }
DI float red16(float v) { v = red8(v); v += dppf<0x140>(v); return v; }
DI float red8_ns(float v) { v += dppf<0xB1>(v); asm("" : "+v"(v)); v += dppf<0x4E>(v); asm("" : "+v"(v)); v += dppf<0x141>(v); asm("" : "+v"(v)); return v; }
DI f32x4 mfma16(bf16x8 a, bf16x8 b, f32x4 c) { return __builtin_amdgcn_mfma_f32_16x16x32_bf16(a, b, c, 0, 0, 0); }
DI f32x16 mfma32(bf16x8 a, bf16x8 b, f32x16 c) { return __builtin_amdgcn_mfma_f32_32x32x16_bf16(a, b, c, 0, 0, 0); }
DI const float* xrow_in(const Params& p, int row) {
  const int b = row / TB, j = row - b * TB;
  return j < NCX ? p.in[2] + (size_t)(b * NCX + j) * 1024 : p.in[0] + (size_t)(b * 2048 + j - NCX) * 1024;
}
DI int modrow_of(int row) { const int b = row / TB, j = row - b * TB; return j < NCX ? 8 : b; }

DI void p0_misc(const Params& p) {
  const int tid = VT;
  float* rsq = (float*)(p.ws + O_RSQ);
  for (int i = tid; i < MT * 2; i += 256) rsq[i] = 0.f;
  unsigned* cnt = (unsigned*)(p.ws + O_CNT);
  if (tid < 64) cnt[tid] = 0u;
  { float* spt = (float*)(p.ws + O_SP); for (int i = tid; i < 2048; i += 256) spt[i] = 8.f * log1pf(__expf(-p.in[39][i])); }
  float* rope = (float*)(p.ws + O_ROPE);
  for (int i = tid; i < 512; i += 256) {
    const int pos = i >> 3, f = i & 7;
    const float inv = powf(10000.f, -(float)(2 * f) / 16.f);
    const float ang = (float)pos * inv;
    rope[i * 2] = cosf(ang); rope[i * 2 + 1] = sinf(ang);
  }
}
DI void p0_zero_y(const Params& p, int u) {
  f32x4* y = (f32x4*)((char*)p.out + OO_Y) + (size_t)u * 4096;
  const f32x4 z = {0.f, 0.f, 0.f, 0.f};
  for (int i = VT; i < 4096; i += 256) y[i] = z;
}
DI void p0_mods(const Params& p, int u, char* smem) {
  const int tid = VT, layer = u / 192, n0 = (u % 192) * 32;
  float* sl = (float*)smem;
  float* red = sl + 9216;
  const float* c = p.in[1]; const float* cc = p.in[3];
  __syncthreads();
  for (int i = tid; i < 9216; i += 256) { const float v = i < 8192 ? c[i] : cc[i - 8192]; sl[i] = v / (1.f + __expf(-v)); }
  __syncthreads();
  const float* W = p.in[layer ? 30 : 4]; const float* bias = p.in[layer ? 31 : 5];
  const int kg = tid >> 5, cn = tid & 31;
  float acc[9];
#pragma unroll
  for (int r = 0; r < 9; ++r) acc[r] = 0.f;
  const float* wp = W + (size_t)(kg * 128) * 6144 + n0 + cn;
#pragma unroll 1
  for (int k0 = 0; k0 < 128; k0 += 16) {
    float w[16];
#pragma unroll
    for (int q = 0; q < 16; ++q) w[q] = wp[(size_t)(k0 + q) * 6144];
#pragma unroll
    for (int q = 0; q < 16; ++q) {
#pragma unroll
      for (int r = 0; r < 9; ++r) acc[r] += sl[r * 1024 + kg * 128 + k0 + q] * w[q];
    }
  }
#pragma unroll
  for (int r = 0; r < 9; ++r) red[(kg * 9 + r) * 32 + cn] = acc[r];
  __syncthreads();
  float* mods = (float*)(p.ws + O_MODS) + (size_t)layer * 9 * 6144;
  for (int i = tid; i < 288; i += 256) {
    const int r = i >> 5, n = i & 31;
    float sacc = bias[n0 + n];
#pragma unroll
    for (int g = 0; g < 8; ++g) sacc += red[(g * 9 + r) * 32 + n];
    mods[r * 6144 + n0 + n] = sacc;
  }
}
DI void p0_cvt(const Params& p, int t, char* smem) {
  int ji = 0;
  for (int q = 1; q < p.njobs; ++q) if (t >= p.jobs[q].tile0) ji = q;
  const CvtJob& J = p.jobs[ji];
  int lt = t - J.tile0;
  const int tk = J.K >> 6, tn = J.Npad >> 6;
  const int bi = lt / (tk * tn); lt -= bi * tk * tn;
  const int k0 = (lt / tn) * 64, n0 = (lt % tn) * 64;
  const float* src = J.src + (size_t)bi * J.K * J.N;
  bf16_t* dst = J.dst + (size_t)bi * J.Npad * J.K;
  float* tile = (float*)smem;
  const int tid = VT, a = tid >> 6, l = tid & 63;
  __syncthreads();
#pragma unroll 4
  for (int i = 0; i < 16; ++i) {
    const int kk = i * 4 + a, n = n0 + l;
    float v = 0.f;
    if (n < J.N) { v = src[(size_t)(k0 + kk) * J.lds + n]; if (J.scale) v *= J.scale[k0 + kk]; }
    tile[kk * 65 + l] = v;
  }
  __syncthreads();
#pragma unroll 4
  for (int i = 0; i < 16; ++i) {
    const int nn = i * 4 + a;
    dst[(size_t)(n0 + nn) * J.K + k0 + l] = (bf16_t)(cvtpk(tile[l * 65 + nn], 0.f) & 0xffffu);
  }
}
DI void phase0(const Params& p, char* smem, int bid, int nb) {
  const int ncp = (p.ncvt_early + 1) & ~1;
  const int total = 384 + ncp + 2;
  for (int t = bid; t < total; t += nb) {
    if (t < 384) p0_mods(p, t, smem);
    else if (t - 384 < ncp) { if (t - 384 < p.ncvt_early) p0_cvt(p, t - 384, smem); else { __syncthreads(); __syncthreads(); } }
    else { const int z = t - 384 - ncp; if (z == 0) p0_misc(p); }
  }
}

DI void phase_prep_a0(const Params& p, int bid, int nb) {
  const float* mods = (const float*)(p.ws + O_MODS);
  bf16_t* H = (bf16_t*)(p.ws + O_A);
  const int stride = nb * 256;
  for (int i0 = bid * 256 + VT; i0 < MT * 128; i0 += 3 * stride) {
    f32x4 x0[3], x1[3], sh0[3], sh1[3], sc0[3], sc1[3];
#pragma unroll
    for (int q = 0; q < 3; ++q) {
      const int i = i0 + q * stride;
      if (i < MT * 128) {
        const int row = i >> 7, c = (i & 127) * 8;
        const float* src = xrow_in(p, row) + c;
        const float* mp = mods + modrow_of(row) * 6144 + c;
        x0[q] = *(const f32x4*)src; x1[q] = *(const f32x4*)(src + 4);
        sh0[q] = *(const f32x4*)mp; sh1[q] = *(const f32x4*)(mp + 4);
        sc0[q] = *(const f32x4*)(mp + 1024); sc1[q] = *(const f32x4*)(mp + 1028);
      }
    }
#pragma unroll
    for (int q = 0; q < 3; ++q) {
      const int i = i0 + q * stride;
      if (i < MT * 128) {
        const int row = i >> 7, c = (i & 127) * 8;
        const f32x4 y0 = x0[q] * (1.f + sc0[q]) + sh0[q], y1 = x1[q] * (1.f + sc1[q]) + sh1[q];
        u32x4 w; w.x = cvtpk(y0[0], y0[1]); w.y = cvtpk(y0[2], y0[3]); w.z = cvtpk(y1[0], y1[1]); w.w = cvtpk(y1[2], y1[3]);
        *(u32x4*)(H + (size_t)row * 1024 + c) = w;
      }
    }
  }
}

namespace g8 {
constexpr int BM = 256, BK = 64, HALF = 128, HT = HALF * BK, NXCD = 8, WGM = 8;
DI int lds_byte(int r, int c) { const int st = (r >> 4) * 2 + (c >> 5), rr = r & 15, cc = c & 31, ob = rr * 64 + cc * 2; return st * 1024 + (ob ^ (((ob >> 9) & 1) << 5)); }
DI void stage_rc(int b, int& R, int& C) { const int st = b / 1024, sb = b % 1024, swz = sb ^ (((sb >> 9) & 1) << 5); R = (st >> 1) * 16 + swz / 64; C = (st & 1) * 32 + (swz % 64) / 2; }
}
typedef __attribute__((address_space(3))) unsigned char lds_u8;
template <class Epi>
DI void gemm8_phase(const bf16_t* __restrict__ A, int lda, const bf16_t* __restrict__ Bt, int ldb, int K,
                    int nM, int nN, int mode, int base, const Epi& epi, char* dsm, int bid, int nb, int ksplit = 1) {
  using namespace g8;
  constexpr int HTB = HALF * BK * 2;
  lds_u8* lds = (lds_u8*)dsm;
  const int tid = opaque_tid(), wid = __builtin_amdgcn_readfirstlane(tid >> 6), lane = tid & 63, wr = wid >> 2, wc = wid & 3, fr = lane & 15, fq = lane >> 4;
  unsigned voffA[2], voffB[2];
#pragma unroll
  for (int i = 0; i < 2; ++i) { int R, C; stage_rc(tid * 16 + i * 8192, R, C); voffA[i] = (unsigned)(R * lda + C) * 2u; voffB[i] = (unsigned)(R * ldb + C) * 2u; }
  const size_t hstepA = (size_t)HALF * lda * 2, hstepB = (size_t)HALF * ldb * 2;
  const unsigned ldsw = (unsigned)wid * 1024u;
  const int aoff = lds_byte(wr * 64 + fr, fq * 8), boff = lds_byte(wc * 32 + fr, fq * 8);
  #define SA(b,h) (((b)*2+(h))*HTB)
  #define SB(b,h) ((4+(b)*2+(h))*HTB)
  #define STAGE(bufoff,gbase,voff) do{ _Pragma("unroll") for(int _i=0;_i<2;++_i) \
    __builtin_amdgcn_global_load_lds((const unsigned*)((const char*)(gbase)+(voff)[_i]),(__attribute__((address_space(3))) unsigned*)(lds+(bufoff)+ldsw+_i*8192),16,0,0);}while(0)
  #define LDA(dst,b,h) do{ _Pragma("unroll") for(int m=0;m<4;++m) _Pragma("unroll") for(int k=0;k<2;++k) dst[m][k]=*(const __attribute__((address_space(3))) bf16x8*)(lds+SA(b,h)+aoff+m*2048+k*1024);}while(0)
  #define LDB(dst,b,h) do{ _Pragma("unroll") for(int n=0;n<2;++n) _Pragma("unroll") for(int k=0;k<2;++k) dst[n][k]=*(const __attribute__((address_space(3))) bf16x8*)(lds+SB(b,h)+boff+n*2048+k*1024);}while(0)
  #define MMA(ai,bj,At_,Bt_) do{__builtin_amdgcn_s_setprio(1); _Pragma("unroll") for(int m=0;m<4;++m) _Pragma("unroll") for(int n=0;n<2;++n) _Pragma("unroll") for(int k=0;k<2;++k) \
      acc[ai][bj][m][n]=__builtin_amdgcn_mfma_f32_16x16x32_bf16(Bt_[n][k],At_[m][k],acc[ai][bj][m][n],0,0,0); \
    __builtin_amdgcn_s_setprio(0);}while(0)
  #define WAIT_V(n) asm volatile("s_waitcnt vmcnt(" #n ")":::"memory")
  #define WAIT_L(n) asm volatile("s_waitcnt lgkmcnt(" #n ")":::"memory")
  #define BAR __builtin_amdgcn_s_barrier()
  #define SCHED __builtin_amdgcn_sched_barrier(0)
  const int nwt = nM * nN, nwg = nwt * ksplit, nt = K / BK;
  for (int L = bid; L < nwg; L += nb) {
    const int ks = L % ksplit;
    int wgid = L / ksplit;
    { const int q = nwt / NXCD, r = nwt % NXCD, xcd = wgid % NXCD, off = wgid / NXCD; wgid = (xcd < r ? xcd * (q + 1) : r * (q + 1) + (xcd - r) * q) + off; }
    const int nig = WGM * nN, gid = wgid / nig, fm = gid * WGM, gsz = min(nM - fm, WGM);
    const int pm = fm + ((wgid % nig) % gsz), pn = (wgid % nig) / gsz;
    const int brow = mode == 1 ? ((((base + pm) >> 3) * 9 + 1 + ((base + pm) & 7)) * 256) : (mode == 2 ? pm * TB : base + pm * 256);
    const int bcol = pn * BM;
    f32x4 acc[2][2][4][2];
#pragma unroll
    for (int a_ = 0; a_ < 2; ++a_)
#pragma unroll
      for (int b_ = 0; b_ < 2; ++b_)
#pragma unroll
        for (int m = 0; m < 4; ++m)
#pragma unroll
          for (int n = 0; n < 2; ++n) acc[a_][b_][m][n] = (f32x4){0.f, 0.f, 0.f, 0.f};
    bf16x8 At[4][2], B0[2][2], B1[2][2];
    const char* cA = (const char*)(A + (size_t)brow * lda + (size_t)ks * K); const char* cB = (const char*)(Bt + (size_t)bcol * ldb + (size_t)ks * K);
    STAGE(SB(0,0),cB,voffB); STAGE(SA(0,0),cA,voffA); STAGE(SB(0,1),cB+hstepB,voffB); STAGE(SA(0,1),cA+hstepA,voffA);
    if(wr==1)BAR;
    WAIT_V(4); BAR;
    STAGE(SB(1,0),cB+128,voffB); STAGE(SA(1,0),cA+128,voffA); STAGE(SB(1,1),cB+hstepB+128,voffB);
    WAIT_V(6); BAR;
    for(int t=0;t<nt-2;t+=2){
      const char* a1 = cA + (size_t)(t+1)*128; const char* a2 = cA + (size_t)(t+2)*128; const char* a3 = cA + (size_t)(t+3)*128;
      const char* b2 = cB + (size_t)(t+2)*128; const char* b3 = cB + (size_t)(t+3)*128;
      LDB(B0,0,0); SCHED; LDA(At,0,0); STAGE(SA(1,1),a1+hstepA,voffA);
      WAIT_L(8); BAR; WAIT_L(0); MMA(0,0,At,B0); BAR; SCHED;
      LDB(B1,0,1); STAGE(SB(0,0),b2,voffB);
      BAR; WAIT_L(0); MMA(0,1,At,B1); BAR;
      LDA(At,0,1); STAGE(SA(0,0),a2,voffA);
      BAR; WAIT_L(0); MMA(1,0,At,B0); BAR; SCHED;
      STAGE(SB(0,1),b2+hstepB,voffB);
      WAIT_V(6); BAR; MMA(1,1,At,B1); BAR;
      LDB(B0,1,0); SCHED; LDA(At,1,0); STAGE(SA(0,1),a2+hstepA,voffA);
      WAIT_L(8); BAR; WAIT_L(0); MMA(0,0,At,B0); BAR; SCHED;
      LDB(B1,1,1); STAGE(SB(1,0),b3,voffB);
      BAR; WAIT_L(0); MMA(0,1,At,B1); BAR;
      LDA(At,1,1); STAGE(SA(1,0),a3,voffA);
      BAR; WAIT_L(0); MMA(1,0,At,B0); BAR; SCHED;
      STAGE(SB(1,1),b3+hstepB,voffB);
      WAIT_V(6); BAR; MMA(1,1,At,B1); BAR;
    }
    { LDB(B0,0,0); LDA(At,0,0); STAGE(SA(1,1),cA+(size_t)(nt-1)*128+hstepA,voffA);
      BAR; WAIT_L(0); MMA(0,0,At,B0); BAR;
      LDB(B1,0,1); BAR; WAIT_L(0); MMA(0,1,At,B1); BAR;
      LDA(At,0,1); WAIT_V(4); BAR; WAIT_L(0); MMA(1,0,At,B0); MMA(1,1,At,B1); BAR; }
    { LDB(B0,1,0); LDA(At,1,0); WAIT_V(2); BAR; WAIT_L(0); MMA(0,0,At,B0); BAR;
      LDB(B1,1,1); WAIT_V(0); BAR; WAIT_L(0); MMA(0,1,At,B1); BAR;
      LDA(At,1,1); BAR; WAIT_L(0); MMA(1,0,At,B0); MMA(1,1,At,B1); BAR; }
    if(wr==0)BAR;
#pragma unroll
    for (int ai = 0; ai < 2; ++ai)
#pragma unroll
      for (int bj = 0; bj < 2; ++bj) epi(acc[ai][bj], brow + ai * HALF + wr * 64, bcol + bj * HALF + wc * 32 + ks * 1024, fr, fq);
    epi.post(brow, pn);
  }
  #undef SA
  #undef SB
  #undef STAGE
  #undef LDA
  #undef LDB
  #undef MMA
  #undef WAIT_V
  #undef WAIT_L
  #undef BAR
  #undef SCHED
}

struct EpiWin0 {
  bf16_t* FQ; bf16_t* FKV; float* FKR; bf16_t* FRW; float* RSQ;
  template <int NN> DI void operator()(f32x4 (&acc)[4][NN], int rb, int cb, int fr, int fq) const {
    if (cb < 640) {
      const bool isq = cb < 384; bf16_t* dst = isq ? FQ : FKV; const int ld = isq ? 384 : 256; const int co = isq ? cb : cb - 384;
#pragma unroll
      for (int m = 0; m < 4; ++m) {
        const int row = rb + m * 16 + fr; float s = 0.f;
#pragma unroll
        for (int n = 0; n < NN; ++n) {
          const f32x4 v = acc[m][n]; s += v[0] * v[0] + v[1] * v[1] + v[2] * v[2] + v[3] * v[3];
          *(u32x2*)(dst + (size_t)row * ld + co + n * 16 + fq * 4) = pack4(v);
        }
        s += __shfl_xor(s, 16); s += __shfl_xor(s, 32);
        if (fq == 0) atomicAdd(&RSQ[row * 2 + (isq ? 0 : 1)], s);
      }
    } else {
#pragma unroll
      for (int m = 0; m < 4; ++m) {
        const int row = rb + m * 16 + fr;
#pragma unroll
        for (int n = 0; n < NN; ++n) {
          const int cs = cb + n * 16, c = cs + fq * 4;
          if (cs < 672) *(f32x4*)(FKR + (size_t)row * 32 + (c - 640)) = acc[m][n];
          else if (cs < 2592) *(u32x2*)(FRW + (size_t)row * 1920 + (c - 672)) = pack4(acc[m][n]);
        }
      }
    }
  }
  DI void post(int, int) const {}
};
struct EpiQ {
  bf16_t* Q; const float* RSQ; const float* ROPE;
  template <int NN> DI void operator()(f32x4 (&acc)[4][NN], int rb, int cb, int fr, int fq) const {
#pragma unroll
    for (int m = 0; m < 4; ++m) {
      const int row = rb + m * 16 + fr;
      const float rs = rsqrtf(RSQ[row * 2] * (1.f / 384.f) + 1e-6f);
      const int b = row / TB, j = row - b * TB; const bool latent = j >= NCX; const int nl = j - NCX;
#pragma unroll
      for (int n = 0; n < NN; ++n) {
        const int cs = cb + n * 16, within = cs % 96;
        f32x4 v = acc[m][n] * rs;
        if (within >= 64) {
          f32x4 pr;
#pragma unroll
          for (int e = 0; e < 4; ++e) pr[e] = __shfl_xor(v[e], 32);
          if (latent) {
            const int axis = (within - 64) >> 4; const int pos = axis ? (nl & 63) : (nl >> 6);
            const float* tb = ROPE + (pos * 8 + (fq & 1) * 4) * 2;
#pragma unroll
            for (int e = 0; e < 4; ++e) { const float c = tb[e * 2], s = tb[e * 2 + 1]; v[e] = (fq & 2) ? v[e] * c + pr[e] * s : v[e] * c - pr[e] * s; }
          }
        }
        *(u32x2*)(Q + (size_t)row * 768 + cs + fq * 4) = pack4(v);
      }
    }
  }
  DI void post(int, int) const {}
};
struct EpiKn {
  bf16_t* Kb; const float* RSQ; const float* FKR; const float* ROPE;
  template <int NN> DI void operator()(f32x4 (&acc)[4][NN], int rb, int cb, int fr, int fq) const {
#pragma unroll
    for (int m = 0; m < 4; ++m) {
      const int row = rb + m * 16 + fr;
      const float rs = rsqrtf(RSQ[row * 2 + 1] * (1.f / 256.f) + 1e-6f);
#pragma unroll
      for (int n = 0; n < NN; ++n) {
        const int cs = cb + n * 16, hh = cs >> 6, off = (cs & 63) + fq * 4;
        *(u32x2*)(Kb + (size_t)row * 768 + hh * 96 + off) = pack4(acc[m][n] * rs);
      }
    }
  }
  DI void post(int row0, int nt) const {
    if (nt != 0) return;
    const int tid = threadIdx.x, row = row0 + (tid >> 1), axis = tid & 1;
    const int b = row / TB, j = row - b * TB; const bool latent = j >= NCX; const int nl = j - NCX;
    const float* src = FKR + (size_t)row * 32 + axis * 16;
    float x[16];
#pragma unroll
    for (int e = 0; e < 4; ++e) { const f32x4 v = *(const f32x4*)(src + e * 4); x[e * 4] = v[0]; x[e * 4 + 1] = v[1]; x[e * 4 + 2] = v[2]; x[e * 4 + 3] = v[3]; }
    if (latent) {
      const int pos = axis ? (nl & 63) : (nl >> 6);
      const float* tb = ROPE + pos * 16;
#pragma unroll
      for (int f = 0; f < 8; ++f) { const float c = tb[f * 2], s = tb[f * 2 + 1], x1 = x[f], x2 = x[8 + f]; x[f] = x1 * c - x2 * s; x[8 + f] = x2 * c + x1 * s; }
    }
    u32x4 w0, w1;
    w0.x = cvtpk(x[0], x[1]); w0.y = cvtpk(x[2], x[3]); w0.z = cvtpk(x[4], x[5]); w0.w = cvtpk(x[6], x[7]);
    w1.x = cvtpk(x[8], x[9]); w1.y = cvtpk(x[10], x[11]); w1.z = cvtpk(x[12], x[13]); w1.w = cvtpk(x[14], x[15]);
#pragma unroll
    for (int hh = 0; hh < 8; ++hh) { bf16_t* d = Kb + (size_t)row * 768 + hh * 96 + 64 + axis * 16; *(u32x4*)d = w0; *(u32x4*)(d + 8) = w1; }
  }
};
struct EpiVt {
  bf16_t* VTP; const float* RSQ;
  template <int NN> DI void operator()(f32x4 (&acc)[4][NN], int rb, int cb, int fr, int fq) const {
#pragma unroll
    for (int n = 0; n < NN; ++n) {
      const int c = cb + n * 16 + fq * 4;
      f32x4 rs;
#pragma unroll
      for (int e = 0; e < 4; ++e) rs[e] = rsqrtf(RSQ[(c + e) * 2 + 1] * (1.f / 256.f) + 1e-6f);
#pragma unroll
      for (int m = 0; m < 4; ++m) { const int row = rb + m * 16 + fr; *(u32x2*)(VTP + (size_t)row * MT + c) = pack4(acc[m][n] * rs); }
    }
  }
  DI void post(int, int) const {}
};
struct EpiRes {
  const float* xin; const float* cin; float* XA; const float* mods; int goff; int from_input; float alpha;
  const float* stats; const float* lng; const float* lnb;
  template <int NN> DI void operator()(f32x4 (&acc)[4][NN], int rb, int cb, int fr, int fq) const {
#pragma unroll
    for (int m = 0; m < 4; ++m) {
      const int row = rb + m * 16 + fr;
      const float* gp = mods + modrow_of(row) * 6144 + goff;
      const int b_ = row / TB, j_ = row - b_ * TB;
      const float* src = from_input ? (j_ < NCX ? cin + (size_t)(b_ * NCX + j_) * 1024 : xin + (size_t)(b_ * 2048 + j_ - NCX) * 1024) : XA + (size_t)row * 1024;
      float mean = 0.f, rstd = 1.f;
      if (stats) { const f32x2 st = *(const f32x2*)(stats + (size_t)row * 2); mean = st[0]; rstd = st[1]; }
#pragma unroll
      for (int n = 0; n < NN; ++n) {
        const int c = cb + n * 16 + fq * 4;
        f32x4 xv = *(const f32x4*)(src + c); const f32x4 gv = *(const f32x4*)(gp + c);
        if (stats) xv = (xv - mean) * rstd * *(const f32x4*)(lng + c) + *(const f32x4*)(lnb + c);
        *(f32x4*)(XA + (size_t)row * 1024 + c) = alpha * xv + gv * acc[m][n];
      }
    }
  }
  DI void post(int, int) const {}
};
struct EpiPartial {
  float* P; int slot0; int compact;
  template <int NN> DI void operator()(f32x4 (&acc)[4][NN], int rb, int cb, int fr, int fq) const {
    const int ks = cb >> 10, c0 = cb & 1023;
#pragma unroll
    for (int m = 0; m < 4; ++m) {
      const int row = rb + m * 16 + fr, b_ = row / TB, cr = compact ? row : b_ * NCX + (row - b_ * TB);
      float* dst = P + ((size_t)(slot0 + ks) * 2048 + cr) * 1024 + c0 + fq * 4;
#pragma unroll
      for (int n = 0; n < NN; ++n) *(f32x4*)(dst + n * 16) = acc[m][n];
    }
  }
  DI void post(int, int) const {}
};
struct EpiGlt {
  bf16_t* GLT;
  template <int NN> DI void operator()(f32x4 (&acc)[4][NN], int rb, int cb, int fr, int fq) const {
    if (cb >= 32) return;
#pragma unroll
    for (int m = 0; m < 4; ++m) {
      const int row = rb + m * 16 + fr;
#pragma unroll
      for (int n = 0; n < NN; ++n) *(u32x2*)(GLT + (size_t)row * 32 + cb + n * 16 + fq * 4) = pack4(acc[m][n]);
    }
  }
  DI void post(int, int) const {}
};
struct EpiMlp1 {
  bf16_t* H1;
  template <int NN> DI void operator()(f32x4 (&acc)[4][NN], int rb, int cb, int fr, int fq) const {
#pragma unroll
    for (int m = 0; m < 4; ++m) {
      const int row = rb + m * 16 + fr;
#pragma unroll
      for (int n = 0; n < NN; ++n) {
        f32x4 v = acc[m][n];
#pragma unroll
        for (int e = 0; e < 4; ++e) { const float r = fmaxf(v[e], 0.f); v[e] = r * r; }
        *(u32x2*)(H1 + (size_t)row * 2048 + cb + n * 16 + fq * 4) = pack4(v);
      }
    }
  }
  DI void post(int, int) const {}
};
struct EpiMlp1Ctx {
  bf16_t* H1c;
  template <int NN> DI void operator()(f32x4 (&acc)[4][NN], int rb, int cb, int fr, int fq) const {
#pragma unroll
    for (int m = 0; m < 4; ++m) {
      const int row = rb + m * 16 + fr, b_ = row / TB, cr = b_ * NCX + (row - b_ * TB);
#pragma unroll
      for (int n = 0; n < NN; ++n) {
        f32x4 v = acc[m][n];
#pragma unroll
        for (int e = 0; e < 4; ++e) { const float r = fmaxf(v[e], 0.f); v[e] = r * r; }
        *(u32x2*)(H1c + (size_t)cr * 4096 + cb + n * 16 + fq * 4) = pack4(v);
      }
    }
  }
  DI void post(int, int) const {}
};
struct EpiWin1 {
  bf16_t* GATE; bf16_t* XR;
  template <int NN> DI void operator()(f32x4 (&acc)[4][NN], int rb, int cb, int fr, int fq) const {
#pragma unroll
    for (int m = 0; m < 4; ++m) {
      const int row = rb + m * 16 + fr;
#pragma unroll
      for (int n = 0; n < NN; ++n) {
        const int c = cb + n * 16 + fq * 4;
        f32x4 v = acc[m][n];
        if (cb < 1024) {
#pragma unroll
          for (int e = 0; e < 4; ++e) v[e] = gelu_tanh(v[e]);
          *(u32x2*)(GATE + (size_t)row * 1024 + c) = pack4(v);
        } else *(u32x2*)(XR + (size_t)row * 1024 + c - 1024) = pack4(v);
      }
    }
  }
  DI void post(int, int) const {}
};

DI void attn_unit(const Params& p, int u, char* smem) {
  const int tid = VT, lane = tid & 63, wid = tid >> 6, r32 = lane & 31, hi = lane >> 5;
  int b, h, qrow0, nkeys;
  if (u < 1024) { b = u >> 7; h = (u >> 4) & 7; qrow0 = b * TB + NCX + (u & 15) * 128; nkeys = TB; }
  else { const int v = u - 1024; b = v >> 4; h = (v >> 1) & 7; qrow0 = b * TB + (v & 1) * 128; nkeys = NCX; }
  const int key0 = b * TB;
  const bf16_t* Q = (const bf16_t*)(p.ws + O_Q); const bf16_t* Kb = (const bf16_t*)(p.ws + O_K);
  const bf16_t* VTP = (const bf16_t*)((const char*)p.out + OO_VT);
  bf16_t* CAT = (bf16_t*)(p.ws + O_A);
  char* sK = smem; char* sV = smem + 64 * 208;
  const int qrow = qrow0 + wid * 32 + r32;
  bf16x8 qf[6];
  {
    const bf16_t* qp = Q + (size_t)qrow * 768 + h * 96 + hi * 8;
#pragma unroll
    for (int d0 = 0; d0 < 6; ++d0) qf[d0] = *(const bf16x8*)(qp + d0 * 16);
  }
  f32x16 o0, o1;
#pragma unroll
  for (int r = 0; r < 16; ++r) { o0[r] = 0.f; o1[r] = 0.f; }
  float mrun = -1e30f, lrun = 0.f;
  constexpr float C = 0.10206207261596575f * 1.4426950408889634f;
  const bf16_t* gk[3]; int lk[3];
#pragma unroll
  for (int i = 0; i < 3; ++i) { const int c = tid + i * 256, kr = c / 12, kc = c - kr * 12; gk[i] = Kb + (size_t)(key0 + kr) * 768 + h * 96 + kc * 8; lk[i] = kr * 208 + kc * 16; }
  const bf16_t* gv[2]; int lv[2];
#pragma unroll
  for (int i = 0; i < 2; ++i) { const int c = tid + i * 256, vr = c >> 3, vc = c & 7; gv[i] = VTP + (size_t)(h * 64 + vr) * MT + key0 + vc * 8; lv[i] = vr * 144 + vc * 16; }
  u32x4 rk[3], rv[2];
#pragma unroll
  for (int i = 0; i < 3; ++i) rk[i] = *(const u32x4*)(gk[i]);
#pragma unroll
  for (int i = 0; i < 2; ++i) rv[i] = *(const u32x4*)(gv[i]);
  for (int k0 = 0; k0 < nkeys; k0 += 64) {
    __syncthreads();
#pragma unroll
    for (int i = 0; i < 3; ++i) *(u32x4*)(sK + lk[i]) = rk[i];
#pragma unroll
    for (int i = 0; i < 2; ++i) *(u32x4*)(sV + lv[i]) = rv[i];
    __syncthreads();
    if (k0 + 64 < nkeys) {
#pragma unroll
      for (int i = 0; i < 3; ++i) rk[i] = *(const u32x4*)(gk[i] + (size_t)(k0 + 64) * 768);
#pragma unroll
      for (int i = 0; i < 2; ++i) rv[i] = *(const u32x4*)(gv[i] + k0 + 64);
    }
    f32x16 p0, p1;
#pragma unroll
    for (int r = 0; r < 16; ++r) { p0[r] = 0.f; p1[r] = 0.f; }
#pragma unroll
    for (int d0 = 0; d0 < 6; ++d0) {
      const bf16x8 k0f = *(const bf16x8*)(sK + r32 * 208 + d0 * 32 + hi * 16);
      const bf16x8 k1f = *(const bf16x8*)(sK + (32 + r32) * 208 + d0 * 32 + hi * 16);
      p0 = mfma32(k0f, qf[d0], p0); p1 = mfma32(k1f, qf[d0], p1);
    }
    float tmax = p0[0];
#pragma unroll
    for (int r = 1; r < 16; ++r) tmax = fmaxf(tmax, p0[r]);
#pragma unroll
    for (int r = 0; r < 16; ++r) tmax = fmaxf(tmax, p1[r]);
    tmax = fmaxf(tmax, __shfl_xor(tmax, 32));
    const float mn = fmaxf(mrun, tmax);
    const float alpha = exp2f((mrun - mn) * C);
    mrun = mn;
    const float mc = -mn * C;
    float ps = 0.f;
#pragma unroll
    for (int r = 0; r < 16; ++r) { p0[r] = exp2f(fmaf(p0[r], C, mc)); ps += p0[r]; }
#pragma unroll
    for (int r = 0; r < 16; ++r) { p1[r] = exp2f(fmaf(p1[r], C, mc)); ps += p1[r]; }
    ps += __shfl_xor(ps, 32);
    lrun = lrun * alpha + ps;
#pragma unroll
    for (int r = 0; r < 16; ++r) { o0[r] *= alpha; o1[r] *= alpha; }
#pragma unroll
    for (int ks = 0; ks < 4; ++ks) {
      u32x4 pw;
      if (ks == 0) { pw.x = cvtpk(p0[0], p0[1]); pw.y = cvtpk(p0[2], p0[3]); pw.z = cvtpk(p0[4], p0[5]); pw.w = cvtpk(p0[6], p0[7]); }
      else if (ks == 1) { pw.x = cvtpk(p0[8], p0[9]); pw.y = cvtpk(p0[10], p0[11]); pw.z = cvtpk(p0[12], p0[13]); pw.w = cvtpk(p0[14], p0[15]); }
      else if (ks == 2) { pw.x = cvtpk(p1[0], p1[1]); pw.y = cvtpk(p1[2], p1[3]); pw.z = cvtpk(p1[4], p1[5]); pw.w = cvtpk(p1[6], p1[7]); }
      else { pw.x = cvtpk(p1[8], p1[9]); pw.y = cvtpk(p1[10], p1[11]); pw.z = cvtpk(p1[12], p1[13]); pw.w = cvtpk(p1[14], p1[15]); }
      const bf16x8 pf = *(const bf16x8*)&pw;
      const int kb = ks * 16 + hi * 4;
      u32x4 va, vb;
      { const u32x2 a0 = *(const u32x2*)(sV + r32 * 144 + kb * 2), a1 = *(const u32x2*)(sV + r32 * 144 + (kb + 8) * 2); va.x = a0.x; va.y = a0.y; va.z = a1.x; va.w = a1.y; }
      { const u32x2 a0 = *(const u32x2*)(sV + (32 + r32) * 144 + kb * 2), a1 = *(const u32x2*)(sV + (32 + r32) * 144 + (kb + 8) * 2); vb.x = a0.x; vb.y = a0.y; vb.z = a1.x; vb.w = a1.y; }
      o0 = mfma32(*(const bf16x8*)&va, pf, o0);
      o1 = mfma32(*(const bf16x8*)&vb, pf, o1);
    }
  }
  const float inv = 1.f / lrun;
  bf16_t* op = CAT + (size_t)qrow * 1024 + h * 64 + hi * 4;
#pragma unroll
  for (int g = 0; g < 4; ++g) {
    u32x2 w; w.x = cvtpk(o0[g * 4] * inv, o0[g * 4 + 1] * inv); w.y = cvtpk(o0[g * 4 + 2] * inv, o0[g * 4 + 3] * inv);
    *(u32x2*)(op + g * 8) = w;
    w.x = cvtpk(o1[g * 4] * inv, o1[g * 4 + 1] * inv); w.y = cvtpk(o1[g * 4 + 2] * inv, o1[g * 4 + 3] * inv);
    *(u32x2*)(op + 32 + g * 8) = w;
  }
}

DI void unpack8(u32x4 w, float* f) {
  f[0] = lo_f(w.x); f[1] = hi_f(w.x); f[2] = lo_f(w.y); f[3] = hi_f(w.y); f[4] = lo_f(w.z); f[5] = hi_f(w.z); f[6] = lo_f(w.w); f[7] = hi_f(w.w);
}
DI int scan_row(int d, int gi) { return d == 0 ? gi : (gi < NCX ? NCX - 1 - gi : TB - 1 - (gi - NCX)); }
DI void scan_unit(const Params& p, int u, char* smem) {
  const int tid = VT, lane = tid & 63, wid = tid >> 6, fr = lane & 15, fq = lane >> 4;
  const int half = u & 1, d = (u >> 1) & 1, h = (u >> 2) & 7, b = u >> 5;
  float* R_ = (float*)smem; float* KD_ = R_ + 2048; float* KK_ = KD_ + 2048; float* WD_ = KK_ + 2048; float* BV_ = WD_ + 2048;
  float* V_ = BV_ + 2048; float* YO_ = V_ + 1024; char* TW_ = (char*)(YO_ + 1024); char* AL_ = TW_ + 32 * 144;
  float* NRM_ = (float*)(AL_ + 32 * 144); float* BONS_ = NRM_ + 32;
  const bf16_t* FRW = (const bf16_t*)(p.ws + O_FRW);
  const float* mu = p.in[12];
  float* Y = (float*)((char*)p.out + OO_Y);
  float* BON = (float*)(p.ws + O_BON);
  const int hc = h * 64 + wid * 16 + fr;
  bf16x8 w2f0, w2f1, a2f0, a2f1;
  {
    const bf16_t* w2t = (const bf16_t*)(p.ws + O_W2T) + (size_t)(d * 512 + hc) * 64 + fq * 8;
    const bf16_t* a2t = (const bf16_t*)(p.ws + O_A2T) + (size_t)(d * 512 + hc) * 64 + fq * 8;
    w2f0 = *(const bf16x8*)w2t; w2f1 = *(const bf16x8*)(w2t + 32);
    a2f0 = *(const bf16x8*)a2t; a2f1 = *(const bf16x8*)(a2t + 32);
  }
  const float w0c = p.in[13][d * 512 + hc], a0c = p.in[15][d * 512 + hc], kkc = p.in[18][hc], kac = p.in[19][hc], rkc = p.in[20][hc];
  const int il = tid >> 3, js = tid & 7;
  f32x2 S0 = {0.f, 0.f}, S1 = {0.f, 0.f}, S2 = {0.f, 0.f}, S3 = {0.f, 0.f};
  if (tid < 32) { NRM_[tid] = 0.f; BONS_[tid] = 0.f; }
  __syncthreads();
  for (int ci = 0; ci < 72; ++ci) {
    for (int it = tid; it < 1152; it += 256) {
      const int s = it / 36, g = it - s * 36;
      const int j = scan_row(d, ci * 32 + s);
      const size_t row = (size_t)b * TB + j;
      int col;
      if (g < 8) col = h * 64 + g * 8; else if (g < 16) col = 512 + h * 64 + (g - 8) * 8; else if (g < 20) col = 1024 + h * 64 + half * 32 + (g - 16) * 8;
      else if (g < 28) col = 1536 + d * 64 + (g - 20) * 8; else col = 1664 + d * 64 + (g - 28) * 8;
      const bool pv = (j != 0 && j != NCX), nv = (j != NCX - 1 && j != TB - 1);
      const u32x4 z4 = {0u, 0u, 0u, 0u};
      const u32x4 fc = *(const u32x4*)(FRW + row * 1920 + col);
      const u32x4 fp = pv ? *(const u32x4*)(FRW + (row - 1) * 1920 + col) : z4;
      const u32x4 fn = nv ? *(const u32x4*)(FRW + (row + 1) * 1920 + col) : z4;
      float xc[8], xp[8], xn[8], xs[8], mm[8];
      unpack8(fc, xc); unpack8(fp, xp); unpack8(fn, xn);
      { const f32x4 m0 = *(const f32x4*)(mu + col), m1 = *(const f32x4*)(mu + col + 4); mm[0] = m0[0]; mm[1] = m0[1]; mm[2] = m0[2]; mm[3] = m0[3]; mm[4] = m1[0]; mm[5] = m1[1]; mm[6] = m1[2]; mm[7] = m1[3]; }
#pragma unroll
      for (int e = 0; e < 8; ++e) xs[e] = xc[e] + mm[e] * (0.5f * (xp[e] + xn[e]) - xc[e]);
      if (g < 16) {
        float* dst = (g < 8 ? R_ + s * 64 + g * 8 : KD_ + s * 64 + (g - 8) * 8);
        *(f32x4*)dst = (f32x4){xs[0], xs[1], xs[2], xs[3]}; *(f32x4*)(dst + 4) = (f32x4){xs[4], xs[5], xs[6], xs[7]};
        if (g >= 8) {
          const float* kkp = p.in[18] + h * 64 + (g - 8) * 8; float sq = 0.f;
#pragma unroll
          for (int e = 0; e < 8; ++e) { const float t = xs[e] * kkp[e]; sq += t * t; }
          atomicAdd(&NRM_[s], sq);
        }
      } else if (g < 20) {
        float* dst = V_ + s * 32 + (g - 16) * 8;
        *(f32x4*)dst = (f32x4){xs[0], xs[1], xs[2], xs[3]}; *(f32x4*)(dst + 4) = (f32x4){xs[4], xs[5], xs[6], xs[7]};
      } else if (g < 28) {
        u32x4 w; w.x = cvtpk(tanh_fast(xs[0]), tanh_fast(xs[1])); w.y = cvtpk(tanh_fast(xs[2]), tanh_fast(xs[3])); w.z = cvtpk(tanh_fast(xs[4]), tanh_fast(xs[5])); w.w = cvtpk(tanh_fast(xs[6]), tanh_fast(xs[7]));
        *(u32x4*)(TW_ + s * 144 + (g - 20) * 16) = w;
      } else {
        u32x4 w; w.x = cvtpk(xs[0], xs[1]); w.y = cvtpk(xs[2], xs[3]); w.z = cvtpk(xs[4], xs[5]); w.w = cvtpk(xs[6], xs[7]);
        *(u32x4*)(AL_ + s * 144 + (g - 28) * 16) = w;
      }
    }
    __syncthreads();
    {
#pragma unroll
      for (int m = 0; m < 2; ++m) {
        f32x4 accw = {0.f, 0.f, 0.f, 0.f}, acca = {0.f, 0.f, 0.f, 0.f};
        const bf16x8 t0 = *(const bf16x8*)(TW_ + (m * 16 + fr) * 144 + fq * 16), t1 = *(const bf16x8*)(TW_ + (m * 16 + fr) * 144 + 64 + fq * 16);
        const bf16x8 l0 = *(const bf16x8*)(AL_ + (m * 16 + fr) * 144 + fq * 16), l1 = *(const bf16x8*)(AL_ + (m * 16 + fr) * 144 + 64 + fq * 16);
        accw = mfma16(t0, w2f0, accw); accw = mfma16(t1, w2f1, accw);
        acca = mfma16(l0, a2f0, acca); acca = mfma16(l1, a2f1, acca);
#pragma unroll
        for (int e = 0; e < 4; ++e) {
          const int s = m * 16 + fq * 4 + e, idx = s * 64 + wid * 16 + fr;
          const float sg = sigmoidf_(w0c + accw[e]);
          const float decay = __expf(-0.6065306597126334f * sg);
          const float a = sigmoidf_(a0c + acca[e]);
          const float kraw = KD_[idx];
          const float kkn = kraw * kkc * rsqrtf(NRM_[s] + 1e-12f);
          KK_[idx] = kkn; WD_[idx] = decay; BV_[idx] = kkn * a;
          const float kd = kraw * (1.f + (a - 1.f) * kac);
          KD_[idx] = kd;
          float bon = R_[idx] * kd * rkc;
          bon = red16(bon);
          if (fr == 0) atomicAdd(&BONS_[s], bon);
        }
      }
    }
    __syncthreads();
    if (tid < 32) {
      if (half == 0) { const int j = scan_row(d, ci * 32 + tid); BON[((size_t)d * MT + (size_t)b * TB + j) * 8 + h] = BONS_[tid]; }
      BONS_[tid] = 0.f; NRM_[tid] = 0.f;
    }
#pragma unroll 2
    for (int s = 0; s < 32; ++s) {
      const f32x4* pk = (const f32x4*)(KK_ + s * 64 + js * 8); const f32x4 ka = pk[0], kb = pk[1];
      const f32x4* pw = (const f32x4*)(WD_ + s * 64 + js * 8); const f32x4 wa = pw[0], wb = pw[1];
      const f32x4* pb = (const f32x4*)(BV_ + s * 64 + js * 8); const f32x4 ba = pb[0], bb = pb[1];
      const f32x4* pd = (const f32x4*)(KD_ + s * 64 + js * 8); const f32x4 da = pd[0], db = pd[1];
      const f32x4* pr = (const f32x4*)(R_ + s * 64 + js * 8); const f32x4 ra = pr[0], rb = pr[1];
      const float v = V_[s * 32 + il];
      f32x2 t = S0 * (f32x2){ka[0], ka[1]} + S1 * (f32x2){ka[2], ka[3]};
      f32x2 t2 = S2 * (f32x2){kb[0], kb[1]} + S3 * (f32x2){kb[2], kb[3]};
      t = t + t2;
      const float sa = red8(t[0] + t[1]);
      const f32x2 nsa = {-sa, -sa}, vv = {v, v};
      S0 = S0 * (f32x2){wa[0], wa[1]} + nsa * (f32x2){ba[0], ba[1]} + vv * (f32x2){da[0], da[1]};
      S1 = S1 * (f32x2){wa[2], wa[3]} + nsa * (f32x2){ba[2], ba[3]} + vv * (f32x2){da[2], da[3]};
      S2 = S2 * (f32x2){wb[0], wb[1]} + nsa * (f32x2){bb[0], bb[1]} + vv * (f32x2){db[0], db[1]};
      S3 = S3 * (f32x2){wb[2], wb[3]} + nsa * (f32x2){bb[2], bb[3]} + vv * (f32x2){db[2], db[3]};
      f32x2 y = S0 * (f32x2){ra[0], ra[1]} + S1 * (f32x2){ra[2], ra[3]};
      f32x2 y2 = S2 * (f32x2){rb[0], rb[1]} + S3 * (f32x2){rb[2], rb[3]};
      y = y + y2;
      const float yy = red8(y[0] + y[1]);
      if (js == 0) YO_[s * 32 + il] = yy;
    }
    __syncthreads();
    {
      const int s = tid >> 3, i4 = (tid & 7) * 4;
      const int j = scan_row(d, ci * 32 + s);
      float* yp = Y + ((size_t)b * TB + j) * 512 + h * 64 + half * 32 + i4;
      const f32x4 yv = *(const f32x4*)(YO_ + s * 32 + i4);
      atomicAdd(yp, yv[0]); atomicAdd(yp + 1, yv[1]); atomicAdd(yp + 2, yv[2]); atomicAdd(yp + 3, yv[3]);
    }
  }
  __syncthreads();
}

DI void scan_unit8(const Params& p, int u, char* dsm) {
  const int tid = opaque_tid(), lane = tid & 63, wid = __builtin_amdgcn_readfirstlane(tid >> 6), fr = lane & 15, fq = lane >> 4;
  const int d = u & 1, h = (u >> 1) & 7, b = u >> 4;
  const bool producer = wid >= 4;
  float* FB = (float*)dsm;
  float* YO = FB + 2 * 12288;
  char* TW_ = (char*)(YO + 2 * 2048); char* AL_ = TW_ + 32 * 144;
  float* NRM = (float*)(AL_ + 32 * 144); float* BONS = NRM + 64;
  const bf16_t* FRW = (const bf16_t*)(p.ws + O_FRW);
  const float* mu = p.in[12];
  float* Y = (float*)((char*)p.out + OO_Y);
  float* BON = (float*)(p.ws + O_BON);
  const int pt = tid & 255, pw = wid & 3;
  const int hc = h * 64 + pw * 16 + fr;
  bf16x8 w2f0, w2f1, a2f0, a2f1;
  {
    const bf16_t* w2t = (const bf16_t*)(p.ws + O_W2T) + (size_t)(d * 512 + hc) * 64 + fq * 8;
    const bf16_t* a2t = (const bf16_t*)(p.ws + O_A2T) + (size_t)(d * 512 + hc) * 64 + fq * 8;
    w2f0 = *(const bf16x8*)w2t; w2f1 = *(const bf16x8*)(w2t + 32);
    a2f0 = *(const bf16x8*)a2t; a2f1 = *(const bf16x8*)(a2t + 32);
  }
  const float w0c = p.in[13][d * 512 + hc], a0c = p.in[15][d * 512 + hc], kkc = p.in[18][hc], kac = p.in[19][hc], rkc = p.in[20][hc];
  const int rp = pt >> 3, js = pt & 7;
  f32x2 Sa0 = {0.f, 0.f}, Sa1 = {0.f, 0.f}, Sa2 = {0.f, 0.f}, Sa3 = {0.f, 0.f};
  f32x2 Sb0 = {0.f, 0.f}, Sb1 = {0.f, 0.f}, Sb2 = {0.f, 0.f}, Sb3 = {0.f, 0.f};
  __syncthreads();
  if (tid < 64) { NRM[tid] = 0.f; BONS[tid] = 0.f; }
  __syncthreads();

  auto S1 = [&](int ci) {
    float* F = FB + (ci & 1) * 12288; float* nrm = NRM + (ci & 1) * 32;
    u32x4 fc[5], fp[5], fn[5];
#pragma unroll
    for (int k = 0; k < 5; ++k) {
      const int it = pt + k * 256, s = it / 40, g = it - s * 40;
      const int j = scan_row(d, ci * 32 + s);
      const size_t row = (size_t)b * TB + j;
      const int col = (g < 24 ? (g >> 3) * 512 + h * 64 + (g & 7) * 8 : (g < 32 ? 1536 + d * 64 + (g - 24) * 8 : 1664 + d * 64 + (g - 32) * 8));
      const bool pv = (j != 0 && j != NCX), nv = (j != NCX - 1 && j != TB - 1);
      const u32x4 z4 = {0u, 0u, 0u, 0u};
      fc[k] = *(const u32x4*)(FRW + row * 1920 + col);
      fp[k] = pv ? *(const u32x4*)(FRW + (row - 1) * 1920 + col) : z4;
      fn[k] = nv ? *(const u32x4*)(FRW + (row + 1) * 1920 + col) : z4;
    }
#pragma unroll
    for (int k = 0; k < 5; ++k) {
      const int it = pt + k * 256, s = it / 40, g = it - s * 40;
      const int col = (g < 24 ? (g >> 3) * 512 + h * 64 + (g & 7) * 8 : (g < 32 ? 1536 + d * 64 + (g - 24) * 8 : 1664 + d * 64 + (g - 32) * 8));
      float xc[8], xp[8], xn[8], xs[8], mm[8];
      unpack8(fc[k], xc); unpack8(fp[k], xp); unpack8(fn[k], xn);
      { const f32x4 m0 = *(const f32x4*)(mu + col), m1 = *(const f32x4*)(mu + col + 4); mm[0] = m0[0]; mm[1] = m0[1]; mm[2] = m0[2]; mm[3] = m0[3]; mm[4] = m1[0]; mm[5] = m1[1]; mm[6] = m1[2]; mm[7] = m1[3]; }
#pragma unroll
      for (int e = 0; e < 8; ++e) xs[e] = xc[e] + mm[e] * (0.5f * (xp[e] + xn[e]) - xc[e]);
      if (g < 24) {
        float* dst = (g < 8 ? F + s * 64 + g * 8 : (g < 16 ? F + 2048 + s * 64 + (g - 8) * 8 : F + 10240 + s * 64 + (g - 16) * 8));
        *(f32x4*)dst = (f32x4){xs[0], xs[1], xs[2], xs[3]}; *(f32x4*)(dst + 4) = (f32x4){xs[4], xs[5], xs[6], xs[7]};
        if (g >= 8 && g < 16) {
          const float* kkp = p.in[18] + h * 64 + (g - 8) * 8; float sq = 0.f;
#pragma unroll
          for (int e = 0; e < 8; ++e) { const float t = xs[e] * kkp[e]; sq += t * t; }
          atomicAdd(&nrm[s], sq);
        }
      } else if (g < 32) {
        u32x4 w; w.x = cvtpk(tanh_fast(xs[0]), tanh_fast(xs[1])); w.y = cvtpk(tanh_fast(xs[2]), tanh_fast(xs[3])); w.z = cvtpk(tanh_fast(xs[4]), tanh_fast(xs[5])); w.w = cvtpk(tanh_fast(xs[6]), tanh_fast(xs[7]));
        *(u32x4*)(TW_ + s * 144 + (g - 24) * 16) = w;
      } else {
        u32x4 w; w.x = cvtpk(xs[0], xs[1]); w.y = cvtpk(xs[2], xs[3]); w.z = cvtpk(xs[4], xs[5]); w.w = cvtpk(xs[6], xs[7]);
        *(u32x4*)(AL_ + s * 144 + (g - 32) * 16) = w;
      }
    }
  };
  auto S2 = [&](int ci) {
    float* F = FB + (ci & 1) * 12288; float* R_ = F; float* KD_ = F + 2048; float* KK_ = F + 4096; float* WD_ = F + 6144; float* BV_ = F + 8192;
    const float* nrm = NRM + (ci & 1) * 32; float* bons = BONS + (ci & 1) * 32;
#pragma unroll
    for (int m = 0; m < 2; ++m) {
      f32x4 accw = {0.f, 0.f, 0.f, 0.f}, acca = {0.f, 0.f, 0.f, 0.f};
      const bf16x8 t0 = *(const bf16x8*)(TW_ + (m * 16 + fr) * 144 + fq * 16), t1 = *(const bf16x8*)(TW_ + (m * 16 + fr) * 144 + 64 + fq * 16);
      const bf16x8 l0 = *(const bf16x8*)(AL_ + (m * 16 + fr) * 144 + fq * 16), l1 = *(const bf16x8*)(AL_ + (m * 16 + fr) * 144 + 64 + fq * 16);
      accw = mfma16(t0, w2f0, accw); accw = mfma16(t1, w2f1, accw);
      acca = mfma16(l0, a2f0, acca); acca = mfma16(l1, a2f1, acca);
#pragma unroll
      for (int e = 0; e < 4; ++e) {
        const int s = m * 16 + fq * 4 + e, idx = s * 64 + pw * 16 + fr;
        const float sg = sigmoidf_(w0c + accw[e]);
        const float decay = __expf(-0.6065306597126334f * sg);
        const float a = sigmoidf_(a0c + acca[e]);
        const float kraw = KD_[idx];
        const float kkn = kraw * kkc * rsqrtf(nrm[s] + 1e-12f);
        KK_[idx] = kkn; WD_[idx] = decay; BV_[idx] = kkn * a;
        const float kd = kraw * (1.f + (a - 1.f) * kac);
        KD_[idx] = kd;
        float bon = R_[idx] * kd * rkc;
        bon = red16(bon);
        if (fr == 0) atomicAdd(&bons[s], bon);
      }
    }
    if (pt < 32) NRM[((ci & 1) ^ 1) * 32 + pt] = 0.f;
  };
  struct StepVec { f32x4 ra, rb, da, db, ka, kb, wa, wb, ba, bb; f32x2 v2; };
  auto LOADV = [&](StepVec& X, const float* F, int s) {
    const f32x4* pr = (const f32x4*)(F + s * 64 + js * 8); X.ra = pr[0]; X.rb = pr[1];
    const f32x4* pd = (const f32x4*)(F + 2048 + s * 64 + js * 8); X.da = pd[0]; X.db = pd[1];
    const f32x4* pk = (const f32x4*)(F + 4096 + s * 64 + js * 8); X.ka = pk[0]; X.kb = pk[1];
    const f32x4* pw_ = (const f32x4*)(F + 6144 + s * 64 + js * 8); X.wa = pw_[0]; X.wb = pw_[1];
    const f32x4* pb = (const f32x4*)(F + 8192 + s * 64 + js * 8); X.ba = pb[0]; X.bb = pb[1];
    X.v2 = *(const f32x2*)(F + 10240 + s * 64 + rp * 2);
  };
  auto STEP = [&](const StepVec& X, float* yo, int s) {
    const f32x2 k01 = {X.ka[0], X.ka[1]}, k23 = {X.ka[2], X.ka[3]}, k45 = {X.kb[0], X.kb[1]}, k67 = {X.kb[2], X.kb[3]};
    f32x2 ta = Sa0 * k01 + Sa1 * k23; ta = ta + (Sa2 * k45 + Sa3 * k67);
    f32x2 tb = Sb0 * k01 + Sb1 * k23; tb = tb + (Sb2 * k45 + Sb3 * k67);
    const float saa = red8(ta[0] + ta[1]), sab = red8(tb[0] + tb[1]);
    const f32x2 w01 = {X.wa[0], X.wa[1]}, w23 = {X.wa[2], X.wa[3]}, w45 = {X.wb[0], X.wb[1]}, w67 = {X.wb[2], X.wb[3]};
    const f32x2 b01 = {X.ba[0], X.ba[1]}, b23 = {X.ba[2], X.ba[3]}, b45 = {X.bb[0], X.bb[1]}, b67 = {X.bb[2], X.bb[3]};
    const f32x2 d01 = {X.da[0], X.da[1]}, d23 = {X.da[2], X.da[3]}, d45 = {X.db[0], X.db[1]}, d67 = {X.db[2], X.db[3]};
    { const f32x2 ns = {-saa, -saa}, vv = {X.v2[0], X.v2[0]};
      Sa0 = Sa0 * w01 + ns * b01 + vv * d01; Sa1 = Sa1 * w23 + ns * b23 + vv * d23; Sa2 = Sa2 * w45 + ns * b45 + vv * d45; Sa3 = Sa3 * w67 + ns * b67 + vv * d67; }
    { const f32x2 ns = {-sab, -sab}, vv = {X.v2[1], X.v2[1]};
      Sb0 = Sb0 * w01 + ns * b01 + vv * d01; Sb1 = Sb1 * w23 + ns * b23 + vv * d23; Sb2 = Sb2 * w45 + ns * b45 + vv * d45; Sb3 = Sb3 * w67 + ns * b67 + vv * d67; }
    const f32x2 r01 = {X.ra[0], X.ra[1]}, r23 = {X.ra[2], X.ra[3]}, r45 = {X.rb[0], X.rb[1]}, r67 = {X.rb[2], X.rb[3]};
    f32x2 ya = Sa0 * r01 + Sa1 * r23; ya = ya + (Sa2 * r45 + Sa3 * r67);
    f32x2 yb = Sb0 * r01 + Sb1 * r23; yb = yb + (Sb2 * r45 + Sb3 * r67);
    const float y0 = red8_ns(ya[0] + ya[1]), y1 = red8(yb[0] + yb[1]);
    if (js == 0) *(f32x2*)(yo + s * 64 + rp * 2) = (f32x2){y0, y1};
  };
  auto SCAN = [&](int ci, int s0) {
    const float* F = FB + (ci & 1) * 12288; float* yo = YO + (ci & 1) * 2048;
    StepVec A, B;
    LOADV(A, F, s0);
#pragma unroll 1
    for (int s = s0; s < s0 + 16; s += 2) {
      LOADV(B, F, s + 1);
      STEP(A, yo, s);
      LOADV(A, F, s + 2);
      STEP(B, yo, s + 1);
    }
  };

  if (producer) S1(0);
  __syncthreads();
  if (producer) S2(0);
  __syncthreads();
  for (int ci = 0; ci < 72; ++ci) {
    if (producer) {
      if (pt < 32) { float* bons = BONS + (ci & 1) * 32; const int j = scan_row(d, ci * 32 + pt); BON[((size_t)d * MT + (size_t)b * TB + j) * 8 + h] = bons[pt]; bons[pt] = 0.f; }
      if (ci + 1 < 72) S1(ci + 1);
    } else SCAN(ci, 0);
    __syncthreads();
    if (producer) { if (ci + 1 < 72) S2(ci + 1); }
    else SCAN(ci, 16);
    __syncthreads();
    if (!producer) {
      const float* yo = YO + (ci & 1) * 2048;
      const int s = pt >> 3, i8 = (pt & 7) * 8;
      const int j = scan_row(d, ci * 32 + s);
      bf16_t* yp = (bf16_t*)((char*)p.out + OO_Y) + (size_t)d * MT * 512 + ((size_t)b * TB + j) * 512 + h * 64 + i8;
      const f32x4 y0 = *(const f32x4*)(yo + s * 64 + i8), y1 = *(const f32x4*)(yo + s * 64 + i8 + 4);
      u32x4 w; w.x = cvtpk(y0[0], y0[1]); w.y = cvtpk(y0[2], y0[3]); w.z = cvtpk(y1[0], y1[1]); w.w = cvtpk(y1[2], y1[3]);
      *(u32x4*)yp = w;
    }
  }
  __syncthreads();
}

DI unsigned sb_ld(unsigned* q) { return __hip_atomic_load(q, __ATOMIC_RELAXED, __HIP_MEMORY_SCOPE_AGENT); }
DI void qkv_work(const Params& p, char* dsm, int b3, int n3) {
  char* ws = p.ws;
  EpiQ eq{(bf16_t*)(ws + O_Q), (const float*)(ws + O_RSQ), (const float*)(ws + O_ROPE)};
  gemm8_phase((const bf16_t*)(ws + O_FQ), 384, (const bf16_t*)(ws + O_WUQ), 384, 384, 72, 3, 0, 0, eq, dsm, b3, n3);
  EpiKn ek{(bf16_t*)(ws + O_K), (const float*)(ws + O_RSQ), (const float*)(ws + O_FKR), (const float*)(ws + O_ROPE)};
  gemm8_phase((const bf16_t*)(ws + O_FKV), 256, (const bf16_t*)(ws + O_WUK), 256, 256, 72, 2, 0, 0, ek, dsm, (b3 + n3 - (216 % n3)) % n3, n3);
  EpiVt ev{(bf16_t*)((char*)p.out + OO_VT), (const float*)(ws + O_RSQ)};
  gemm8_phase((const bf16_t*)(ws + O_WUV), 256, (const bf16_t*)(ws + O_FKV), 256, 256, 2, 72, 0, 0, ev, dsm, (b3 + n3 - (104 % n3)) % n3, n3);
  EpiGlt eg{(bf16_t*)(ws + O_GLT)};
  gemm8_phase((const bf16_t*)(ws + O_A), 1024, (const bf16_t*)(ws + O_WTAIL), 1024, 1024, 72, 1, 0, 0, eg, dsm, (b3 + n3 - (16 % n3)) % n3, n3);
}
DI void phase_mixer(const Params& p, char* smem, char* dsm, int bid, int nb) {
  unsigned* cnt = (unsigned*)(p.ws + O_CNT);
  const int pbid = blockIdx.x, pnb = gridDim.x;
  const int q0 = pnb >= 192 ? 128 : 0, nq = pnb - q0;
  if (pbid >= q0) {
    qkv_work(p, dsm, pbid - q0, nq);
    asm volatile("s_waitcnt vmcnt(0)" ::: "memory");
    __syncthreads();
    if (threadIdx.x == 0) {
      __builtin_amdgcn_fence(__ATOMIC_RELEASE, "agent");
      asm volatile("s_waitcnt vmcnt(0)" ::: "memory");
      __hip_atomic_fetch_add(cnt + 8, 1u, __ATOMIC_RELAXED, __HIP_MEMORY_SCOPE_AGENT);
    }
  }
  for (int u = pbid; u < 128; u += pnb) scan_unit8(p, u, dsm);
  __syncthreads();
  if (threadIdx.x == 0) {
    unsigned sp = 0;
    while (sb_ld(cnt + 8) < (unsigned)nq) { __builtin_amdgcn_s_sleep(2); if (++sp > (1u << 23)) break; }
    __builtin_amdgcn_fence(__ATOMIC_ACQUIRE, "agent");
    asm volatile("s_waitcnt vmcnt(0)" ::: "memory");
  }
  __syncthreads();
  int* slot = (int*)(dsm + 2 * SMEM_BYTES);
  const int vb = __builtin_amdgcn_readfirstlane(opaque_tid() >> 8);
  for (;;) {
    __syncthreads();
    if (threadIdx.x == 0) *slot = (int)atomicAdd(cnt, 1u);
    __syncthreads();
    const int q = *slot;
    if (q >= 576) break;
    attn_unit(p, 2 * q + vb, smem);
  }
  for (;;) {
    __syncthreads();
    if (threadIdx.x == 0) *slot = (int)atomicAdd(cnt + 2, 1u);
    __syncthreads();
    const int t = p.ncvt_early + 2 * (*slot) + vb;
    if (t - vb >= p.ncvt) break;
    if (t < p.ncvt) p0_cvt(p, t, smem); else { __syncthreads(); __syncthreads(); }
  }
}

DI void rwkv_out_unit(const Params& p, int u, char* smem) {
  const int tid = VT, lane = tid & 63, wid = tid >> 6, wr = wid >> 1, wc = wid & 1, fr = lane & 15, fq = lane >> 4;
  const int mt = u >> 2, nt = u & 3, row0 = mt * 128;
  const bf16_t* FRW = (const bf16_t*)(p.ws + O_FRW);
  const float* mu = p.in[12];
  __syncthreads();
  for (int it = tid; it < 2048; it += 256) {
    const int r = it >> 4, c8 = (it & 15) * 8, row = row0 + r, j = row % TB, col = 1792 + c8;
    const bool pv = (j != 0 && j != NCX), nv = (j != NCX - 1 && j != TB - 1);
    const u32x4 z4 = {0u, 0u, 0u, 0u};
    const bool tail = c8 >= 96;
    const bf16_t* sp_ = tail ? (const bf16_t*)(p.ws + O_GLT) + (size_t)row * 32 + (c8 - 96) : FRW + (size_t)row * 1920 + col;
    const int rs_ = tail ? 32 : 1920;
    const u32x4 fc = *(const u32x4*)sp_;
    const u32x4 fp = pv ? *(const u32x4*)(sp_ - rs_) : z4;
    const u32x4 fn = nv ? *(const u32x4*)(sp_ + rs_) : z4;
    float xc[8], xp[8], xn[8], xs[8];
    unpack8(fc, xc); unpack8(fp, xp); unpack8(fn, xn);
#pragma unroll
    for (int e = 0; e < 8; ++e) { const float m = mu[col + e]; xs[e] = sigmoidf_(xc[e] + m * (0.5f * (xp[e] + xn[e]) - xc[e])); }
    u32x4 w; w.x = cvtpk(xs[0], xs[1]); w.y = cvtpk(xs[2], xs[3]); w.z = cvtpk(xs[4], xs[5]); w.w = cvtpk(xs[6], xs[7]);
    *(u32x4*)(smem + r * 272 + c8 * 2) = w;
  }
  __syncthreads();
  f32x4 acc[4][4];
#pragma unroll
  for (int m = 0; m < 4; ++m)
#pragma unroll
    for (int n = 0; n < 4; ++n) acc[m][n] = (f32x4){0.f, 0.f, 0.f, 0.f};
  const bf16_t* g2t = (const bf16_t*)(p.ws + O_G2T) + (size_t)(nt * 128 + wc * 64 + fr) * 128 + fq * 8;
#pragma unroll
  for (int kk = 0; kk < 4; ++kk) {
    bf16x8 af[4], bv[4];
#pragma unroll
    for (int m = 0; m < 4; ++m) af[m] = *(const bf16x8*)(smem + (wr * 64 + m * 16 + fr) * 272 + kk * 64 + fq * 16);
#pragma unroll
    for (int n = 0; n < 4; ++n) bv[n] = *(const bf16x8*)(g2t + n * 16 * 128 + kk * 32);
#pragma unroll
    for (int m = 0; m < 4; ++m)
#pragma unroll
      for (int n = 0; n < 4; ++n) acc[m][n] = mfma16(bv[n], af[m], acc[m][n]);
  }
  const int hh = nt * 2 + wc;
  const bf16_t* Yb = (const bf16_t*)((const char*)p.out + OO_Y);
  const float* BON = (const float*)(p.ws + O_BON);
  const float* gnw = p.in[21]; const float* gnb = p.in[22];
  bf16_t* CAT = (bf16_t*)(p.ws + O_A);
#pragma unroll
  for (int m = 0; m < 4; ++m) {
    const int row = row0 + wr * 64 + m * 16 + fr, j = row % TB;
    const bool pv = (j != 0 && j != NCX), nv = (j != NCX - 1 && j != TB - 1);
    f32x4 y[4]; float s = 0.f;
#pragma unroll
    for (int n = 0; n < 4; ++n) {
      const u32x2 ya = *(const u32x2*)(Yb + (size_t)row * 512 + hh * 64 + n * 16 + fq * 4), yb = *(const u32x2*)(Yb + (size_t)MT * 512 + (size_t)row * 512 + hh * 64 + n * 16 + fq * 4);
      y[n] = (f32x4){lo_f(ya.x) + lo_f(yb.x), hi_f(ya.x) + hi_f(yb.x), lo_f(ya.y) + lo_f(yb.y), hi_f(ya.y) + hi_f(yb.y)};
      s += y[n][0] + y[n][1] + y[n][2] + y[n][3];
    }
    s += __shfl_xor(s, 16); s += __shfl_xor(s, 32);
    const float mean = s * (1.f / 64.f); float q = 0.f;
#pragma unroll
    for (int n = 0; n < 4; ++n) { const f32x4 dd = y[n] - mean; q += dd[0] * dd[0] + dd[1] * dd[1] + dd[2] * dd[2] + dd[3] * dd[3]; }
    q += __shfl_xor(q, 16); q += __shfl_xor(q, 32);
    const float rstd = rsqrtf(q * (1.f / 64.f) + 64e-5f);
    const float bsum = BON[(size_t)row * 8 + hh] + BON[((size_t)MT + row) * 8 + hh];
#pragma unroll
    for (int n = 0; n < 4; ++n) {
      const int c = hh * 64 + n * 16 + fq * 4, col = 1024 + c;
      const u32x2 z2 = {0u, 0u};
      const u32x2 fc = *(const u32x2*)(FRW + (size_t)row * 1920 + col);
      const u32x2 fp = pv ? *(const u32x2*)(FRW + (size_t)(row - 1) * 1920 + col) : z2;
      const u32x2 fn = nv ? *(const u32x2*)(FRW + (size_t)(row + 1) * 1920 + col) : z2;
      const float xc[4] = {lo_f(fc.x), hi_f(fc.x), lo_f(fc.y), hi_f(fc.y)}, xp[4] = {lo_f(fp.x), hi_f(fp.x), lo_f(fp.y), hi_f(fp.y)}, xn[4] = {lo_f(fn.x), hi_f(fn.x), lo_f(fn.y), hi_f(fn.y)};
      const f32x4 mm = *(const f32x4*)(mu + col), gw = *(const f32x4*)(gnw + c), gb = *(const f32x4*)(gnb + c);
      f32x4 o;
#pragma unroll
      for (int e = 0; e < 4; ++e) {
        const float v = xc[e] + mm[e] * (0.5f * (xp[e] + xn[e]) - xc[e]);
        const float yn = (y[n][e] - mean) * rstd * gw[e] + gb[e];
        o[e] = (yn + bsum * v) * acc[m][n][e];
      }
      *(u32x2*)(CAT + (size_t)row * 1024 + 512 + c) = pack4(o);
    }
  }
}

DI float wave_sum(float v) {
#pragma unroll
  for (int o = 1; o < 64; o <<= 1) v += __shfl_xor(v, o);
  return v;
}
DI void phase_ln(const Params& p, const float* g, const float* bt, const float* mods, int sh_off, int sc_off, int latent_only, int is_final, int bid, int nb, int ctx_comb = 0) {
  const int lane = VT & 63, wid = VT >> 6;
  float* XA = (float*)(p.ws + O_X); bf16_t* H = (bf16_t*)(p.ws + O_A);
  const int nrows = latent_only ? 16384 : MT;
  f32x4 gv[4], bv[4];
#pragma unroll
  for (int i = 0; i < 4; ++i) { gv[i] = *(const f32x4*)(g + i * 256 + lane * 4); bv[i] = *(const f32x4*)(bt + i * 256 + lane * 4); }
  for (int ri = bid * 4 + wid; ri < nrows; ri += nb * 4) {
    const int row = latent_only ? (ri >> 11) * TB + NCX + (ri & 2047) : ri;
    float* xr = XA + (size_t)row * 1024;
    f32x4 v[4]; float s = 0.f;
    const float* mp = mods + modrow_of(row) * 6144;
    f32x4 scv[4], shv[4];
#pragma unroll
    for (int i = 0; i < 4; ++i) v[i] = *(const f32x4*)(xr + i * 256 + lane * 4);
    if (!is_final) {
#pragma unroll
      for (int i = 0; i < 4; ++i) { scv[i] = *(const f32x4*)(mp + sc_off + i * 256 + lane * 4); shv[i] = *(const f32x4*)(mp + sh_off + i * 256 + lane * 4); }
    }
    if (ctx_comb && (row % TB) < NCX) {
      const f32x2 st1 = *(const f32x2*)((const float*)(p.ws + O_STATS) + (size_t)row * 2);
      const float* g2p = (const float*)(p.ws + O_MODS) + 8 * 6144 + 5120;
      const int cr = (row / TB) * NCX + (row % TB);
      const float* P = p.out;
#pragma unroll
      for (int i = 0; i < 4; ++i) {
        const int c = i * 256 + lane * 4;
        f32x4 acc = *(const f32x4*)(P + (size_t)cr * 1024 + c);
#pragma unroll
        for (int sp_ = 1; sp_ < 8; ++sp_) acc += *(const f32x4*)(P + ((size_t)sp_ * 2048 + cr) * 1024 + c);
        v[i] = ALPHA * ((v[i] - st1[0]) * st1[1] * *(const f32x4*)(p.in[24] + c) + *(const f32x4*)(p.in[25] + c)) + *(const f32x4*)(g2p + c) * acc;
      }
    }
#pragma unroll
    for (int i = 0; i < 4; ++i) s += v[i][0] + v[i][1] + v[i][2] + v[i][3];
    const float mean = wave_sum(s) * (1.f / 1024.f);
    float q = 0.f;
#pragma unroll
    for (int i = 0; i < 4; ++i) { const f32x4 dd = v[i] - mean; q += dd[0] * dd[0] + dd[1] * dd[1] + dd[2] * dd[2] + dd[3] * dd[3]; }
    const float rstd = rsqrtf(wave_sum(q) * (1.f / 1024.f) + 1e-5f);
    if (!is_final && lane == 0) *(f32x2*)((float*)(p.ws + O_STATS) + (size_t)row * 2) = (f32x2){mean, rstd};
#pragma unroll
    for (int i = 0; i < 4; ++i) {
      const int c = i * 256 + lane * 4;
      const f32x4 o = (v[i] - mean) * rstd * gv[i] + bv[i];
      if (is_final) *(f32x4*)(p.out + (size_t)ri * 1024 + c) = o;
      else {
        const f32x4 hm = o * (1.f + scv[i]) + shv[i];
        *(u32x2*)(H + (size_t)row * 1024 + c) = pack4(hm);
      }
    }
  }
}

DI void lru_unit(const Params& p, int u, int pass, char* smem) {
  const int tid = VT, lane = tid & 63, wid = tid >> 6, fr = lane & 15, fq = lane >> 4;
  const int ci = u % 72, k = (u / 72) & 7, b = u / 576;
  if (pass == 2 && ci < 8) return;
  float* XC_ = (float*)smem; char* At_ = smem + 16384; float* A_ = (float*)(smem + 16384 + 8704); float* U_ = A_ + 4096;
  const bf16_t* XR = (const bf16_t*)(p.ws + O_XR);
  const int j0 = ci * 32, row0 = b * TB + j0, seg_lo = ci < 8 ? 0 : NCX, seg_hi = ci < 8 ? NCX - 1 : TB - 1;
  const float* cw = p.in[33]; const float* cb = p.in[34];
  bf16x8 bga[2][4], bgx[2][4];
  float gabv[2][2], gxbv[2][2], lamv[2][2];
  {
    const bf16_t* ga = (const bf16_t*)(p.ws + O_GAT) + (size_t)(k * 128 + wid * 32 + fr) * 128 + fq * 8;
    const bf16_t* gx = (const bf16_t*)(p.ws + O_GXT) + (size_t)(k * 128 + wid * 32 + fr) * 128 + fq * 8;
#pragma unroll
    for (int n = 0; n < 2; ++n)
#pragma unroll
      for (int kk = 0; kk < 4; ++kk) { bga[n][kk] = *(const bf16x8*)(ga + n * 2048 + kk * 32); bgx[n][kk] = *(const bf16x8*)(gx + n * 2048 + kk * 32); }
#pragma unroll
    for (int d = 0; d < 2; ++d)
#pragma unroll
      for (int n = 0; n < 2; ++n) { const int ch = d * 1024 + k * 128 + wid * 32 + n * 16 + fr; gabv[d][n] = p.in[36][ch]; gxbv[d][n] = p.in[38][ch]; lamv[d][n] = ((const float*)(p.ws + O_SP))[ch]; }
  }
  __syncthreads();
  for (int it = tid; it < 512; it += 256) {
    const int t = it >> 4, c8 = (it & 15) * 8, j = j0 + t, ch = k * 128 + c8;
    float a[8];
#pragma unroll
    for (int e = 0; e < 8; ++e) a[e] = cb[ch + e];
#pragma unroll
    for (int i = 0; i < 4; ++i) {
      const int jj = j + i - 2;
      if (jj >= seg_lo && jj <= seg_hi) {
        float x[8]; unpack8(*(const u32x4*)(XR + (size_t)(b * TB + jj) * 1024 + ch), x);
#pragma unroll
        for (int e = 0; e < 8; ++e) a[e] += x[e] * cw[i * 1024 + ch + e];
      }
    }
    *(f32x4*)(XC_ + t * 128 + c8) = (f32x4){a[0], a[1], a[2], a[3]}; *(f32x4*)(XC_ + t * 128 + c8 + 4) = (f32x4){a[4], a[5], a[6], a[7]};
    u32x4 w; w.x = cvtpk(a[0], a[1]); w.y = cvtpk(a[2], a[3]); w.z = cvtpk(a[4], a[5]); w.w = cvtpk(a[6], a[7]);
    *(u32x4*)(At_ + t * 272 + c8 * 2) = w;
  }
  __syncthreads();
  float hs[32];
#pragma unroll
  for (int t = 0; t < 32; ++t) hs[t] = 0.f;
  f32x2* CARRY = (f32x2*)(p.ws + O_CARRY); const float* HIN = (const float*)(p.ws + O_HIN);
#pragma unroll
  for (int d = 0; d < 2; ++d) {
    f32x4 aa[2][2], ax[2][2];
#pragma unroll
    for (int m = 0; m < 2; ++m)
#pragma unroll
      for (int n = 0; n < 2; ++n) { aa[m][n] = (f32x4){0.f, 0.f, 0.f, 0.f}; ax[m][n] = (f32x4){0.f, 0.f, 0.f, 0.f}; }
#pragma unroll
    for (int kk = 0; kk < 4; ++kk) {
      bf16x8 af[2];
#pragma unroll
      for (int m = 0; m < 2; ++m) af[m] = *(const bf16x8*)(At_ + (m * 16 + fr) * 272 + kk * 64 + fq * 16);
#pragma unroll
      for (int n = 0; n < 2; ++n)
#pragma unroll
        for (int m = 0; m < 2; ++m) { aa[m][n] = mfma16(af[m], bga[n][kk], aa[m][n]); ax[m][n] = mfma16(af[m], bgx[n][kk], ax[m][n]); }
    }
    if (d == 0) {
      const bf16_t* ga = (const bf16_t*)(p.ws + O_GAT) + (size_t)((8 + k) * 128 + wid * 32 + fr) * 128 + fq * 8;
      const bf16_t* gx = (const bf16_t*)(p.ws + O_GXT) + (size_t)((8 + k) * 128 + wid * 32 + fr) * 128 + fq * 8;
#pragma unroll
      for (int n = 0; n < 2; ++n)
#pragma unroll
        for (int kk = 0; kk < 4; ++kk) { bga[n][kk] = *(const bf16x8*)(ga + n * 2048 + kk * 32); bgx[n][kk] = *(const bf16x8*)(gx + n * 2048 + kk * 32); }
    }
    const size_t cidx = ((size_t)((b * 2 + d) * 72 + ci)) * 1024 + k * 128 + (tid & 127);
    float hin = 0.f;
    if (pass == 2 && tid < 128) hin = HIN[cidx];
#pragma unroll
    for (int n = 0; n < 2; ++n) {
      const int cc = wid * 32 + n * 16 + fr;
      const float gab = gabv[d][n], gxb = gxbv[d][n];
      const float sp = lamv[d][n];
#pragma unroll
      for (int m = 0; m < 2; ++m)
#pragma unroll
        for (int e = 0; e < 4; ++e) {
          const int t = m * 16 + fq * 4 + e;
          const float e1 = 1.f + __expf(-(aa[m][n][e] + gab)), e2 = 1.f + __expf(-(ax[m][n][e] + gxb));
          const float inv = __builtin_amdgcn_rcpf(e1 * e2);
          const float r = e2 * inv, ig = e1 * inv;
          const float av = __expf(-sp * r);
          A_[t * 128 + cc] = av;
          U_[t * 128 + cc] = __builtin_amdgcn_sqrtf(fmaxf(fmaf(-av, av, 1.f), 0.f)) * ig * XC_[t * 128 + cc];
        }
    }
    __syncthreads();
    if (tid < 128) {
      if (pass == 1) {
        float hcur = 0.f, P = 1.f;
#pragma unroll
        for (int tt = 0; tt < 32; ++tt) { const int t = d ? 31 - tt : tt; const float a = A_[t * 128 + tid]; hcur = a * hcur + U_[t * 128 + tid]; P *= a; }
        CARRY[cidx] = (f32x2){P, hcur};
      } else {
        float hcur = hin;
#pragma unroll
        for (int tt = 0; tt < 32; ++tt) { const int t = d ? 31 - tt : tt; hcur = A_[t * 128 + tid] * hcur + U_[t * 128 + tid]; hs[t] += hcur; }
      }
    }
    __syncthreads();
  }
  if (pass == 2) {
    if (tid < 128) {
#pragma unroll
      for (int t = 0; t < 32; ++t) A_[t * 128 + tid] = hs[t];
    }
    __syncthreads();
    const bf16_t* GATE = (const bf16_t*)(p.ws + O_GATE); bf16_t* Pout = (bf16_t*)(p.ws + O_A);
#pragma unroll
    for (int i = 0; i < 2; ++i) {
      const int it = tid + i * 256, t = it >> 4, c8 = (it & 15) * 8;
      const size_t idx = (size_t)(row0 + t) * 1024 + k * 128 + c8;
      float g8[8]; unpack8(*(const u32x4*)(GATE + idx), g8);
      const f32x4 h0 = *(const f32x4*)(A_ + t * 128 + c8), h1 = *(const f32x4*)(A_ + t * 128 + c8 + 4);
      u32x4 w; w.x = cvtpk(g8[0] * h0[0], g8[1] * h0[1]); w.y = cvtpk(g8[2] * h0[2], g8[3] * h0[3]); w.z = cvtpk(g8[4] * h1[0], g8[5] * h1[1]); w.w = cvtpk(g8[6] * h1[2], g8[7] * h1[3]);
      *(u32x4*)(Pout + idx) = w;
    }
  }
}
DI void phase_lru_carry(const Params& p, int bid, int nb) {
  const f32x2* CARRY = (const f32x2*)(p.ws + O_CARRY); float* HIN = (float*)(p.ws + O_HIN);
  for (int gid = bid * 256 + VT; gid < 16384; gid += nb * 256) {
    const int b = gid >> 11, d = (gid >> 10) & 1, ch = gid & 1023;
    const size_t base = ((size_t)((b * 2 + d) * 72)) * 1024 + ch;
    float hcur = 0.f;
#pragma unroll 1
    for (int ob = 0; ob < 72; ob += 24) {
      f32x2 c[24];
#pragma unroll
      for (int q = 0; q < 24; ++q) { const int oi = ob + q; const int ci = d == 0 ? oi : (oi < 8 ? 7 - oi : 71 - (oi - 8)); c[q] = CARRY[base + (size_t)ci * 1024]; }
#pragma unroll
      for (int q = 0; q < 24; ++q) { const int oi = ob + q; const int ci = d == 0 ? oi : (oi < 8 ? 7 - oi : 71 - (oi - 8)); HIN[base + (size_t)ci * 1024] = hcur; hcur = c[q][0] * hcur + c[q][1]; }
    }
  }
}

#define XB_TMO      128
#define XB_XCNT(j)  (256  + 64 * (j))
#define XB_XSUB(j)  (1280 + 64 * (j))
#define XB_XGEN(j)  (2304 + 64 * (j))
#define XB_TOP      3328
#define XB_TOPGEN   3392
#define XCD_BAR_WORDS 3456
#define XB_SPIN_CAP (1u << 22)
#define LAS __attribute__((address_space(3)))
DI unsigned xb_ld(unsigned* p) { return __hip_atomic_load(p, __ATOMIC_RELAXED, __HIP_MEMORY_SCOPE_AGENT); }
DI unsigned xb_add(unsigned* p, unsigned v) { return __hip_atomic_fetch_add(p, v, __ATOMIC_RELAXED, __HIP_MEMORY_SCOPE_AGENT); }
DI unsigned xb_xcc_id() { return (unsigned)__builtin_amdgcn_s_getreg((3 << 11) | 20) & 0xFu; }
#define XB_SPIN(cond, bar) do { unsigned _sp = 0; while (cond) { __builtin_amdgcn_s_sleep(1); \
    if ((++_sp & 255u) == 0u) { if (xb_ld(&(bar)[XB_TMO])) break; if (_sp > XB_SPIN_CAP) { atomicAdd(&(bar)[XB_TMO], 1u); break; } } } } while (0)
struct XcdBarrier { unsigned* bar; unsigned x; volatile LAS unsigned* st; };
DI XcdBarrier xcd_barrier_post(unsigned* bar, volatile LAS unsigned* st) {
  XcdBarrier b; b.bar = bar; b.x = xb_xcc_id(); b.st = st;
  if (threadIdx.x == 0) (void)xb_add(&bar[XB_XCNT(b.x)], 1u);
  return b;
}
DI void xcd_barrier_complete(unsigned* bar, unsigned x, unsigned& nloc, unsigned& nx) {
  const unsigned G = gridDim.x * gridDim.y * gridDim.z;
  unsigned sum, cnt, mine, sp = 0u;
  for (;;) {
    sum = 0u; cnt = 0u; mine = 0u;
#pragma unroll
    for (unsigned j = 0; j < 16; ++j) { const unsigned c = xb_ld(&bar[XB_XCNT(j)]); sum += c; cnt += (c > 0u) ? 1u : 0u; mine = (j == x) ? c : mine; }
    if (sum == G) break;
    __builtin_amdgcn_s_sleep(1);
    if ((++sp & 255u) == 0u) { if (xb_ld(&bar[XB_TMO])) break; if (sp > XB_SPIN_CAP) { atomicAdd(&bar[XB_TMO], 1u); break; } }
  }
  nloc = mine > 0u ? mine : 1u; nx = cnt > 0u ? cnt : 1u;
}
DI void xcd_barrier(const XcdBarrier& b) {
  asm volatile("s_waitcnt vmcnt(0)" ::: "memory");
  __syncthreads();
  if (threadIdx.x == 0) {
    unsigned* bar = b.bar;
    __builtin_amdgcn_s_waitcnt(0);
    unsigned nloc = b.st[0], nx = b.st[1];
    if (nloc == 0u) { xcd_barrier_complete(bar, b.x, nloc, nx); b.st[0] = nloc; b.st[1] = nx; }
    const unsigned old = xb_add(&bar[XB_XSUB(b.x)], 1u);
    const unsigned gen = old / nloc;
    if (old + 1u == (gen + 1u) * nloc) {
      __builtin_amdgcn_fence(__ATOMIC_RELEASE, "agent");
      asm volatile("s_waitcnt vmcnt(0)" ::: "memory");
      const unsigned og = xb_add(&bar[XB_TOP], 1u);
      const unsigned tg = og / nx;
      if (og + 1u == (tg + 1u) * nx) xb_add(&bar[XB_TOPGEN], 1u);
      else XB_SPIN(xb_ld(&bar[XB_TOPGEN]) == tg, bar);
      __builtin_amdgcn_fence(__ATOMIC_ACQUIRE, "agent");
      xb_add(&bar[XB_XGEN(b.x)], 1u);
      asm volatile("s_waitcnt vmcnt(0)" ::: "memory");
    } else {
      XB_SPIN(xb_ld(&bar[XB_XGEN(b.x)]) == gen, bar);
      __builtin_amdgcn_fence(__ATOMIC_ACQUIRE, "agent");
      asm volatile("s_waitcnt vmcnt(0)" ::: "memory");
    }
  }
  __syncthreads();
}

constexpr int N_PHASES = 24;
template <int ph>
DI void run_phase(const Params& p, char* smem, char* dsm, int bid, int nb, int pbid, int pnb) {
  char* ws = p.ws;
  const float* mods0 = (const float*)(ws + O_MODS); const float* mods1 = mods0 + 9 * 6144;
  bf16_t* HA = (bf16_t*)(ws + O_A); float* XA = (float*)(ws + O_X);
  bf16_t* H1 = (bf16_t*)(ws + O_B);
  if constexpr (ph == 0) phase0(p, smem, bid, nb);
  else if constexpr (ph == 1) phase_prep_a0(p, bid, nb);
  else if constexpr (ph == 2) { EpiWin0 e{(bf16_t*)(ws + O_FQ), (bf16_t*)(ws + O_FKV), (float*)(ws + O_FKR), (bf16_t*)(ws + O_FRW), (float*)(ws + O_RSQ)};
      gemm8_phase(HA, 1024, (const bf16_t*)(ws + O_WIN0), 1024, 1024, 72, 10, 0, 0, e, dsm, pbid, pnb); }
  else if constexpr (ph == 3) {}
  else if constexpr (ph == 4) phase_mixer(p, smem, dsm, bid, nb);
  else if constexpr (ph == 5) { for (int u = bid; u < 576; u += nb) rwkv_out_unit(p, u, smem); }
  else if constexpr (ph == 6) { EpiRes e{p.in[0], p.in[2], XA, mods0, 2048, 1, ALPHA, nullptr, nullptr, nullptr};
      gemm8_phase(HA, 1024, (const bf16_t*)(ws + O_WOUT0), 1024, 1024, 72, 4, 0, 0, e, dsm, pbid, pnb); }
  else if constexpr (ph == 7) phase_ln(p, p.in[24], p.in[25], mods0, 3072, 4096, 0, 0, bid, nb);
  else if constexpr (ph == 8 || ph == 10) { constexpr int hf = (ph - 8) >> 1; EpiMlp1 e{H1};
      gemm8_phase(HA, 1024, (const bf16_t*)(ws + O_W1_0) + (size_t)hf * 2048 * 1024, 1024, 1024, 64, 8, 1, 0, e, dsm, pbid, pnb);
      if constexpr (hf == 0) { EpiMlp1Ctx ec{(bf16_t*)(ws + O_B + 72 * MiB)};
        gemm8_phase(HA, 1024, (const bf16_t*)(ws + O_W1_0), 1024, 1024, 8, 16, 2, 0, ec, dsm, pbid, pnb); } }
  else if constexpr (ph == 9 || ph == 11) { constexpr int hf = (ph - 9) >> 1;
      EpiRes e{p.in[0], p.in[2], XA, mods0, 5120, 0, hf ? 1.f : ALPHA, hf ? nullptr : (const float*)(ws + O_STATS), p.in[24], p.in[25]};
      gemm8_phase(H1, 2048, (const bf16_t*)(ws + O_W2_0) + (size_t)hf * 2048, 4096, 2048, 64, 4, 1, 0, e, dsm, pbid, pnb);
      if constexpr (hf == 0) { EpiPartial ep{p.out, 0, 1};
        gemm8_phase((const bf16_t*)(ws + O_B + 72 * MiB), 4096, (const bf16_t*)(ws + O_W2_0), 4096, 512, 8, 4, 3, 0, ep, dsm, pbid, pnb, 8); } }
  else if constexpr (ph == 12) phase_ln(p, p.in[28], p.in[29], mods1, 0, 1024, 0, 0, bid, nb, 1);
  else if constexpr (ph == 13) { EpiWin1 e{(bf16_t*)(ws + O_GATE), (bf16_t*)(ws + O_XR)};
      gemm8_phase(HA, 1024, (const bf16_t*)(ws + O_WIN1), 1024, 1024, 72, 8, 0, 0, e, dsm, pbid, pnb); }
  else if constexpr (ph == 14) { for (int u = bid; u < 4608; u += nb) lru_unit(p, u, 1, smem); }
  else if constexpr (ph == 15) phase_lru_carry(p, bid, nb);
  else if constexpr (ph == 16) { for (int u = bid; u < 4608; u += nb) lru_unit(p, u, 2, smem); }
  else if constexpr (ph == 17) { EpiRes e{p.in[0], p.in[2], XA, mods1, 2048, 0, ALPHA, (const float*)(ws + O_STATS), p.in[28], p.in[29]};
      gemm8_phase(HA, 1024, (const bf16_t*)(ws + O_WOUT1), 1024, 1024, 64, 4, 1, 0, e, dsm, pbid, pnb); }
  else if constexpr (ph == 18) phase_ln(p, p.in[41], p.in[42], mods1, 3072, 4096, 1, 0, bid, nb);
  else if constexpr (ph == 19 || ph == 21) { constexpr int hf = (ph - 19) >> 1; EpiMlp1 e{H1};
      gemm8_phase(HA, 1024, (const bf16_t*)(ws + O_W1_1) + (size_t)hf * 2048 * 1024, 1024, 1024, 64, 8, 1, 0, e, dsm, pbid, pnb); }
  else if constexpr (ph == 20 || ph == 22) { constexpr int hf = (ph - 20) >> 1; EpiRes e{p.in[0], p.in[2], XA, mods1, 5120, 0, hf ? 1.f : ALPHA, hf ? nullptr : (const float*)(ws + O_STATS), p.in[41], p.in[42]};
      gemm8_phase(H1, 2048, (const bf16_t*)(ws + O_W2_1) + (size_t)hf * 2048, 4096, 2048, 64, 4, 1, 0, e, dsm, pbid, pnb); }
  else if constexpr (ph == 23) phase_ln(p, p.in[45], p.in[46], mods1, 0, 0, 1, 1, bid, nb);
}

template <int PH, int HI>
DI void run_range(const Params& p, char* smem, char* dsm, int bid, int nb, int pbid, int pnb, const XcdBarrier& xb) {
  run_phase<PH>(p, smem, dsm, bid, nb, pbid, pnb);
  if constexpr (PH < HI) { if constexpr (PH != 3) xcd_barrier(xb); run_range<PH + 1, HI>(p, smem, dsm, bid, nb, pbid, pnb, xb); }
}
constexpr int DYN_LDS = 131072;
template <int LO, int HI>
__global__ void __launch_bounds__(512, 2) mega(Params p) {
  extern __shared__ __attribute__((aligned(16))) char dsm[];
  __shared__ uint4 xb_words;
  XcdBarrier xb; xb.bar = (unsigned*)(p.ws + O_BAR); xb.x = 0; xb.st = (volatile LAS unsigned*)&xb_words;
  if constexpr (LO < HI) {
    if (threadIdx.x == 0) xb_words = make_uint4(0u, 0u, 0u, 0u);
    __syncthreads();
    xb = xcd_barrier_post((unsigned*)(p.ws + O_BAR), (volatile LAS unsigned*)&xb_words);
    if (p.njobs < 0) cg::this_grid().sync();
  }
  const int vb = __builtin_amdgcn_readfirstlane(threadIdx.x >> 8);
  run_range<LO, HI>(p, dsm + vb * SMEM_BYTES, dsm, blockIdx.x * 2 + vb, gridDim.x * 2, blockIdx.x, gridDim.x, xb);
}
template <int PH>
static void launch_split(const Params& p, int grid, hipStream_t stream) {
  (void)hipFuncSetAttribute((const void*)mega<PH, PH>, hipFuncAttributeMaxDynamicSharedMemorySize, DYN_LDS);
  hipLaunchKernelGGL((mega<PH, PH>), dim3(grid), dim3(512), DYN_LDS, stream, p);
  if constexpr (PH + 1 < N_PHASES) launch_split<PH + 1>(p, grid, stream);
}

extern "C" void kernel_launch(void* const* d_in, const int* in_sizes, int n_in, void* d_out, int out_size, void* d_ws, size_t ws_size, hipStream_t stream) {
  static int grid_blocks = 0;
  if (!grid_blocks) {
    int dev = 0, cus = 0, per_cu = 0;
    (void)hipGetDevice(&dev);
    (void)hipDeviceGetAttribute(&cus, hipDeviceAttributeMultiprocessorCount, dev);
    (void)hipFuncSetAttribute((const void*)mega<0, N_PHASES - 1>, hipFuncAttributeMaxDynamicSharedMemorySize, DYN_LDS);
    (void)hipOccupancyMaxActiveBlocksPerMultiprocessor(&per_cu, mega<0, N_PHASES - 1>, 512, DYN_LDS);
    if (per_cu > 1) per_cu = 1;
    if (per_cu < 1) per_cu = 1;
    grid_blocks = cus * per_cu;
  }
  if (n_in != 47 || ws_size < 256 * MiB) { fprintf(stderr, "kernel_launch: bad args n_in %d ws %zu\n", n_in, ws_size); return; }
  Params p; memset(&p, 0, sizeof(p));
  for (int i = 0; i < 47; ++i) p.in[i] = (const float*)d_in[i];
  p.out = (float*)d_out; p.ws = (char*)d_ws;
  char* ws = (char*)d_ws;
  int nj = 0, tiles = 0;
  auto add = [&](int src, size_t soff, size_t dst, int K, int N, int Npad, int nbatch, int scale) {
    CvtJob& J = p.jobs[nj++];
    J.src = (const float*)d_in[src] + soff; J.dst = (bf16_t*)(ws + dst); J.scale = scale >= 0 ? (const float*)d_in[scale] : nullptr;
    J.K = K; J.N = N; J.Npad = Npad; J.nbatch = nbatch; J.tile0 = tiles; J.lds = N;
    tiles += nbatch * (K / 64) * (Npad / 64);
  };
  add(6, 0, O_WIN0, 1024, 2560, 2560, 1, -1); p.jobs[nj - 1].lds = 2592;
  add(6, 2560, O_WTAIL, 1024, 32, 256, 1, -1); p.jobs[nj - 1].lds = 2592;
  add(8, 0, O_WUQ, 384, 768, 768, 1, 7);
  add(10, 0, O_WUK, 256, 512, 512, 1, 9);
  add(11, 0, O_WUV, 256, 512, 512, 1, 9);
  add(14, 0, O_W2T, 64, 512, 512, 2, -1);
  add(16, 0, O_A2T, 64, 512, 512, 2, -1);
  add(17, 0, O_G2T, 128, 512, 512, 1, -1);
  p.ncvt_early = tiles;
  add(23, 0, O_WOUT0, 1024, 1024, 1024, 1, -1);
  add(26, 0, O_W1_0, 1024, 4096, 4096, 1, -1);
  add(27, 0, O_W2_0, 4096, 1024, 1024, 1, -1);
  add(32, 0, O_WIN1, 1024, 2048, 2048, 1, -1);
  add(35, 0, O_GAT, 128, 128, 128, 16, -1);
  add(37, 0, O_GXT, 128, 128, 128, 16, -1);
  add(40, 0, O_WOUT1, 1024, 1024, 1024, 1, -1);
  add(43, 0, O_W1_1, 1024, 4096, 4096, 1, -1);
  add(44, 0, O_W2_1, 4096, 1024, 1024, 1, -1);
  p.njobs = nj; p.ncvt = tiles;
#if N_LAUNCH_SPLIT
  launch_split<0>(p, grid_blocks, stream);
#else
  (void)hipMemsetAsync(ws + O_BAR, 0, XCD_BAR_WORDS * 4, stream);
  void* args[] = {&p};
  hipError_t e = hipLaunchCooperativeKernel((void*)mega<0, N_PHASES - 1>, dim3(grid_blocks), dim3(512), args, DYN_LDS, stream);
  if (e != hipSuccess) fprintf(stderr, "cooperative launch failed: %s (grid %d)\n", hipGetErrorString(e), grid_blocks);
#endif
}
```

```cpp
#include <hip/hip_runtime.h>
#include <hip/hip_cooperative_groups.h>
#include <cstdint>
#include <cstdio>
#include <cstring>
namespace cg = cooperative_groups;

typedef unsigned short bf16_t;
typedef short bf16x8 __attribute__((ext_vector_type(8)));
typedef float f32x2 __attribute__((ext_vector_type(2)));
typedef float f32x4 __attribute__((ext_vector_type(4)));
typedef float f32x16 __attribute__((ext_vector_type(16)));
typedef unsigned u32x2 __attribute__((ext_vector_type(2)));
typedef unsigned u32x4 __attribute__((ext_vector_type(4)));
#define DI __device__ __forceinline__

constexpr int MT = 18432, TB = 2304, NCX = 256;
constexpr size_t MiB = 1u << 20;
constexpr float ALPHA = 1.41421356237f;
constexpr int SMEM_BYTES = 59392;
#ifndef N_LAUNCH_SPLIT
#define N_LAUNCH_SPLIT 0
#endif

constexpr size_t O_WIN0 = 0;
constexpr size_t O_WTAIL = O_WIN0 + (size_t)2560 * 1024 * 2;
constexpr size_t O_WUQ = O_WTAIL + (size_t)256 * 1024 * 2;
constexpr size_t O_WUK = O_WUQ + (size_t)768 * 384 * 2;
constexpr size_t O_WUV = O_WUK + (size_t)512 * 256 * 2;
constexpr size_t O_W2T = O_WUV + (size_t)512 * 256 * 2;
constexpr size_t O_A2T = O_W2T + (size_t)2 * 512 * 64 * 2;
constexpr size_t O_G2T = O_A2T + (size_t)2 * 512 * 64 * 2;
constexpr size_t O_WOUT0 = O_G2T + (size_t)512 * 128 * 2;
constexpr size_t O_W1_0 = O_WOUT0 + (size_t)1024 * 1024 * 2;
constexpr size_t O_W2_0 = O_W1_0 + (size_t)4096 * 1024 * 2;
constexpr size_t O_WIN1 = O_W2_0 + (size_t)4096 * 1024 * 2;
constexpr size_t O_GAT = O_WIN1 + (size_t)2048 * 1024 * 2;
constexpr size_t O_GXT = O_GAT + (size_t)16 * 128 * 128 * 2;
constexpr size_t O_WOUT1 = O_GXT + (size_t)16 * 128 * 128 * 2;
constexpr size_t O_W1_1 = O_WOUT1 + (size_t)1024 * 1024 * 2;
constexpr size_t O_W2_1 = O_W1_1 + (size_t)4096 * 1024 * 2;
constexpr size_t O_MODS = O_W2_1 + (size_t)4096 * 1024 * 2;
constexpr size_t O_ROPE = O_MODS + (size_t)2 * 9 * 6144 * 4;
constexpr size_t O_RSQ = O_ROPE + 4096;
constexpr size_t O_CNT = O_RSQ + (size_t)MT * 2 * 4;
constexpr size_t O_BAR = O_CNT + 256;
constexpr size_t O_STATS = O_BAR + 3456 * 4;
constexpr size_t O_SP = O_STATS + (size_t)MT * 2 * 4;
constexpr size_t O_GLT = O_SP + 2048 * 4;
constexpr size_t O_WEND = O_GLT + (size_t)MT * 32 * 2;
static_assert(O_WEND <= 52 * MiB, "weight region overflow");
constexpr size_t O_A = 52 * MiB;
constexpr size_t O_X = 88 * MiB;
constexpr size_t O_B = 160 * MiB;
constexpr size_t O_FRW = O_X;
constexpr size_t O_FQ = O_FRW + (size_t)MT * 1920 * 2;
constexpr size_t O_FKV = O_FQ + (size_t)MT * 384 * 2;
constexpr size_t O_Q = O_FKV + (size_t)MT * 256 * 2;
constexpr size_t O_K = O_Q + (size_t)MT * 768 * 2;
constexpr size_t O_FKR = O_K + (size_t)MT * 768 * 2;
constexpr size_t O_BON = O_FKR + (size_t)MT * 32 * 4;
static_assert(O_BON + (size_t)2 * MT * 8 * 4 <= 256 * MiB, "mixer region overflow");
constexpr size_t O_GATE = O_B;
constexpr size_t O_XR = O_B + 36 * MiB;
constexpr size_t O_CARRY = O_B + 72 * MiB;
constexpr size_t O_HIN = O_CARRY + 9 * MiB;
constexpr size_t OO_Y = 0;
constexpr size_t OO_VT = 36 * MiB;

struct CvtJob { const float* src; bf16_t* dst; const float* scale; int K, N, Npad, nbatch, tile0, lds; };
struct Params {
  const float* in[47];
  float* out; char* ws;
  CvtJob jobs[20];
  int njobs, ncvt, ncvt_early, pad2_;
};

DI int opaque_tid() { int t = threadIdx.x; asm volatile("" : "+v"(t)); return t; }
#define VT (opaque_tid() & 255)
DI unsigned cvtpk(float lo, float hi) { unsigned r; asm("v_cvt_pk_bf16_f32 %0, %1, %2" : "=v"(r) : "v"(lo), "v"(hi)); return r; }
DI float bf2f(bf16_t b) { return __uint_as_float((unsigned)b << 16); }
DI float lo_f(unsigned w) { return __uint_as_float(w << 16); }
DI float hi_f(unsigned w) { return __uint_as_float(w & 0xffff0000u); }
DI u32x2 pack4(f32x4 v) { u32x2 r; r.x = cvtpk(v[0], v[1]); r.y = cvtpk(v[2], v[3]); return r; }
DI float sigmoidf_(float x) { return __builtin_amdgcn_rcpf(1.f + __expf(-x)); }
DI float tanh_fast(float x) { x = fminf(fmaxf(x, -15.f), 15.f); float t = __expf(2.f * x); return (t - 1.f) * __builtin_amdgcn_rcpf(t + 1.f); }
DI float one_minus_exp(float x) { const float ps = -x * (1.f + x * (0.5f + x * (0.16666667f + x * (0.041666668f + x * (0.0083333338f + x * 0.0013888889f))))); return x > -0.35f ? ps : 1.f - __expf(x); }
DI float gelu_tanh(float x) { float u = 0.7978845608f * (x + 0.044715f * x * x * x); return 0.5f * x * (1.f + tanh_fast(u)); }
template <int CTRL> DI float dppf(float v) { return __int_as_float(__builtin_amdgcn_update_dpp(0, __float_as_int(v), CTRL, 0xF, 0xF, true)); }
DI float red8(float v) { v += dppf<0xB1>(v); v += dppf<0x4E>(v); v += dppf<0x141>(v); return v; }
DI float red16(float v) { v = red8(v); v += dppf<0x140>(v); return v; }
DI float red8_ns(float v) { v += dppf<0xB1>(v); asm("" : "+v"(v)); v += dppf<0x4E>(v); asm("" : "+v"(v)); v += dppf<0x141>(v); asm("" : "+v"(v)); return v; }
DI f32x4 mfma16(bf16x8 a, bf16x8 b, f32x4 c) { return __builtin_amdgcn_mfma_f32_16x16x32_bf16(a, b, c, 0, 0, 0); }
DI f32x16 mfma32(bf16x8 a, bf16x8 b, f32x16 c) { return __builtin_amdgcn_mfma_f32_32x32x16_bf16(a, b, c, 0, 0, 0); }
DI const float* xrow_in(const Params& p, int row) {
  const int b = row / TB, j = row - b * TB;
  return j < NCX ? p.in[2] + (size_t)(b * NCX + j) * 1024 : p.in[0] + (size_t)(b * 2048 + j - NCX) * 1024;
}
DI int modrow_of(int row) { const int b = row / TB, j = row - b * TB; return j < NCX ? 8 : b; }

DI void p0_misc(const Params& p) {
  const int tid = VT;
  float* rsq = (float*)(p.ws + O_RSQ);
  for (int i = tid; i < MT * 2; i += 256) rsq[i] = 0.f;
  unsigned* cnt = (unsigned*)(p.ws + O_CNT);
  if (tid < 64) cnt[tid] = 0u;
  { float* spt = (float*)(p.ws + O_SP); for (int i = tid; i < 2048; i += 256) spt[i] = 8.f * log1pf(__expf(-p.in[39][i])); }
  float* rope = (float*)(p.ws + O_ROPE);
  for (int i = tid; i < 512; i += 256) {
    const int pos = i >> 3, f = i & 7;
    const float inv = powf(10000.f, -(float)(2 * f) / 16.f);
    const float ang = (float)pos * inv;
    rope[i * 2] = cosf(ang); rope[i * 2 + 1] = sinf(ang);
  }
}
DI void p0_zero_y(const Params& p, int u) {
  f32x4* y = (f32x4*)((char*)p.out + OO_Y) + (size_t)u * 4096;
  const f32x4 z = {0.f, 0.f, 0.f, 0.f};
  for (int i = VT; i < 4096; i += 256) y[i] = z;
}
DI void p0_mods(const Params& p, int u, char* smem) {
  const int tid = VT, layer = u / 192, n0 = (u % 192) * 32;
  float* sl = (float*)smem;
  float* red = sl + 9216;
  const float* c = p.in[1]; const float* cc = p.in[3];
  __syncthreads();
  for (int i = tid; i < 9216; i += 256) { const float v = i < 8192 ? c[i] : cc[i - 8192]; sl[i] = v / (1.f + __expf(-v)); }
  __syncthreads();
  const float* W = p.in[layer ? 30 : 4]; const float* bias = p.in[layer ? 31 : 5];
  const int kg = tid >> 5, cn = tid & 31;
  float acc[9];
#pragma unroll
  for (int r = 0; r < 9; ++r) acc[r] = 0.f;
  const float* wp = W + (size_t)(kg * 128) * 6144 + n0 + cn;
#pragma unroll 1
  for (int k0 = 0; k0 < 128; k0 += 16) {
    float w[16];
#pragma unroll
    for (int q = 0; q < 16; ++q) w[q] = wp[(size_t)(k0 + q) * 6144];
#pragma unroll
    for (int q = 0; q < 16; ++q) {
#pragma unroll
      for (int r = 0; r < 9; ++r) acc[r] += sl[r * 1024 + kg * 128 + k0 + q] * w[q];
    }
  }
#pragma unroll
  for (int r = 0; r < 9; ++r) red[(kg * 9 + r) * 32 + cn] = acc[r];
  __syncthreads();
  float* mods = (float*)(p.ws + O_MODS) + (size_t)layer * 9 * 6144;
  for (int i = tid; i < 288; i += 256) {
    const int r = i >> 5, n = i & 31;
    float sacc = bias[n0 + n];
#pragma unroll
    for (int g = 0; g < 8; ++g) sacc += red[(g * 9 + r) * 32 + n];
    mods[r * 6144 + n0 + n] = sacc;
  }
}
DI void p0_cvt(const Params& p, int t, char* smem) {
  int ji = 0;
  for (int q = 1; q < p.njobs; ++q) if (t >= p.jobs[q].tile0) ji = q;
  const CvtJob& J = p.jobs[ji];
  int lt = t - J.tile0;
  const int tk = J.K >> 6, tn = J.Npad >> 6;
  const int bi = lt / (tk * tn); lt -= bi * tk * tn;
  const int k0 = (lt / tn) * 64, n0 = (lt % tn) * 64;
  const float* src = J.src + (size_t)bi * J.K * J.N;
  bf16_t* dst = J.dst + (size_t)bi * J.Npad * J.K;
  float* tile = (float*)smem;
  const int tid = VT, a = tid >> 6, l = tid & 63;
  __syncthreads();
#pragma unroll 4
  for (int i = 0; i < 16; ++i) {
    const int kk = i * 4 + a, n = n0 + l;
    float v = 0.f;
    if (n < J.N) { v = src[(size_t)(k0 + kk) * J.lds + n]; if (J.scale) v *= J.scale[k0 + kk]; }
    tile[kk * 65 + l] = v;
  }
  __syncthreads();
#pragma unroll 4
  for (int i = 0; i < 16; ++i) {
    const int nn = i * 4 + a;
    dst[(size_t)(n0 + nn) * J.K + k0 + l] = (bf16_t)(cvtpk(tile[l * 65 + nn], 0.f) & 0xffffu);
  }
}
DI void phase0(const Params& p, char* smem, int bid, int nb) {
  const int ncp = (p.ncvt_early + 1) & ~1;
  const int total = 384 + ncp + 2;
  for (int t = bid; t < total; t += nb) {
    if (t < 384) p0_mods(p, t, smem);
    else if (t - 384 < ncp) { if (t - 384 < p.ncvt_early) p0_cvt(p, t - 384, smem); else { __syncthreads(); __syncthreads(); } }
    else { const int z = t - 384 - ncp; if (z == 0) p0_misc(p); }
  }
}

DI void phase_prep_a0(const Params& p, int bid, int nb) {
  const float* mods = (const float*)(p.ws + O_MODS);
  bf16_t* H = (bf16_t*)(p.ws + O_A);
  const int stride = nb * 256;
  for (int i0 = bid * 256 + VT; i0 < MT * 128; i0 += 3 * stride) {
    f32x4 x0[3], x1[3], sh0[3], sh1[3], sc0[3], sc1[3];
#pragma unroll
    for (int q = 0; q < 3; ++q) {
      const int i = i0 + q * stride;
      if (i < MT * 128) {
        const int row = i >> 7, c = (i & 127) * 8;
        const float* src = xrow_in(p, row) + c;
        const float* mp = mods + modrow_of(row) * 6144 + c;
        x0[q] = *(const f32x4*)src; x1[q] = *(const f32x4*)(src + 4);
        sh0[q] = *(const f32x4*)mp; sh1[q] = *(const f32x4*)(mp + 4);
        sc0[q] = *(const f32x4*)(mp + 1024); sc1[q] = *(const f32x4*)(mp + 1028);
      }
    }
#pragma unroll
    for (int q = 0; q < 3; ++q) {
      const int i = i0 + q * stride;
      if (i < MT * 128) {
        const int row = i >> 7, c = (i & 127) * 8;
        const f32x4 y0 = x0[q] * (1.f + sc0[q]) + sh0[q], y1 = x1[q] * (1.f + sc1[q]) + sh1[q];
        u32x4 w; w.x = cvtpk(y0[0], y0[1]); w.y = cvtpk(y0[2], y0[3]); w.z = cvtpk(y1[0], y1[1]); w.w = cvtpk(y1[2], y1[3]);
        *(u32x4*)(H + (size_t)row * 1024 + c) = w;
      }
    }
  }
}

namespace g8 {
constexpr int BM = 256, BK = 64, HALF = 128, HT = HALF * BK, NXCD = 8, WGM = 8;
DI int lds_byte(int r, int c) { const int st = (r >> 4) * 2 + (c >> 5), rr = r & 15, cc = c & 31, ob = rr * 64 + cc * 2; return st * 1024 + (ob ^ (((ob >> 9) & 1) << 5)); }
DI void stage_rc(int b, int& R, int& C) { const int st = b / 1024, sb = b % 1024, swz = sb ^ (((sb >> 9) & 1) << 5); R = (st >> 1) * 16 + swz / 64; C = (st & 1) * 32 + (swz % 64) / 2; }
}
typedef __attribute__((address_space(3))) unsigned char lds_u8;
template <class Epi>
DI void gemm8_phase(const bf16_t* __restrict__ A, int lda, const bf16_t* __restrict__ Bt, int ldb, int K,
                    int nM, int nN, int mode, int base, const Epi& epi, char* dsm, int bid, int nb, int ksplit = 1) {
  using namespace g8;
  constexpr int HTB = HALF * BK * 2;
  lds_u8* lds = (lds_u8*)dsm;
  const int tid = opaque_tid(), wid = __builtin_amdgcn_readfirstlane(tid >> 6), lane = tid & 63, wr = wid >> 2, wc = wid & 3, fr = lane & 15, fq = lane >> 4;
  unsigned voffA[2], voffB[2];
#pragma unroll
  for (int i = 0; i < 2; ++i) { int R, C; stage_rc(tid * 16 + i * 8192, R, C); voffA[i] = (unsigned)(R * lda + C) * 2u; voffB[i] = (unsigned)(R * ldb + C) * 2u; }
  const size_t hstepA = (size_t)HALF * lda * 2, hstepB = (size_t)HALF * ldb * 2;
  const unsigned ldsw = (unsigned)wid * 1024u;
  const int aoff = lds_byte(wr * 64 + fr, fq * 8), boff = lds_byte(wc * 32 + fr, fq * 8);
  #define SA(b,h) (((b)*2+(h))*HTB)
  #define SB(b,h) ((4+(b)*2+(h))*HTB)
  #define STAGE(bufoff,gbase,voff) do{ _Pragma("unroll") for(int _i=0;_i<2;++_i) \
    __builtin_amdgcn_global_load_lds((const unsigned*)((const char*)(gbase)+(voff)[_i]),(__attribute__((address_space(3))) unsigned*)(lds+(bufoff)+ldsw+_i*8192),16,0,0);}while(0)
  #define LDA(dst,b,h) do{ _Pragma("unroll") for(int m=0;m<4;++m) _Pragma("unroll") for(int k=0;k<2;++k) dst[m][k]=*(const __attribute__((address_space(3))) bf16x8*)(lds+SA(b,h)+aoff+m*2048+k*1024);}while(0)
  #define LDB(dst,b,h) do{ _Pragma("unroll") for(int n=0;n<2;++n) _Pragma("unroll") for(int k=0;k<2;++k) dst[n][k]=*(const __attribute__((address_space(3))) bf16x8*)(lds+SB(b,h)+boff+n*2048+k*1024);}while(0)
  #define MMA(ai,bj,At_,Bt_) do{__builtin_amdgcn_s_setprio(1); _Pragma("unroll") for(int m=0;m<4;++m) _Pragma("unroll") for(int n=0;n<2;++n) _Pragma("unroll") for(int k=0;k<2;++k) \
      acc[ai][bj][m][n]=__builtin_amdgcn_mfma_f32_16x16x32_bf16(Bt_[n][k],At_[m][k],acc[ai][bj][m][n],0,0,0); \
    __builtin_amdgcn_s_setprio(0);}while(0)
  #define WAIT_V(n) asm volatile("s_waitcnt vmcnt(" #n ")":::"memory")
  #define WAIT_L(n) asm volatile("s_waitcnt lgkmcnt(" #n ")":::"memory")
  #define BAR __builtin_amdgcn_s_barrier()
  #define SCHED __builtin_amdgcn_sched_barrier(0)
  const int nwt = nM * nN, nwg = nwt * ksplit, nt = K / BK;
  for (int L = bid; L < nwg; L += nb) {
    const int ks = L % ksplit;
    int wgid = L / ksplit;
    { const int q = nwt / NXCD, r = nwt % NXCD, xcd = wgid % NXCD, off = wgid / NXCD; wgid = (xcd < r ? xcd * (q + 1) : r * (q + 1) + (xcd - r) * q) + off; }
    const int nig = WGM * nN, gid = wgid / nig, fm = gid * WGM, gsz = min(nM - fm, WGM);
    const int pm = fm + ((wgid % nig) % gsz), pn = (wgid % nig) / gsz;
    const int brow = mode == 1 ? ((((base + pm) >> 3) * 9 + 1 + ((base + pm) & 7)) * 256) : (mode == 2 ? pm * TB : base + pm * 256);
    const int bcol = pn * BM;
    f32x4 acc[2][2][4][2];
#pragma unroll
    for (int a_ = 0; a_ < 2; ++a_)
#pragma unroll
      for (int b_ = 0; b_ < 2; ++b_)
#pragma unroll
        for (int m = 0; m < 4; ++m)
#pragma unroll
          for (int n = 0; n < 2; ++n) acc[a_][b_][m][n] = (f32x4){0.f, 0.f, 0.f, 0.f};
    bf16x8 At[4][2], B0[2][2], B1[2][2];
    const char* cA = (const char*)(A + (size_t)brow * lda + (size_t)ks * K); const char* cB = (const char*)(Bt + (size_t)bcol * ldb + (size_t)ks * K);
    STAGE(SB(0,0),cB,voffB); STAGE(SA(0,0),cA,voffA); STAGE(SB(0,1),cB+hstepB,voffB); STAGE(SA(0,1),cA+hstepA,voffA);
    if(wr==1)BAR;
    WAIT_V(4); BAR;
    STAGE(SB(1,0),cB+128,voffB); STAGE(SA(1,0),cA+128,voffA); STAGE(SB(1,1),cB+hstepB+128,voffB);
    WAIT_V(6); BAR;
    for(int t=0;t<nt-2;t+=2){
      const char* a1 = cA + (size_t)(t+1)*128; const char* a2 = cA + (size_t)(t+2)*128; const char* a3 = cA + (size_t)(t+3)*128;
      const char* b2 = cB + (size_t)(t+2)*128; const char* b3 = cB + (size_t)(t+3)*128;
      LDB(B0,0,0); SCHED; LDA(At,0,0); STAGE(SA(1,1),a1+hstepA,voffA);
      WAIT_L(8); BAR; WAIT_L(0); MMA(0,0,At,B0); BAR; SCHED;
      LDB(B1,0,1); STAGE(SB(0,0),b2,voffB);
      BAR; WAIT_L(0); MMA(0,1,At,B1); BAR;
      LDA(At,0,1); STAGE(SA(0,0),a2,voffA);
      BAR; WAIT_L(0); MMA(1,0,At,B0); BAR; SCHED;
      STAGE(SB(0,1),b2+hstepB,voffB);
      WAIT_V(6); BAR; MMA(1,1,At,B1); BAR;
      LDB(B0,1,0); SCHED; LDA(At,1,0); STAGE(SA(0,1),a2+hstepA,voffA);
      WAIT_L(8); BAR; WAIT_L(0); MMA(0,0,At,B0); BAR; SCHED;
      LDB(B1,1,1); STAGE(SB(1,0),b3,voffB);
      BAR; WAIT_L(0); MMA(0,1,At,B1); BAR;
      LDA(At,1,1); STAGE(SA(1,0),a3,voffA);
      BAR; WAIT_L(0); MMA(1,0,At,B0); BAR; SCHED;
      STAGE(SB(1,1),b3+hstepB,voffB);
      WAIT_V(6); BAR; MMA(1,1,At,B1); BAR;
    }
    { LDB(B0,0,0); LDA(At,0,0); STAGE(SA(1,1),cA+(size_t)(nt-1)*128+hstepA,voffA);
      BAR; WAIT_L(0); MMA(0,0,At,B0); BAR;
      LDB(B1,0,1); BAR; WAIT_L(0); MMA(0,1,At,B1); BAR;
      LDA(At,0,1); WAIT_V(4); BAR; WAIT_L(0); MMA(1,0,At,B0); MMA(1,1,At,B1); BAR; }
    { LDB(B0,1,0); LDA(At,1,0); WAIT_V(2); BAR; WAIT_L(0); MMA(0,0,At,B0); BAR;
      LDB(B1,1,1); WAIT_V(0); BAR; WAIT_L(0); MMA(0,1,At,B1); BAR;
      LDA(At,1,1); BAR; WAIT_L(0); MMA(1,0,At,B0); MMA(1,1,At,B1); BAR; }
    if(wr==0)BAR;
#pragma unroll
    for (int ai = 0; ai < 2; ++ai)
#pragma unroll
      for (int bj = 0; bj < 2; ++bj) epi(acc[ai][bj], brow + ai * HALF + wr * 64, bcol + bj * HALF + wc * 32 + ks * 1024, fr, fq);
    epi.post(brow, pn);
  }
  #undef SA
  #undef SB
  #undef STAGE
  #undef LDA
  #undef LDB
  #undef MMA
  #undef WAIT_V
  #undef WAIT_L
  #undef BAR
  #undef SCHED
}

struct EpiWin0 {
  bf16_t* FQ; bf16_t* FKV; float* FKR; bf16_t* FRW; float* RSQ;
  template <int NN> DI void operator()(f32x4 (&acc)[4][NN], int rb, int cb, int fr, int fq) const {
    if (cb < 640) {
      const bool isq = cb < 384; bf16_t* dst = isq ? FQ : FKV; const int ld = isq ? 384 : 256; const int co = isq ? cb : cb - 384;
#pragma unroll
      for (int m = 0; m < 4; ++m) {
        const int row = rb + m * 16 + fr; float s = 0.f;
#pragma unroll
        for (int n = 0; n < NN; ++n) {
          const f32x4 v = acc[m][n]; s += v[0] * v[0] + v[1] * v[1] + v[2] * v[2] + v[3] * v[3];
          *(u32x2*)(dst + (size_t)row * ld + co + n * 16 + fq * 4) = pack4(v);
        }
        s += __shfl_xor(s, 16); s += __shfl_xor(s, 32);
        if (fq == 0) atomicAdd(&RSQ[row * 2 + (isq ? 0 : 1)], s);
      }
    } else {
#pragma unroll
      for (int m = 0; m < 4; ++m) {
        const int row = rb + m * 16 + fr;
#pragma unroll
        for (int n = 0; n < NN; ++n) {
          const int cs = cb + n * 16, c = cs + fq * 4;
          if (cs < 672) *(f32x4*)(FKR + (size_t)row * 32 + (c - 640)) = acc[m][n];
          else if (cs < 2592) *(u32x2*)(FRW + (size_t)row * 1920 + (c - 672)) = pack4(acc[m][n]);
        }
      }
    }
  }
  DI void post(int, int) const {}
};
struct EpiQ {
  bf16_t* Q; const float* RSQ; const float* ROPE;
  template <int NN> DI void operator()(f32x4 (&acc)[4][NN], int rb, int cb, int fr, int fq) const {
#pragma unroll
    for (int m = 0; m < 4; ++m) {
      const int row = rb + m * 16 + fr;
      const float rs = rsqrtf(RSQ[row * 2] * (1.f / 384.f) + 1e-6f);
      const int b = row / TB, j = row - b * TB; const bool latent = j >= NCX; const int nl = j - NCX;
#pragma unroll
      for (int n = 0; n < NN; ++n) {
        const int cs = cb + n * 16, within = cs % 96;
        f32x4 v = acc[m][n] * rs;
        if (within >= 64) {
          f32x4 pr;
#pragma unroll
          for (int e = 0; e < 4; ++e) pr[e] = __shfl_xor(v[e], 32);
          if (latent) {
            const int axis = (within - 64) >> 4; const int pos = axis ? (nl & 63) : (nl >> 6);
            const float* tb = ROPE + (pos * 8 + (fq & 1) * 4) * 2;
#pragma unroll
            for (int e = 0; e < 4; ++e) { const float c = tb[e * 2], s = tb[e * 2 + 1]; v[e] = (fq & 2) ? v[e] * c + pr[e] * s : v[e] * c - pr[e] * s; }
          }
        }
        *(u32x2*)(Q + (size_t)row * 768 + cs + fq * 4) = pack4(v);
      }
    }
  }
  DI void post(int, int) const {}
};
struct EpiKn {
  bf16_t* Kb; const float* RSQ; const float* FKR; const float* ROPE;
  template <int NN> DI void operator()(f32x4 (&acc)[4][NN], int rb, int cb, int fr, int fq) const {
#pragma unroll
    for (int m = 0; m < 4; ++m) {
      const int row = rb + m * 16 + fr;
      const float rs = rsqrtf(RSQ[row * 2 + 1] * (1.f / 256.f) + 1e-6f);
#pragma unroll
      for (int n = 0; n < NN; ++n) {
        const int cs = cb + n * 16, hh = cs >> 6, off = (cs & 63) + fq * 4;
        *(u32x2*)(Kb + (size_t)row * 768 + hh * 96 + off) = pack4(acc[m][n] * rs);
      }
    }
  }
  DI void post(int row0, int nt) const {
    if (nt != 0) return;
    const int tid = threadIdx.x, row = row0 + (tid >> 1), axis = tid & 1;
    const int b = row / TB, j = row - b * TB; const bool latent = j >= NCX; const int nl = j - NCX;
    const float* src = FKR + (size_t)row * 32 + axis * 16;
    float x[16];
#pragma unroll
    for (int e = 0; e < 4; ++e) { const f32x4 v = *(const f32x4*)(src + e * 4); x[e * 4] = v[0]; x[e * 4 + 1] = v[1]; x[e * 4 + 2] = v[2]; x[e * 4 + 3] = v[3]; }
    if (latent) {
      const int pos = axis ? (nl & 63) : (nl >> 6);
      const float* tb = ROPE + pos * 16;
#pragma unroll
      for (int f = 0; f < 8; ++f) { const float c = tb[f * 2], s = tb[f * 2 + 1], x1 = x[f], x2 = x[8 + f]; x[f] = x1 * c - x2 * s; x[8 + f] = x2 * c + x1 * s; }
    }
    u32x4 w0, w1;
    w0.x = cvtpk(x[0], x[1]); w0.y = cvtpk(x[2], x[3]); w0.z = cvtpk(x[4], x[5]); w0.w = cvtpk(x[6], x[7]);
    w1.x = cvtpk(x[8], x[9]); w1.y = cvtpk(x[10], x[11]); w1.z = cvtpk(x[12], x[13]); w1.w = cvtpk(x[14], x[15]);
#pragma unroll
    for (int hh = 0; hh < 8; ++hh) { bf16_t* d = Kb + (size_t)row * 768 + hh * 96 + 64 + axis * 16; *(u32x4*)d = w0; *(u32x4*)(d + 8) = w1; }
  }
};
struct EpiVt {
  bf16_t* VTP; const float* RSQ;
  template <int NN> DI void operator()(f32x4 (&acc)[4][NN], int rb, int cb, int fr, int fq) const {
#pragma unroll
    for (int n = 0; n < NN; ++n) {
      const int c = cb + n * 16 + fq * 4;
      f32x4 rs;
#pragma unroll
      for (int e = 0; e < 4; ++e) rs[e] = rsqrtf(RSQ[(c + e) * 2 + 1] * (1.f / 256.f) + 1e-6f);
#pragma unroll
      for (int m = 0; m < 4; ++m) { const int row = rb + m * 16 + fr; *(u32x2*)(VTP + (size_t)row * MT + c) = pack4(acc[m][n] * rs); }
    }
  }
  DI void post(int, int) const {}
};
struct EpiRes {
  const float* xin; const float* cin; float* XA; const float* mods; int goff; int from_input; float alpha;
  const float* stats; const float* lng; const float* lnb;
  template <int NN> DI void operator()(f32x4 (&acc)[4][NN], int rb, int cb, int fr, int fq) const {
#pragma unroll
    for (int m = 0; m < 4; ++m) {
      const int row = rb + m * 16 + fr;
      const float* gp = mods + modrow_of(row) * 6144 + goff;
      const int b_ = row / TB, j_ = row - b_ * TB;
      const float* src = from_input ? (j_ < NCX ? cin + (size_t)(b_ * NCX + j_) * 1024 : xin + (size_t)(b_ * 2048 + j_ - NCX) * 1024) : XA + (size_t)row * 1024;
      float mean = 0.f, rstd = 1.f;
      if (stats) { const f32x2 st = *(const f32x2*)(stats + (size_t)row * 2); mean = st[0]; rstd = st[1]; }
#pragma unroll
      for (int n = 0; n < NN; ++n) {
        const int c = cb + n * 16 + fq * 4;
        f32x4 xv = *(const f32x4*)(src + c); const f32x4 gv = *(const f32x4*)(gp + c);
        if (stats) xv = (xv - mean) * rstd * *(const f32x4*)(lng + c) + *(const f32x4*)(lnb + c);
        *(f32x4*)(XA + (size_t)row * 1024 + c) = alpha * xv + gv * acc[m][n];
      }
    }
  }
  DI void post(int, int) const {}
};
struct EpiPartial {
  float* P; int slot0; int compact;
  template <int NN> DI void operator()(f32x4 (&acc)[4][NN], int rb, int cb, int fr, int fq) const {
    const int ks = cb >> 10, c0 = cb & 1023;
#pragma unroll
    for (int m = 0; m < 4; ++m) {
      const int row = rb + m * 16 + fr, b_ = row / TB, cr = compact ? row : b_ * NCX + (row - b_ * TB);
      float* dst = P + ((size_t)(slot0 + ks) * 2048 + cr) * 1024 + c0 + fq * 4;
#pragma unroll
      for (int n = 0; n < NN; ++n) *(f32x4*)(dst + n * 16) = acc[m][n];
    }
  }
  DI void post(int, int) const {}
};
struct EpiGlt {
  bf16_t* GLT;
  template <int NN> DI void operator()(f32x4 (&acc)[4][NN], int rb, int cb, int fr, int fq) const {
    if (cb >= 32) return;
#pragma unroll
    for (int m = 0; m < 4; ++m) {
      const int row = rb + m * 16 + fr;
#pragma unroll
      for (int n = 0; n < NN; ++n) *(u32x2*)(GLT + (size_t)row * 32 + cb + n * 16 + fq * 4) = pack4(acc[m][n]);
    }
  }
  DI void post(int, int) const {}
};
struct EpiMlp1 {
  bf16_t* H1;
  template <int NN> DI void operator()(f32x4 (&acc)[4][NN], int rb, int cb, int fr, int fq) const {
#pragma unroll
    for (int m = 0; m < 4; ++m) {
      const int row = rb + m * 16 + fr;
#pragma unroll
      for (int n = 0; n < NN; ++n) {
        f32x4 v = acc[m][n];
#pragma unroll
        for (int e = 0; e < 4; ++e) { const float r = fmaxf(v[e], 0.f); v[e] = r * r; }
        *(u32x2*)(H1 + (size_t)row * 2048 + cb + n * 16 + fq * 4) = pack4(v);
      }
    }
  }
  DI void post(int, int) const {}
};
struct EpiMlp1Ctx {
  bf16_t* H1c;
  template <int NN> DI void operator()(f32x4 (&acc)[4][NN], int rb, int cb, int fr, int fq) const {
#pragma unroll
    for (int m = 0; m < 4; ++m) {
      const int row = rb + m * 16 + fr, b_ = row / TB, cr = b_ * NCX + (row - b_ * TB);
#pragma unroll
      for (int n = 0; n < NN; ++n) {
        f32x4 v = acc[m][n];
#pragma unroll
        for (int e = 0; e < 4; ++e) { const float r = fmaxf(v[e], 0.f); v[e] = r * r; }
        *(u32x2*)(H1c + (size_t)cr * 4096 + cb + n * 16 + fq * 4) = pack4(v);
      }
    }
  }
  DI void post(int, int) const {}
};
struct EpiWin1 {
  bf16_t* GATE; bf16_t* XR;
  template <int NN> DI void operator()(f32x4 (&acc)[4][NN], int rb, int cb, int fr, int fq) const {
#pragma unroll
    for (int m = 0; m < 4; ++m) {
      const int row = rb + m * 16 + fr;
#pragma unroll
      for (int n = 0; n < NN; ++n) {
        const int c = cb + n * 16 + fq * 4;
        f32x4 v = acc[m][n];
        if (cb < 1024) {
#pragma unroll
          for (int e = 0; e < 4; ++e) v[e] = gelu_tanh(v[e]);
          *(u32x2*)(GATE + (size_t)row * 1024 + c) = pack4(v);
        } else *(u32x2*)(XR + (size_t)row * 1024 + c - 1024) = pack4(v);
      }
    }
  }
  DI void post(int, int) const {}
};

DI void attn_unit(const Params& p, int u, char* smem) {
  const int tid = VT, lane = tid & 63, wid = tid >> 6, r32 = lane & 31, hi = lane >> 5;
  int b, h, qrow0, nkeys;
  if (u < 1024) { b = u >> 7; h = (u >> 4) & 7; qrow0 = b * TB + NCX + (u & 15) * 128; nkeys = TB; }
  else { const int v = u - 1024; b = v >> 4; h = (v >> 1) & 7; qrow0 = b * TB + (v & 1) * 128; nkeys = NCX; }
  const int key0 = b * TB;
  const bf16_t* Q = (const bf16_t*)(p.ws + O_Q); const bf16_t* Kb = (const bf16_t*)(p.ws + O_K);
  const bf16_t* VTP = (const bf16_t*)((const char*)p.out + OO_VT);
  bf16_t* CAT = (bf16_t*)(p.ws + O_A);
  char* sK = smem; char* sV = smem + 64 * 208;
  const int qrow = qrow0 + wid * 32 + r32;
  bf16x8 qf[6];
  {
    const bf16_t* qp = Q + (size_t)qrow * 768 + h * 96 + hi * 8;
#pragma unroll
    for (int d0 = 0; d0 < 6; ++d0) qf[d0] = *(const bf16x8*)(qp + d0 * 16);
  }
  f32x16 o0, o1;
#pragma unroll
  for (int r = 0; r < 16; ++r) { o0[r] = 0.f; o1[r] = 0.f; }
  float mrun = -1e30f, lrun = 0.f;
  constexpr float C = 0.10206207261596575f * 1.4426950408889634f;
  const bf16_t* gk[3]; int lk[3];
#pragma unroll
  for (int i = 0; i < 3; ++i) { const int c = tid + i * 256, kr = c / 12, kc = c - kr * 12; gk[i] = Kb + (size_t)(key0 + kr) * 768 + h * 96 + kc * 8; lk[i] = kr * 208 + kc * 16; }
  const bf16_t* gv[2]; int lv[2];
#pragma unroll
  for (int i = 0; i < 2; ++i) { const int c = tid + i * 256, vr = c >> 3, vc = c & 7; gv[i] = VTP + (size_t)(h * 64 + vr) * MT + key0 + vc * 8; lv[i] = vr * 144 + vc * 16; }
  u32x4 rk[3], rv[2];
#pragma unroll
  for (int i = 0; i < 3; ++i) rk[i] = *(const u32x4*)(gk[i]);
#pragma unroll
  for (int i = 0; i < 2; ++i) rv[i] = *(const u32x4*)(gv[i]);
  for (int k0 = 0; k0 < nkeys; k0 += 64) {
    __syncthreads();
#pragma unroll
    for (int i = 0; i < 3; ++i) *(u32x4*)(sK + lk[i]) = rk[i];
#pragma unroll
    for (int i = 0; i < 2; ++i) *(u32x4*)(sV + lv[i]) = rv[i];
    __syncthreads();
    if (k0 + 64 < nkeys) {
#pragma unroll
      for (int i = 0; i < 3; ++i) rk[i] = *(const u32x4*)(gk[i] + (size_t)(k0 + 64) * 768);
#pragma unroll
      for (int i = 0; i < 2; ++i) rv[i] = *(const u32x4*)(gv[i] + k0 + 64);
    }
    f32x16 p0, p1;
#pragma unroll
    for (int r = 0; r < 16; ++r) { p0[r] = 0.f; p1[r] = 0.f; }
#pragma unroll
    for (int d0 = 0; d0 < 6; ++d0) {
      const bf16x8 k0f = *(const bf16x8*)(sK + r32 * 208 + d0 * 32 + hi * 16);
      const bf16x8 k1f = *(const bf16x8*)(sK + (32 + r32) * 208 + d0 * 32 + hi * 16);
      p0 = mfma32(k0f, qf[d0], p0); p1 = mfma32(k1f, qf[d0], p1);
    }
    float tmax = p0[0];
#pragma unroll
    for (int r = 1; r < 16; ++r) tmax = fmaxf(tmax, p0[r]);
#pragma unroll
    for (int r = 0; r < 16; ++r) tmax = fmaxf(tmax, p1[r]);
    tmax = fmaxf(tmax, __shfl_xor(tmax, 32));
    const float mn = fmaxf(mrun, tmax);
    const float alpha = exp2f((mrun - mn) * C);
    mrun = mn;
    const float mc = -mn * C;
    float ps = 0.f;
#pragma unroll
    for (int r = 0; r < 16; ++r) { p0[r] = exp2f(fmaf(p0[r], C, mc)); ps += p0[r]; }
#pragma unroll
    for (int r = 0; r < 16; ++r) { p1[r] = exp2f(fmaf(p1[r], C, mc)); ps += p1[r]; }
    ps += __shfl_xor(ps, 32);
    lrun = lrun * alpha + ps;
#pragma unroll
    for (int r = 0; r < 16; ++r) { o0[r] *= alpha; o1[r] *= alpha; }
#pragma unroll
    for (int ks = 0; ks < 4; ++ks) {
      u32x4 pw;
      if (ks == 0) { pw.x = cvtpk(p0[0], p0[1]); pw.y = cvtpk(p0[2], p0[3]); pw.z = cvtpk(p0[4], p0[5]); pw.w = cvtpk(p0[6], p0[7]); }
      else if (ks == 1) { pw.x = cvtpk(p0[8], p0[9]); pw.y = cvtpk(p0[10], p0[11]); pw.z = cvtpk(p0[12], p0[13]); pw.w = cvtpk(p0[14], p0[15]); }
      else if (ks == 2) { pw.x = cvtpk(p1[0], p1[1]); pw.y = cvtpk(p1[2], p1[3]); pw.z = cvtpk(p1[4], p1[5]); pw.w = cvtpk(p1[6], p1[7]); }
      else { pw.x = cvtpk(p1[8], p1[9]); pw.y = cvtpk(p1[10], p1[11]); pw.z = cvtpk(p1[12], p1[13]); pw.w = cvtpk(p1[14], p1[15]); }
      const bf16x8 pf = *(const bf16x8*)&pw;
      const int kb = ks * 16 + hi * 4;
      u32x4 va, vb;
      { const u32x2 a0 = *(const u32x2*)(sV + r32 * 144 + kb * 2), a1 = *(const u32x2*)(sV + r32 * 144 + (kb + 8) * 2); va.x = a0.x; va.y = a0.y; va.z = a1.x; va.w = a1.y; }
      { const u32x2 a0 = *(const u32x2*)(sV + (32 + r32) * 144 + kb * 2), a1 = *(const u32x2*)(sV + (32 + r32) * 144 + (kb + 8) * 2); vb.x = a0.x; vb.y = a0.y; vb.z = a1.x; vb.w = a1.y; }
      o0 = mfma32(*(const bf16x8*)&va, pf, o0);
      o1 = mfma32(*(const bf16x8*)&vb, pf, o1);
    }
  }
  const float inv = 1.f / lrun;
  bf16_t* op = CAT + (size_t)qrow * 1024 + h * 64 + hi * 4;
#pragma unroll
  for (int g = 0; g < 4; ++g) {
    u32x2 w; w.x = cvtpk(o0[g * 4] * inv, o0[g * 4 + 1] * inv); w.y = cvtpk(o0[g * 4 + 2] * inv, o0[g * 4 + 3] * inv);
    *(u32x2*)(op + g * 8) = w;
    w.x = cvtpk(o1[g * 4] * inv, o1[g * 4 + 1] * inv); w.y = cvtpk(o1[g * 4 + 2] * inv, o1[g * 4 + 3] * inv);
    *(u32x2*)(op + 32 + g * 8) = w;
  }
}

DI void unpack8(u32x4 w, float* f) {
  f[0] = lo_f(w.x); f[1] = hi_f(w.x); f[2] = lo_f(w.y); f[3] = hi_f(w.y); f[4] = lo_f(w.z); f[5] = hi_f(w.z); f[6] = lo_f(w.w); f[7] = hi_f(w.w);
}
DI int scan_row(int d, int gi) { return d == 0 ? gi : (gi < NCX ? NCX - 1 - gi : TB - 1 - (gi - NCX)); }
DI void scan_unit(const Params& p, int u, char* smem) {
  const int tid = VT, lane = tid & 63, wid = tid >> 6, fr = lane & 15, fq = lane >> 4;
  const int half = u & 1, d = (u >> 1) & 1, h = (u >> 2) & 7, b = u >> 5;
  float* R_ = (float*)smem; float* KD_ = R_ + 2048; float* KK_ = KD_ + 2048; float* WD_ = KK_ + 2048; float* BV_ = WD_ + 2048;
  float* V_ = BV_ + 2048; float* YO_ = V_ + 1024; char* TW_ = (char*)(YO_ + 1024); char* AL_ = TW_ + 32 * 144;
  float* NRM_ = (float*)(AL_ + 32 * 144); float* BONS_ = NRM_ + 32;
  const bf16_t* FRW = (const bf16_t*)(p.ws + O_FRW);
  const float* mu = p.in[12];
  float* Y = (float*)((char*)p.out + OO_Y);
  float* BON = (float*)(p.ws + O_BON);
  const int hc = h * 64 + wid * 16 + fr;
  bf16x8 w2f0, w2f1, a2f0, a2f1;
  {
    const bf16_t* w2t = (const bf16_t*)(p.ws + O_W2T) + (size_t)(d * 512 + hc) * 64 + fq * 8;
    const bf16_t* a2t = (const bf16_t*)(p.ws + O_A2T) + (size_t)(d * 512 + hc) * 64 + fq * 8;
    w2f0 = *(const bf16x8*)w2t; w2f1 = *(const bf16x8*)(w2t + 32);
    a2f0 = *(const bf16x8*)a2t; a2f1 = *(const bf16x8*)(a2t + 32);
  }
  const float w0c = p.in[13][d * 512 + hc], a0c = p.in[15][d * 512 + hc], kkc = p.in[18][hc], kac = p.in[19][hc], rkc = p.in[20][hc];
  const int il = tid >> 3, js = tid & 7;
  f32x2 S0 = {0.f, 0.f}, S1 = {0.f, 0.f}, S2 = {0.f, 0.f}, S3 = {0.f, 0.f};
  if (tid < 32) { NRM_[tid] = 0.f; BONS_[tid] = 0.f; }
  __syncthreads();
  for (int ci = 0; ci < 72; ++ci) {
    for (int it = tid; it < 1152; it += 256) {
      const int s = it / 36, g = it - s * 36;
      const int j = scan_row(d, ci * 32 + s);
      const size_t row = (size_t)b * TB + j;
      int col;
      if (g < 8) col = h * 64 + g * 8; else if (g < 16) col = 512 + h * 64 + (g - 8) * 8; else if (g < 20) col = 1024 + h * 64 + half * 32 + (g - 16) * 8;
      else if (g < 28) col = 1536 + d * 64 + (g - 20) * 8; else col = 1664 + d * 64 + (g - 28) * 8;
      const bool pv = (j != 0 && j != NCX), nv = (j != NCX - 1 && j != TB - 1);
      const u32x4 z4 = {0u, 0u, 0u, 0u};
      const u32x4 fc = *(const u32x4*)(FRW + row * 1920 + col);
      const u32x4 fp = pv ? *(const u32x4*)(FRW + (row - 1) * 1920 + col) : z4;
      const u32x4 fn = nv ? *(const u32x4*)(FRW + (row + 1) * 1920 + col) : z4;
      float xc[8], xp[8], xn[8], xs[8], mm[8];
      unpack8(fc, xc); unpack8(fp, xp); unpack8(fn, xn);
      { const f32x4 m0 = *(const f32x4*)(mu + col), m1 = *(const f32x4*)(mu + col + 4); mm[0] = m0[0]; mm[1] = m0[1]; mm[2] = m0[2]; mm[3] = m0[3]; mm[4] = m1[0]; mm[5] = m1[1]; mm[6] = m1[2]; mm[7] = m1[3]; }
#pragma unroll
      for (int e = 0; e < 8; ++e) xs[e] = xc[e] + mm[e] * (0.5f * (xp[e] + xn[e]) - xc[e]);
      if (g < 16) {
        float* dst = (g < 8 ? R_ + s * 64 + g * 8 : KD_ + s * 64 + (g - 8) * 8);
        *(f32x4*)dst = (f32x4){xs[0], xs[1], xs[2], xs[3]}; *(f32x4*)(dst + 4) = (f32x4){xs[4], xs[5], xs[6], xs[7]};
        if (g >= 8) {
          const float* kkp = p.in[18] + h * 64 + (g - 8) * 8; float sq = 0.f;
#pragma unroll
          for (int e = 0; e < 8; ++e) { const float t = xs[e] * kkp[e]; sq += t * t; }
          atomicAdd(&NRM_[s], sq);
        }
      } else if (g < 20) {
        float* dst = V_ + s * 32 + (g - 16) * 8;
        *(f32x4*)dst = (f32x4){xs[0], xs[1], xs[2], xs[3]}; *(f32x4*)(dst + 4) = (f32x4){xs[4], xs[5], xs[6], xs[7]};
      } else if (g < 28) {
        u32x4 w; w.x = cvtpk(tanh_fast(xs[0]), tanh_fast(xs[1])); w.y = cvtpk(tanh_fast(xs[2]), tanh_fast(xs[3])); w.z = cvtpk(tanh_fast(xs[4]), tanh_fast(xs[5])); w.w = cvtpk(tanh_fast(xs[6]), tanh_fast(xs[7]));
        *(u32x4*)(TW_ + s * 144 + (g - 20) * 16) = w;
      } else {
        u32x4 w; w.x = cvtpk(xs[0], xs[1]); w.y = cvtpk(xs[2], xs[3]); w.z = cvtpk(xs[4], xs[5]); w.w = cvtpk(xs[6], xs[7]);
        *(u32x4*)(AL_ + s * 144 + (g - 28) * 16) = w;
      }
    }
    __syncthreads();
    {
#pragma unroll
      for (int m = 0; m < 2; ++m) {
        f32x4 accw = {0.f, 0.f, 0.f, 0.f}, acca = {0.f, 0.f, 0.f, 0.f};
        const bf16x8 t0 = *(const bf16x8*)(TW_ + (m * 16 + fr) * 144 + fq * 16), t1 = *(const bf16x8*)(TW_ + (m * 16 + fr) * 144 + 64 + fq * 16);
        const bf16x8 l0 = *(const bf16x8*)(AL_ + (m * 16 + fr) * 144 + fq * 16), l1 = *(const bf16x8*)(AL_ + (m * 16 + fr) * 144 + 64 + fq * 16);
        accw = mfma16(t0, w2f0, accw); accw = mfma16(t1, w2f1, accw);
        acca = mfma16(l0, a2f0, acca); acca = mfma16(l1, a2f1, acca);
#pragma unroll
        for (int e = 0; e < 4; ++e) {
          const int s = m * 16 + fq * 4 + e, idx = s * 64 + wid * 16 + fr;
          const float sg = sigmoidf_(w0c + accw[e]);
          const float decay = __expf(-0.6065306597126334f * sg);
          const float a = sigmoidf_(a0c + acca[e]);
          const float kraw = KD_[idx];
          const float kkn = kraw * kkc * rsqrtf(NRM_[s] + 1e-12f);
          KK_[idx] = kkn; WD_[idx] = decay; BV_[idx] = kkn * a;
          const float kd = kraw * (1.f + (a - 1.f) * kac);
          KD_[idx] = kd;
          float bon = R_[idx] * kd * rkc;
          bon = red16(bon);
          if (fr == 0) atomicAdd(&BONS_[s], bon);
        }
      }
    }
    __syncthreads();
    if (tid < 32) {
      if (half == 0) { const int j = scan_row(d, ci * 32 + tid); BON[((size_t)d * MT + (size_t)b * TB + j) * 8 + h] = BONS_[tid]; }
      BONS_[tid] = 0.f; NRM_[tid] = 0.f;
    }
#pragma unroll 2
    for (int s = 0; s < 32; ++s) {
      const f32x4* pk = (const f32x4*)(KK_ + s * 64 + js * 8); const f32x4 ka = pk[0], kb = pk[1];
      const f32x4* pw = (const f32x4*)(WD_ + s * 64 + js * 8); const f32x4 wa = pw[0], wb = pw[1];
      const f32x4* pb = (const f32x4*)(BV_ + s * 64 + js * 8); const f32x4 ba = pb[0], bb = pb[1];
      const f32x4* pd = (const f32x4*)(KD_ + s * 64 + js * 8); const f32x4 da = pd[0], db = pd[1];
      const f32x4* pr = (const f32x4*)(R_ + s * 64 + js * 8); const f32x4 ra = pr[0], rb = pr[1];
      const float v = V_[s * 32 + il];
      f32x2 t = S0 * (f32x2){ka[0], ka[1]} + S1 * (f32x2){ka[2], ka[3]};
      f32x2 t2 = S2 * (f32x2){kb[0], kb[1]} + S3 * (f32x2){kb[2], kb[3]};
      t = t + t2;
      const float sa = red8(t[0] + t[1]);
      const f32x2 nsa = {-sa, -sa}, vv = {v, v};
      S0 = S0 * (f32x2){wa[0], wa[1]} + nsa * (f32x2){ba[0], ba[1]} + vv * (f32x2){da[0], da[1]};
      S1 = S1 * (f32x2){wa[2], wa[3]} + nsa * (f32x2){ba[2], ba[3]} + vv * (f32x2){da[2], da[3]};
      S2 = S2 * (f32x2){wb[0], wb[1]} + nsa * (f32x2){bb[0], bb[1]} + vv * (f32x2){db[0], db[1]};
      S3 = S3 * (f32x2){wb[2], wb[3]} + nsa * (f32x2){bb[2], bb[3]} + vv * (f32x2){db[2], db[3]};
      f32x2 y = S0 * (f32x2){ra[0], ra[1]} + S1 * (f32x2){ra[2], ra[3]};
      f32x2 y2 = S2 * (f32x2){rb[0], rb[1]} + S3 * (f32x2){rb[2], rb[3]};
      y = y + y2;
      const float yy = red8(y[0] + y[1]);
      if (js == 0) YO_[s * 32 + il] = yy;
    }
    __syncthreads();
    {
      const int s = tid >> 3, i4 = (tid & 7) * 4;
      const int j = scan_row(d, ci * 32 + s);
      float* yp = Y + ((size_t)b * TB + j) * 512 + h * 64 + half * 32 + i4;
      const f32x4 yv = *(const f32x4*)(YO_ + s * 32 + i4);
      atomicAdd(yp, yv[0]); atomicAdd(yp + 1, yv[1]); atomicAdd(yp + 2, yv[2]); atomicAdd(yp + 3, yv[3]);
    }
  }
  __syncthreads();
}

DI void scan_unit8(const Params& p, int u, char* dsm) {
  const int tid = opaque_tid(), lane = tid & 63, wid = __builtin_amdgcn_readfirstlane(tid >> 6), fr = lane & 15, fq = lane >> 4;
  const int d = u & 1, h = (u >> 1) & 7, b = u >> 4;
  const bool producer = wid >= 4;
  float* FB = (float*)dsm;
  float* YO = FB + 2 * 12288;
  char* TW_ = (char*)(YO + 2 * 2048); char* AL_ = TW_ + 32 * 144;
  float* NRM = (float*)(AL_ + 32 * 144); float* BONS = NRM + 64;
  const bf16_t* FRW = (const bf16_t*)(p.ws + O_FRW);
  const float* mu = p.in[12];
  float* Y = (float*)((char*)p.out + OO_Y);
  float* BON = (float*)(p.ws + O_BON);
  const int pt = tid & 255, pw = wid & 3;
  const int hc = h * 64 + pw * 16 + fr;
  bf16x8 w2f0, w2f1, a2f0, a2f1;
  {
    const bf16_t* w2t = (const bf16_t*)(p.ws + O_W2T) + (size_t)(d * 512 + hc) * 64 + fq * 8;
    const bf16_t* a2t = (const bf16_t*)(p.ws + O_A2T) + (size_t)(d * 512 + hc) * 64 + fq * 8;
    w2f0 = *(const bf16x8*)w2t; w2f1 = *(const bf16x8*)(w2t + 32);
    a2f0 = *(const bf16x8*)a2t; a2f1 = *(const bf16x8*)(a2t + 32);
  }
  const float w0c = p.in[13][d * 512 + hc], a0c = p.in[15][d * 512 + hc], kkc = p.in[18][hc], kac = p.in[19][hc], rkc = p.in[20][hc];
  const int rp = pt >> 3, js = pt & 7;
  f32x2 Sa0 = {0.f, 0.f}, Sa1 = {0.f, 0.f}, Sa2 = {0.f, 0.f}, Sa3 = {0.f, 0.f};
  f32x2 Sb0 = {0.f, 0.f}, Sb1 = {0.f, 0.f}, Sb2 = {0.f, 0.f}, Sb3 = {0.f, 0.f};
  __syncthreads();
  if (tid < 64) { NRM[tid] = 0.f; BONS[tid] = 0.f; }
  __syncthreads();

  auto S1 = [&](int ci) {
    float* F = FB + (ci & 1) * 12288; float* nrm = NRM + (ci & 1) * 32;
    u32x4 fc[5], fp[5], fn[5];
#pragma unroll
    for (int k = 0; k < 5; ++k) {
      const int it = pt + k * 256, s = it / 40, g = it - s * 40;
      const int j = scan_row(d, ci * 32 + s);
      const size_t row = (size_t)b * TB + j;
      const int col = (g < 24 ? (g >> 3) * 512 + h * 64 + (g & 7) * 8 : (g < 32 ? 1536 + d * 64 + (g - 24) * 8 : 1664 + d * 64 + (g - 32) * 8));
      const bool pv = (j != 0 && j != NCX), nv = (j != NCX - 1 && j != TB - 1);
      const u32x4 z4 = {0u, 0u, 0u, 0u};
      fc[k] = *(const u32x4*)(FRW + row * 1920 + col);
      fp[k] = pv ? *(const u32x4*)(FRW + (row - 1) * 1920 + col) : z4;
      fn[k] = nv ? *(const u32x4*)(FRW + (row + 1) * 1920 + col) : z4;
    }
#pragma unroll
    for (int k = 0; k < 5; ++k) {
      const int it = pt + k * 256, s = it / 40, g = it - s * 40;
      const int col = (g < 24 ? (g >> 3) * 512 + h * 64 + (g & 7) * 8 : (g < 32 ? 1536 + d * 64 + (g - 24) * 8 : 1664 + d * 64 + (g - 32) * 8));
      float xc[8], xp[8], xn[8], xs[8], mm[8];
      unpack8(fc[k], xc); unpack8(fp[k], xp); unpack8(fn[k], xn);
      { const f32x4 m0 = *(const f32x4*)(mu + col), m1 = *(const f32x4*)(mu + col + 4); mm[0] = m0[0]; mm[1] = m0[1]; mm[2] = m0[2]; mm[3] = m0[3]; mm[4] = m1[0]; mm[5] = m1[1]; mm[6] = m1[2]; mm[7] = m1[3]; }
#pragma unroll
      for (int e = 0; e < 8; ++e) xs[e] = xc[e] + mm[e] * (0.5f * (xp[e] + xn[e]) - xc[e]);
      if (g < 24) {
        float* dst = (g < 8 ? F + s * 64 + g * 8 : (g < 16 ? F + 2048 + s * 64 + (g - 8) * 8 : F + 10240 + s * 64 + (g - 16) * 8));
        *(f32x4*)dst = (f32x4){xs[0], xs[1], xs[2], xs[3]}; *(f32x4*)(dst + 4) = (f32x4){xs[4], xs[5], xs[6], xs[7]};
        if (g >= 8 && g < 16) {
          const float* kkp = p.in[18] + h * 64 + (g - 8) * 8; float sq = 0.f;
#pragma unroll
          for (int e = 0; e < 8; ++e) { const float t = xs[e] * kkp[e]; sq += t * t; }
          atomicAdd(&nrm[s], sq);
        }
      } else if (g < 32) {
        u32x4 w; w.x = cvtpk(tanh_fast(xs[0]), tanh_fast(xs[1])); w.y = cvtpk(tanh_fast(xs[2]), tanh_fast(xs[3])); w.z = cvtpk(tanh_fast(xs[4]), tanh_fast(xs[5])); w.w = cvtpk(tanh_fast(xs[6]), tanh_fast(xs[7]));
        *(u32x4*)(TW_ + s * 144 + (g - 24) * 16) = w;
      } else {
        u32x4 w; w.x = cvtpk(xs[0], xs[1]); w.y = cvtpk(xs[2], xs[3]); w.z = cvtpk(xs[4], xs[5]); w.w = cvtpk(xs[6], xs[7]);
        *(u32x4*)(AL_ + s * 144 + (g - 32) * 16) = w;
      }
    }
  };
  auto S2 = [&](int ci) {
    float* F = FB + (ci & 1) * 12288; float* R_ = F; float* KD_ = F + 2048; float* KK_ = F + 4096; float* WD_ = F + 6144; float* BV_ = F + 8192;
    const float* nrm = NRM + (ci & 1) * 32; float* bons = BONS + (ci & 1) * 32;
#pragma unroll
    for (int m = 0; m < 2; ++m) {
      f32x4 accw = {0.f, 0.f, 0.f, 0.f}, acca = {0.f, 0.f, 0.f, 0.f};
      const bf16x8 t0 = *(const bf16x8*)(TW_ + (m * 16 + fr) * 144 + fq * 16), t1 = *(const bf16x8*)(TW_ + (m * 16 + fr) * 144 + 64 + fq * 16);
      const bf16x8 l0 = *(const bf16x8*)(AL_ + (m * 16 + fr) * 144 + fq * 16), l1 = *(const bf16x8*)(AL_ + (m * 16 + fr) * 144 + 64 + fq * 16);
      accw = mfma16(t0, w2f0, accw); accw = mfma16(t1, w2f1, accw);
      acca = mfma16(l0, a2f0, acca); acca = mfma16(l1, a2f1, acca);
#pragma unroll
      for (int e = 0; e < 4; ++e) {
        const int s = m * 16 + fq * 4 + e, idx = s * 64 + pw * 16 + fr;
        const float sg = sigmoidf_(w0c + accw[e]);
        const float decay = __expf(-0.6065306597126334f * sg);
        const float a = sigmoidf_(a0c + acca[e]);
        const float kraw = KD_[idx];
        const float kkn = kraw * kkc * rsqrtf(nrm[s] + 1e-12f);
        KK_[idx] = kkn; WD_[idx] = decay; BV_[idx] = kkn * a;
        const float kd = kraw * (1.f + (a - 1.f) * kac);
        KD_[idx] = kd;
        float bon = R_[idx] * kd * rkc;
        bon = red16(bon);
        if (fr == 0) atomicAdd(&bons[s], bon);
      }
    }
    if (pt < 32) NRM[((ci & 1) ^ 1) * 32 + pt] = 0.f;
  };
  struct StepVec { f32x4 ra, rb, da, db, ka, kb, wa, wb, ba, bb; f32x2 v2; };
  auto LOADV = [&](StepVec& X, const float* F, int s) {
    const f32x4* pr = (const f32x4*)(F + s * 64 + js * 8); X.ra = pr[0]; X.rb = pr[1];
    const f32x4* pd = (const f32x4*)(F + 2048 + s * 64 + js * 8); X.da = pd[0]; X.db = pd[1];
    const f32x4* pk = (const f32x4*)(F + 4096 + s * 64 + js * 8); X.ka = pk[0]; X.kb = pk[1];
    const f32x4* pw_ = (const f32x4*)(F + 6144 + s * 64 + js * 8); X.wa = pw_[0]; X.wb = pw_[1];
    const f32x4* pb = (const f32x4*)(F + 8192 + s * 64 + js * 8); X.ba = pb[0]; X.bb = pb[1];
    X.v2 = *(const f32x2*)(F + 10240 + s * 64 + rp * 2);
  };
  auto STEP = [&](const StepVec& X, float* yo, int s) {
    const f32x2 k01 = {X.ka[0], X.ka[1]}, k23 = {X.ka[2], X.ka[3]}, k45 = {X.kb[0], X.kb[1]}, k67 = {X.kb[2], X.kb[3]};
    f32x2 ta = Sa0 * k01; ta = Sa1 * k23 + ta; ta = Sa2 * k45 + ta; ta = Sa3 * k67 + ta;
    f32x2 tb = Sb0 * k01; tb = Sb1 * k23 + tb; tb = Sb2 * k45 + tb; tb = Sb3 * k67 + tb;
    const float saa = red8(ta[0] + ta[1]), sab = red8(tb[0] + tb[1]);
    const f32x2 w01 = {X.wa[0], X.wa[1]}, w23 = {X.wa[2], X.wa[3]}, w45 = {X.wb[0], X.wb[1]}, w67 = {X.wb[2], X.wb[3]};
    const f32x2 b01 = {X.ba[0], X.ba[1]}, b23 = {X.ba[2], X.ba[3]}, b45 = {X.bb[0], X.bb[1]}, b67 = {X.bb[2], X.bb[3]};
    const f32x2 d01 = {X.da[0], X.da[1]}, d23 = {X.da[2], X.da[3]}, d45 = {X.db[0], X.db[1]}, d67 = {X.db[2], X.db[3]};
    { const f32x2 ns = {-saa, -saa}, vv = {X.v2[0], X.v2[0]};
      Sa0 = Sa0 * w01 + ns * b01 + vv * d01; Sa1 = Sa1 * w23 + ns * b23 + vv * d23; Sa2 = Sa2 * w45 + ns * b45 + vv * d45; Sa3 = Sa3 * w67 + ns * b67 + vv * d67; }
    { const f32x2 ns = {-sab, -sab}, vv = {X.v2[1], X.v2[1]};
      Sb0 = Sb0 * w01 + ns * b01 + vv * d01; Sb1 = Sb1 * w23 + ns * b23 + vv * d23; Sb2 = Sb2 * w45 + ns * b45 + vv * d45; Sb3 = Sb3 * w67 + ns * b67 + vv * d67; }
    const f32x2 r01 = {X.ra[0], X.ra[1]}, r23 = {X.ra[2], X.ra[3]}, r45 = {X.rb[0], X.rb[1]}, r67 = {X.rb[2], X.rb[3]};
    f32x2 ya = Sa0 * r01; ya = Sa1 * r23 + ya; ya = Sa2 * r45 + ya; ya = Sa3 * r67 + ya;
    f32x2 yb = Sb0 * r01; yb = Sb1 * r23 + yb; yb = Sb2 * r45 + yb; yb = Sb3 * r67 + yb;
    const float y0 = red8_ns(ya[0] + ya[1]), y1 = red8(yb[0] + yb[1]);
    if (js == 0) *(f32x2*)(yo + s * 64 + rp * 2) = (f32x2){y0, y1};
  };
  auto SCAN = [&](int ci, int s0) {
    const float* F = FB + (ci & 1) * 12288; float* yo = YO + (ci & 1) * 2048;
    StepVec A, B;
    LOADV(A, F, s0);
#pragma unroll 1
    for (int s = s0; s < s0 + 16; s += 2) {
      LOADV(B, F, s + 1);
      STEP(A, yo, s);
      LOADV(A, F, s + 2);
      STEP(B, yo, s + 1);
    }
  };

  if (producer) S1(0);
  __syncthreads();
  if (producer) S2(0);
  __syncthreads();
  for (int ci = 0; ci < 72; ++ci) {
    if (producer) {
      if (pt < 32) { float* bons = BONS + (ci & 1) * 32; const int j = scan_row(d, ci * 32 + pt); BON[((size_t)d * MT + (size_t)b * TB + j) * 8 + h] = bons[pt]; bons[pt] = 0.f; }
      if (ci + 1 < 72) S1(ci + 1);
    } else SCAN(ci, 0);
    __syncthreads();
    if (producer) { if (ci + 1 < 72) S2(ci + 1); }
    else SCAN(ci, 16);
    __syncthreads();
    if (!producer) {
      const float* yo = YO + (ci & 1) * 2048;
      const int s = pt >> 3, i8 = (pt & 7) * 8;
      const int j = scan_row(d, ci * 32 + s);
      bf16_t* yp = (bf16_t*)((char*)p.out + OO_Y) + (size_t)d * MT * 512 + ((size_t)b * TB + j) * 512 + h * 64 + i8;
      const f32x4 y0 = *(const f32x4*)(yo + s * 64 + i8), y1 = *(const f32x4*)(yo + s * 64 + i8 + 4);
      u32x4 w; w.x = cvtpk(y0[0], y0[1]); w.y = cvtpk(y0[2], y0[3]); w.z = cvtpk(y1[0], y1[1]); w.w = cvtpk(y1[2], y1[3]);
      *(u32x4*)yp = w;
    }
  }
  __syncthreads();
}

DI unsigned sb_ld(unsigned* q) { return __hip_atomic_load(q, __ATOMIC_RELAXED, __HIP_MEMORY_SCOPE_AGENT); }
DI void qkv_work(const Params& p, char* dsm, int b3, int n3) {
  char* ws = p.ws;
  EpiQ eq{(bf16_t*)(ws + O_Q), (const float*)(ws + O_RSQ), (const float*)(ws + O_ROPE)};
  gemm8_phase((const bf16_t*)(ws + O_FQ), 384, (const bf16_t*)(ws + O_WUQ), 384, 384, 72, 3, 0, 0, eq, dsm, b3, n3);
  EpiKn ek{(bf16_t*)(ws + O_K), (const float*)(ws + O_RSQ), (const float*)(ws + O_FKR), (const float*)(ws + O_ROPE)};
  gemm8_phase((const bf16_t*)(ws + O_FKV), 256, (const bf16_t*)(ws + O_WUK), 256, 256, 72, 2, 0, 0, ek, dsm, (b3 + n3 - (216 % n3)) % n3, n3);
  EpiVt ev{(bf16_t*)((char*)p.out + OO_VT), (const float*)(ws + O_RSQ)};
  gemm8_phase((const bf16_t*)(ws + O_WUV), 256, (const bf16_t*)(ws + O_FKV), 256, 256, 2, 72, 0, 0, ev, dsm, (b3 + n3 - (104 % n3)) % n3, n3);
  EpiGlt eg{(bf16_t*)(ws + O_GLT)};
  gemm8_phase((const bf16_t*)(ws + O_A), 1024, (const bf16_t*)(ws + O_WTAIL), 1024, 1024, 72, 1, 0, 0, eg, dsm, (b3 + n3 - (16 % n3)) % n3, n3);
}
DI void phase_mixer(const Params& p, char* smem, char* dsm, int bid, int nb) {
  unsigned* cnt = (unsigned*)(p.ws + O_CNT);
  const int pbid = blockIdx.x, pnb = gridDim.x;
  const int q0 = pnb >= 192 ? 128 : 0, nq = pnb - q0;
  if (pbid >= q0) {
    qkv_work(p, dsm, pbid - q0, nq);
    asm volatile("s_waitcnt vmcnt(0)" ::: "memory");
    __syncthreads();
    if (threadIdx.x == 0) {
      __builtin_amdgcn_fence(__ATOMIC_RELEASE, "agent");
      asm volatile("s_waitcnt vmcnt(0)" ::: "memory");
      __hip_atomic_fetch_add(cnt + 8, 1u, __ATOMIC_RELAXED, __HIP_MEMORY_SCOPE_AGENT);
    }
  }
  for (int u = pbid; u < 128; u += pnb) scan_unit8(p, u, dsm);
  __syncthreads();
  if (threadIdx.x == 0) {
    unsigned sp = 0;
    while (sb_ld(cnt + 8) < (unsigned)nq) { __builtin_amdgcn_s_sleep(2); if (++sp > (1u << 23)) break; }
    __builtin_amdgcn_fence(__ATOMIC_ACQUIRE, "agent");
    asm volatile("s_waitcnt vmcnt(0)" ::: "memory");
  }
  __syncthreads();
  int* slot = (int*)(dsm + 2 * SMEM_BYTES);
  const int vb = __builtin_amdgcn_readfirstlane(opaque_tid() >> 8);
  for (;;) {
    __syncthreads();
    if (threadIdx.x == 0) *slot = (int)atomicAdd(cnt, 1u);
    __syncthreads();
    const int q = *slot;
    if (q >= 576) break;
    attn_unit(p, 2 * q + vb, smem);
  }
  for (;;) {
    __syncthreads();
    if (threadIdx.x == 0) *slot = (int)atomicAdd(cnt + 2, 1u);
    __syncthreads();
    const int t = p.ncvt_early + 2 * (*slot) + vb;
    if (t - vb >= p.ncvt) break;
    if (t < p.ncvt) p0_cvt(p, t, smem); else { __syncthreads(); __syncthreads(); }
  }
}

DI void rwkv_out_unit(const Params& p, int u, char* smem) {
  const int tid = VT, lane = tid & 63, wid = tid >> 6, wr = wid >> 1, wc = wid & 1, fr = lane & 15, fq = lane >> 4;
  const int mt = u >> 2, nt = u & 3, row0 = mt * 128;
  const bf16_t* FRW = (const bf16_t*)(p.ws + O_FRW);
  const float* mu = p.in[12];
  __syncthreads();
  for (int it = tid; it < 2048; it += 256) {
    const int r = it >> 4, c8 = (it & 15) * 8, row = row0 + r, j = row % TB, col = 1792 + c8;
    const bool pv = (j != 0 && j != NCX), nv = (j != NCX - 1 && j != TB - 1);
    const u32x4 z4 = {0u, 0u, 0u, 0u};
    const bool tail = c8 >= 96;
    const bf16_t* sp_ = tail ? (const bf16_t*)(p.ws + O_GLT) + (size_t)row * 32 + (c8 - 96) : FRW + (size_t)row * 1920 + col;
    const int rs_ = tail ? 32 : 1920;
    const u32x4 fc = *(const u32x4*)sp_;
    const u32x4 fp = pv ? *(const u32x4*)(sp_ - rs_) : z4;
    const u32x4 fn = nv ? *(const u32x4*)(sp_ + rs_) : z4;
    float xc[8], xp[8], xn[8], xs[8];
    unpack8(fc, xc); unpack8(fp, xp); unpack8(fn, xn);
#pragma unroll
    for (int e = 0; e < 8; ++e) { const float m = mu[col + e]; xs[e] = sigmoidf_(xc[e] + m * (0.5f * (xp[e] + xn[e]) - xc[e])); }
    u32x4 w; w.x = cvtpk(xs[0], xs[1]); w.y = cvtpk(xs[2], xs[3]); w.z = cvtpk(xs[4], xs[5]); w.w = cvtpk(xs[6], xs[7]);
    *(u32x4*)(smem + r * 272 + c8 * 2) = w;
  }
  __syncthreads();
  f32x4 acc[4][4];
#pragma unroll
  for (int m = 0; m < 4; ++m)
#pragma unroll
    for (int n = 0; n < 4; ++n) acc[m][n] = (f32x4){0.f, 0.f, 0.f, 0.f};
  const bf16_t* g2t = (const bf16_t*)(p.ws + O_G2T) + (size_t)(nt * 128 + wc * 64 + fr) * 128 + fq * 8;
#pragma unroll
  for (int kk = 0; kk < 4; ++kk) {
    bf16x8 af[4], bv[4];
#pragma unroll
    for (int m = 0; m < 4; ++m) af[m] = *(const bf16x8*)(smem + (wr * 64 + m * 16 + fr) * 272 + kk * 64 + fq * 16);
#pragma unroll
    for (int n = 0; n < 4; ++n) bv[n] = *(const bf16x8*)(g2t + n * 16 * 128 + kk * 32);
#pragma unroll
    for (int m = 0; m < 4; ++m)
#pragma unroll
      for (int n = 0; n < 4; ++n) acc[m][n] = mfma16(bv[n], af[m], acc[m][n]);
  }
  const int hh = nt * 2 + wc;
  const bf16_t* Yb = (const bf16_t*)((const char*)p.out + OO_Y);
  const float* BON = (const float*)(p.ws + O_BON);
  const float* gnw = p.in[21]; const float* gnb = p.in[22];
  bf16_t* CAT = (bf16_t*)(p.ws + O_A);
#pragma unroll
  for (int m = 0; m < 4; ++m) {
    const int row = row0 + wr * 64 + m * 16 + fr, j = row % TB;
    const bool pv = (j != 0 && j != NCX), nv = (j != NCX - 1 && j != TB - 1);
    f32x4 y[4]; float s = 0.f;
#pragma unroll
    for (int n = 0; n < 4; ++n) {
      const u32x2 ya = *(const u32x2*)(Yb + (size_t)row * 512 + hh * 64 + n * 16 + fq * 4), yb = *(const u32x2*)(Yb + (size_t)MT * 512 + (size_t)row * 512 + hh * 64 + n * 16 + fq * 4);
      y[n] = (f32x4){lo_f(ya.x) + lo_f(yb.x), hi_f(ya.x) + hi_f(yb.x), lo_f(ya.y) + lo_f(yb.y), hi_f(ya.y) + hi_f(yb.y)};
      s += y[n][0] + y[n][1] + y[n][2] + y[n][3];
    }
    s += __shfl_xor(s, 16); s += __shfl_xor(s, 32);
    const float mean = s * (1.f / 64.f); float q = 0.f;
#pragma unroll
    for (int n = 0; n < 4; ++n) { const f32x4 dd = y[n] - mean; q += dd[0] * dd[0] + dd[1] * dd[1] + dd[2] * dd[2] + dd[3] * dd[3]; }
    q += __shfl_xor(q, 16); q += __shfl_xor(q, 32);
    const float rstd = rsqrtf(q * (1.f / 64.f) + 64e-5f);
    const float bsum = BON[(size_t)row * 8 + hh] + BON[((size_t)MT + row) * 8 + hh];
#pragma unroll
    for (int n = 0; n < 4; ++n) {
      const int c = hh * 64 + n * 16 + fq * 4, col = 1024 + c;
      const u32x2 z2 = {0u, 0u};
      const u32x2 fc = *(const u32x2*)(FRW + (size_t)row * 1920 + col);
      const u32x2 fp = pv ? *(const u32x2*)(FRW + (size_t)(row - 1) * 1920 + col) : z2;
      const u32x2 fn = nv ? *(const u32x2*)(FRW + (size_t)(row + 1) * 1920 + col) : z2;
      const float xc[4] = {lo_f(fc.x), hi_f(fc.x), lo_f(fc.y), hi_f(fc.y)}, xp[4] = {lo_f(fp.x), hi_f(fp.x), lo_f(fp.y), hi_f(fp.y)}, xn[4] = {lo_f(fn.x), hi_f(fn.x), lo_f(fn.y), hi_f(fn.y)};
      const f32x4 mm = *(const f32x4*)(mu + col), gw = *(const f32x4*)(gnw + c), gb = *(const f32x4*)(gnb + c);
      f32x4 o;
#pragma unroll
      for (int e = 0; e < 4; ++e) {
        const float v = xc[e] + mm[e] * (0.5f * (xp[e] + xn[e]) - xc[e]);
        const float yn = (y[n][e] - mean) * rstd * gw[e] + gb[e];
        o[e] = (yn + bsum * v) * acc[m][n][e];
      }
      *(u32x2*)(CAT + (size_t)row * 1024 + 512 + c) = pack4(o);
    }
  }
}

DI float wave_sum(float v) {
#pragma unroll
  for (int o = 1; o < 64; o <<= 1) v += __shfl_xor(v, o);
  return v;
}
DI void phase_ln(const Params& p, const float* g, const float* bt, const float* mods, int sh_off, int sc_off, int latent_only, int is_final, int bid, int nb, int ctx_comb = 0) {
  const int lane = VT & 63, wid = VT >> 6;
  float* XA = (float*)(p.ws + O_X); bf16_t* H = (bf16_t*)(p.ws + O_A);
  const int nrows = latent_only ? 16384 : MT;
  f32x4 gv[4], bv[4];
#pragma unroll
  for (int i = 0; i < 4; ++i) { gv[i] = *(const f32x4*)(g + i * 256 + lane * 4); bv[i] = *(const f32x4*)(bt + i * 256 + lane * 4); }
  for (int ri = bid * 4 + wid; ri < nrows; ri += nb * 4) {
    const int row = latent_only ? (ri >> 11) * TB + NCX + (ri & 2047) : ri;
    float* xr = XA + (size_t)row * 1024;
    f32x4 v[4]; float s = 0.f;
    const float* mp = mods + modrow_of(row) * 6144;
    f32x4 scv[4], shv[4];
#pragma unroll
    for (int i = 0; i < 4; ++i) v[i] = *(const f32x4*)(xr + i * 256 + lane * 4);
    if (!is_final) {
#pragma unroll
      for (int i = 0; i < 4; ++i) { scv[i] = *(const f32x4*)(mp + sc_off + i * 256 + lane * 4); shv[i] = *(const f32x4*)(mp + sh_off + i * 256 + lane * 4); }
    }
    if (ctx_comb && (row % TB) < NCX) {
      const f32x2 st1 = *(const f32x2*)((const float*)(p.ws + O_STATS) + (size_t)row * 2);
      const float* g2p = (const float*)(p.ws + O_MODS) + 8 * 6144 + 5120;
      const int cr = (row / TB) * NCX + (row % TB);
      const float* P = p.out;
#pragma unroll
      for (int i = 0; i < 4; ++i) {
        const int c = i * 256 + lane * 4;
        f32x4 acc = *(const f32x4*)(P + (size_t)cr * 1024 + c);
#pragma unroll
        for (int sp_ = 1; sp_ < 8; ++sp_) acc += *(const f32x4*)(P + ((size_t)sp_ * 2048 + cr) * 1024 + c);
        v[i] = ALPHA * ((v[i] - st1[0]) * st1[1] * *(const f32x4*)(p.in[24] + c) + *(const f32x4*)(p.in[25] + c)) + *(const f32x4*)(g2p + c) * acc;
      }
    }
#pragma unroll
    for (int i = 0; i < 4; ++i) s += v[i][0] + v[i][1] + v[i][2] + v[i][3];
    const float mean = wave_sum(s) * (1.f / 1024.f);
    float q = 0.f;
#pragma unroll
    for (int i = 0; i < 4; ++i) { const f32x4 dd = v[i] - mean; q += dd[0] * dd[0] + dd[1] * dd[1] + dd[2] * dd[2] + dd[3] * dd[3]; }
    const float rstd = rsqrtf(wave_sum(q) * (1.f / 1024.f) + 1e-5f);
    if (!is_final && lane == 0) *(f32x2*)((float*)(p.ws + O_STATS) + (size_t)row * 2) = (f32x2){mean, rstd};
#pragma unroll
    for (int i = 0; i < 4; ++i) {
      const int c = i * 256 + lane * 4;
      const f32x4 o = (v[i] - mean) * rstd * gv[i] + bv[i];
      if (is_final) *(f32x4*)(p.out + (size_t)ri * 1024 + c) = o;
      else {
        const f32x4 hm = o * (1.f + scv[i]) + shv[i];
        *(u32x2*)(H + (size_t)row * 1024 + c) = pack4(hm);
      }
    }
  }
}

DI void lru_unit(const Params& p, int u, int pass, char* smem) {
  const int tid = VT, lane = tid & 63, wid = tid >> 6, fr = lane & 15, fq = lane >> 4;
  const int ci = u % 72, k = (u / 72) & 7, b = u / 576;
  if (pass == 2 && ci < 8) return;
  float* XC_ = (float*)smem; char* At_ = smem + 16384; float* A_ = (float*)(smem + 16384 + 8704); float* U_ = A_ + 4096;
  const bf16_t* XR = (const bf16_t*)(p.ws + O_XR);
  const int j0 = ci * 32, row0 = b * TB + j0, seg_lo = ci < 8 ? 0 : NCX, seg_hi = ci < 8 ? NCX - 1 : TB - 1;
  const float* cw = p.in[33]; const float* cb = p.in[34];
  bf16x8 bga[2][4], bgx[2][4];
  float gabv[2][2], gxbv[2][2], lamv[2][2];
  {
    const bf16_t* ga = (const bf16_t*)(p.ws + O_GAT) + (size_t)(k * 128 + wid * 32 + fr) * 128 + fq * 8;
    const bf16_t* gx = (const bf16_t*)(p.ws + O_GXT) + (size_t)(k * 128 + wid * 32 + fr) * 128 + fq * 8;
#pragma unroll
    for (int n = 0; n < 2; ++n)
#pragma unroll
      for (int kk = 0; kk < 4; ++kk) { bga[n][kk] = *(const bf16x8*)(ga + n * 2048 + kk * 32); bgx[n][kk] = *(const bf16x8*)(gx + n * 2048 + kk * 32); }
#pragma unroll
    for (int d = 0; d < 2; ++d)
#pragma unroll
      for (int n = 0; n < 2; ++n) { const int ch = d * 1024 + k * 128 + wid * 32 + n * 16 + fr; gabv[d][n] = p.in[36][ch]; gxbv[d][n] = p.in[38][ch]; lamv[d][n] = ((const float*)(p.ws + O_SP))[ch]; }
  }
  __syncthreads();
  for (int it = tid; it < 512; it += 256) {
    const int t = it >> 4, c8 = (it & 15) * 8, j = j0 + t, ch = k * 128 + c8;
    float a[8];
#pragma unroll
    for (int e = 0; e < 8; ++e) a[e] = cb[ch + e];
#pragma unroll
    for (int i = 0; i < 4; ++i) {
      const int jj = j + i - 2;
      if (jj >= seg_lo && jj <= seg_hi) {
        float x[8]; unpack8(*(const u32x4*)(XR + (size_t)(b * TB + jj) * 1024 + ch), x);
#pragma unroll
        for (int e = 0; e < 8; ++e) a[e] += x[e] * cw[i * 1024 + ch + e];
      }
    }
    *(f32x4*)(XC_ + t * 128 + c8) = (f32x4){a[0], a[1], a[2], a[3]}; *(f32x4*)(XC_ + t * 128 + c8 + 4) = (f32x4){a[4], a[5], a[6], a[7]};
    u32x4 w; w.x = cvtpk(a[0], a[1]); w.y = cvtpk(a[2], a[3]); w.z = cvtpk(a[4], a[5]); w.w = cvtpk(a[6], a[7]);
    *(u32x4*)(At_ + t * 272 + c8 * 2) = w;
  }
  __syncthreads();
  float hs[32];
#pragma unroll
  for (int t = 0; t < 32; ++t) hs[t] = 0.f;
  f32x2* CARRY = (f32x2*)(p.ws + O_CARRY); const float* HIN = (const float*)(p.ws + O_HIN);
#pragma unroll
  for (int d = 0; d < 2; ++d) {
    f32x4 aa[2][2], ax[2][2];
#pragma unroll
    for (int m = 0; m < 2; ++m)
#pragma unroll
      for (int n = 0; n < 2; ++n) { aa[m][n] = (f32x4){0.f, 0.f, 0.f, 0.f}; ax[m][n] = (f32x4){0.f, 0.f, 0.f, 0.f}; }
#pragma unroll
    for (int kk = 0; kk < 4; ++kk) {
      bf16x8 af[2];
#pragma unroll
      for (int m = 0; m < 2; ++m) af[m] = *(const bf16x8*)(At_ + (m * 16 + fr) * 272 + kk * 64 + fq * 16);
#pragma unroll
      for (int n = 0; n < 2; ++n)
#pragma unroll
        for (int m = 0; m < 2; ++m) { aa[m][n] = mfma16(af[m], bga[n][kk], aa[m][n]); ax[m][n] = mfma16(af[m], bgx[n][kk], ax[m][n]); }
    }
    if (d == 0) {
      const bf16_t* ga = (const bf16_t*)(p.ws + O_GAT) + (size_t)((8 + k) * 128 + wid * 32 + fr) * 128 + fq * 8;
      const bf16_t* gx = (const bf16_t*)(p.ws + O_GXT) + (size_t)((8 + k) * 128 + wid * 32 + fr) * 128 + fq * 8;
#pragma unroll
      for (int n = 0; n < 2; ++n)
#pragma unroll
        for (int kk = 0; kk < 4; ++kk) { bga[n][kk] = *(const bf16x8*)(ga + n * 2048 + kk * 32); bgx[n][kk] = *(const bf16x8*)(gx + n * 2048 + kk * 32); }
    }
    const size_t cidx = ((size_t)((b * 2 + d) * 72 + ci)) * 1024 + k * 128 + (tid & 127);
    float hin = 0.f;
    if (pass == 2 && tid < 128) hin = HIN[cidx];
#pragma unroll
    for (int n = 0; n < 2; ++n) {
      const int cc = wid * 32 + n * 16 + fr;
      const float gab = gabv[d][n], gxb = gxbv[d][n];
      const float sp = lamv[d][n];
#pragma unroll
      for (int m = 0; m < 2; ++m)
#pragma unroll
        for (int e = 0; e < 4; ++e) {
          const int t = m * 16 + fq * 4 + e;
          const float e1 = 1.f + __expf(-(aa[m][n][e] + gab)), e2 = 1.f + __expf(-(ax[m][n][e] + gxb));
          const float inv = __builtin_amdgcn_rcpf(e1 * e2);
          const float r = e2 * inv, ig = e1 * inv;
          const float av = __expf(-sp * r);
          A_[t * 128 + cc] = av;
          U_[t * 128 + cc] = __builtin_amdgcn_sqrtf(fmaxf(fmaf(-av, av, 1.f), 0.f)) * ig * XC_[t * 128 + cc];
        }
    }
    __syncthreads();
    if (tid < 128) {
      if (pass == 1) {
        float hcur = 0.f, P = 1.f;
#pragma unroll
        for (int tt = 0; tt < 32; ++tt) { const int t = d ? 31 - tt : tt; const float a = A_[t * 128 + tid]; hcur = a * hcur + U_[t * 128 + tid]; P *= a; }
        CARRY[cidx] = (f32x2){P, hcur};
      } else {
        float hcur = hin;
#pragma unroll
        for (int tt = 0; tt < 32; ++tt) { const int t = d ? 31 - tt : tt; hcur = A_[t * 128 + tid] * hcur + U_[t * 128 + tid]; hs[t] += hcur; }
      }
    }
    __syncthreads();
  }
  if (pass == 2) {
    if (tid < 128) {
#pragma unroll
      for (int t = 0; t < 32; ++t) A_[t * 128 + tid] = hs[t];
    }
    __syncthreads();
    const bf16_t* GATE = (const bf16_t*)(p.ws + O_GATE); bf16_t* Pout = (bf16_t*)(p.ws + O_A);
#pragma unroll
    for (int i = 0; i < 2; ++i) {
      const int it = tid + i * 256, t = it >> 4, c8 = (it & 15) * 8;
      const size_t idx = (size_t)(row0 + t) * 1024 + k * 128 + c8;
      float g8[8]; unpack8(*(const u32x4*)(GATE + idx), g8);
      const f32x4 h0 = *(const f32x4*)(A_ + t * 128 + c8), h1 = *(const f32x4*)(A_ + t * 128 + c8 + 4);
      u32x4 w; w.x = cvtpk(g8[0] * h0[0], g8[1] * h0[1]); w.y = cvtpk(g8[2] * h0[2], g8[3] * h0[3]); w.z = cvtpk(g8[4] * h1[0], g8[5] * h1[1]); w.w = cvtpk(g8[6] * h1[2], g8[7] * h1[3]);
      *(u32x4*)(Pout + idx) = w;
    }
  }
}
DI void phase_lru_carry(const Params& p, int bid, int nb) {
  const f32x2* CARRY = (const f32x2*)(p.ws + O_CARRY); float* HIN = (float*)(p.ws + O_HIN);
  for (int gid = bid * 256 + VT; gid < 16384; gid += nb * 256) {
    const int b = gid >> 11, d = (gid >> 10) & 1, ch = gid & 1023;
    const size_t base = ((size_t)((b * 2 + d) * 72)) * 1024 + ch;
    float hcur = 0.f;
#pragma unroll 1
    for (int ob = 0; ob < 72; ob += 24) {
      f32x2 c[24];
#pragma unroll
      for (int q = 0; q < 24; ++q) { const int oi = ob + q; const int ci = d == 0 ? oi : (oi < 8 ? 7 - oi : 71 - (oi - 8)); c[q] = CARRY[base + (size_t)ci * 1024]; }
#pragma unroll
      for (int q = 0; q < 24; ++q) { const int oi = ob + q; const int ci = d == 0 ? oi : (oi < 8 ? 7 - oi : 71 - (oi - 8)); HIN[base + (size_t)ci * 1024] = hcur; hcur = c[q][0] * hcur + c[q][1]; }
    }
  }
}

#define XB_TMO      128
#define XB_XCNT(j)  (256  + 64 * (j))
#define XB_XSUB(j)  (1280 + 64 * (j))
#define XB_XGEN(j)  (2304 + 64 * (j))
#define XB_TOP      3328
#define XB_TOPGEN   3392
#define XCD_BAR_WORDS 3456
#define XB_SPIN_CAP (1u << 22)
#define LAS __attribute__((address_space(3)))
DI unsigned xb_ld(unsigned* p) { return __hip_atomic_load(p, __ATOMIC_RELAXED, __HIP_MEMORY_SCOPE_AGENT); }
DI unsigned xb_add(unsigned* p, unsigned v) { return __hip_atomic_fetch_add(p, v, __ATOMIC_RELAXED, __HIP_MEMORY_SCOPE_AGENT); }
DI unsigned xb_xcc_id() { return (unsigned)__builtin_amdgcn_s_getreg((3 << 11) | 20) & 0xFu; }
#define XB_SPIN(cond, bar) do { unsigned _sp = 0; while (cond) { __builtin_amdgcn_s_sleep(1); \
    if ((++_sp & 255u) == 0u) { if (xb_ld(&(bar)[XB_TMO])) break; if (_sp > XB_SPIN_CAP) { atomicAdd(&(bar)[XB_TMO], 1u); break; } } } } while (0)
struct XcdBarrier { unsigned* bar; unsigned x; volatile LAS unsigned* st; };
DI XcdBarrier xcd_barrier_post(unsigned* bar, volatile LAS unsigned* st) {
  XcdBarrier b; b.bar = bar; b.x = xb_xcc_id(); b.st = st;
  if (threadIdx.x == 0) (void)xb_add(&bar[XB_XCNT(b.x)], 1u);
  return b;
}
DI void xcd_barrier_complete(unsigned* bar, unsigned x, unsigned& nloc, unsigned& nx) {
  const unsigned G = gridDim.x * gridDim.y * gridDim.z;
  unsigned sum, cnt, mine, sp = 0u;
  for (;;) {
    sum = 0u; cnt = 0u; mine = 0u;
#pragma unroll
    for (unsigned j = 0; j < 16; ++j) { const unsigned c = xb_ld(&bar[XB_XCNT(j)]); sum += c; cnt += (c > 0u) ? 1u : 0u; mine = (j == x) ? c : mine; }
    if (sum == G) break;
    __builtin_amdgcn_s_sleep(1);
    if ((++sp & 255u) == 0u) { if (xb_ld(&bar[XB_TMO])) break; if (sp > XB_SPIN_CAP) { atomicAdd(&bar[XB_TMO], 1u); break; } }
  }
  nloc = mine > 0u ? mine : 1u; nx = cnt > 0u ? cnt : 1u;
}
DI void xcd_barrier(const XcdBarrier& b) {
  asm volatile("s_waitcnt vmcnt(0)" ::: "memory");
  __syncthreads();
  if (threadIdx.x == 0) {
    unsigned* bar = b.bar;
    __builtin_amdgcn_s_waitcnt(0);
    unsigned nloc = b.st[0], nx = b.st[1];
    if (nloc == 0u) { xcd_barrier_complete(bar, b.x, nloc, nx); b.st[0] = nloc; b.st[1] = nx; }
    const unsigned old = xb_add(&bar[XB_XSUB(b.x)], 1u);
    const unsigned gen = old / nloc;
    if (old + 1u == (gen + 1u) * nloc) {
      __builtin_amdgcn_fence(__ATOMIC_RELEASE, "agent");
      asm volatile("s_waitcnt vmcnt(0)" ::: "memory");
      const unsigned og = xb_add(&bar[XB_TOP], 1u);
      const unsigned tg = og / nx;
      if (og + 1u == (tg + 1u) * nx) xb_add(&bar[XB_TOPGEN], 1u);
      else XB_SPIN(xb_ld(&bar[XB_TOPGEN]) == tg, bar);
      __builtin_amdgcn_fence(__ATOMIC_ACQUIRE, "agent");
      xb_add(&bar[XB_XGEN(b.x)], 1u);
      asm volatile("s_waitcnt vmcnt(0)" ::: "memory");
    } else {
      XB_SPIN(xb_ld(&bar[XB_XGEN(b.x)]) == gen, bar);
      __builtin_amdgcn_fence(__ATOMIC_ACQUIRE, "agent");
      asm volatile("s_waitcnt vmcnt(0)" ::: "memory");
    }
  }
  __syncthreads();
}

constexpr int N_PHASES = 24;
template <int ph>
DI void run_phase(const Params& p, char* smem, char* dsm, int bid, int nb, int pbid, int pnb) {
  char* ws = p.ws;
  const float* mods0 = (const float*)(ws + O_MODS); const float* mods1 = mods0 + 9 * 6144;
  bf16_t* HA = (bf16_t*)(ws + O_A); float* XA = (float*)(ws + O_X);
  bf16_t* H1 = (bf16_t*)(ws + O_B);
  if constexpr (ph == 0) phase0(p, smem, bid, nb);
  else if constexpr (ph == 1) phase_prep_a0(p, bid, nb);
  else if constexpr (ph == 2) { EpiWin0 e{(bf16_t*)(ws + O_FQ), (bf16_t*)(ws + O_FKV), (float*)(ws + O_FKR), (bf16_t*)(ws + O_FRW), (float*)(ws + O_RSQ)};
      gemm8_phase(HA, 1024, (const bf16_t*)(ws + O_WIN0), 1024, 1024, 72, 10, 0, 0, e, dsm, pbid, pnb); }
  else if constexpr (ph == 3) {}
  else if constexpr (ph == 4) phase_mixer(p, smem, dsm, bid, nb);
  else if constexpr (ph == 5) { for (int u = bid; u < 576; u += nb) rwkv_out_unit(p, u, smem); }
  else if constexpr (ph == 6) { EpiRes e{p.in[0], p.in[2], XA, mods0, 2048, 1, ALPHA, nullptr, nullptr, nullptr};
      gemm8_phase(HA, 1024, (const bf16_t*)(ws + O_WOUT0), 1024, 1024, 72, 4, 0, 0, e, dsm, pbid, pnb); }
  else if constexpr (ph == 7) phase_ln(p, p.in[24], p.in[25], mods0, 3072, 4096, 0, 0, bid, nb);
  else if constexpr (ph == 8 || ph == 10) { constexpr int hf = (ph - 8) >> 1; EpiMlp1 e{H1};
      gemm8_phase(HA, 1024, (const bf16_t*)(ws + O_W1_0) + (size_t)hf * 2048 * 1024, 1024, 1024, 64, 8, 1, 0, e, dsm, pbid, pnb);
      if constexpr (hf == 0) { EpiMlp1Ctx ec{(bf16_t*)(ws + O_B + 72 * MiB)};
        gemm8_phase(HA, 1024, (const bf16_t*)(ws + O_W1_0), 1024, 1024, 8, 16, 2, 0, ec, dsm, pbid, pnb); } }
  else if constexpr (ph == 9 || ph == 11) { constexpr int hf = (ph - 9) >> 1;
      EpiRes e{p.in[0], p.in[2], XA, mods0, 5120, 0, hf ? 1.f : ALPHA, hf ? nullptr : (const float*)(ws + O_STATS), p.in[24], p.in[25]};
      gemm8_phase(H1, 2048, (const bf16_t*)(ws + O_W2_0) + (size_t)hf * 2048, 4096, 2048, 64, 4, 1, 0, e, dsm, pbid, pnb);
      if constexpr (hf == 0) { EpiPartial ep{p.out, 0, 1};
        gemm8_phase((const bf16_t*)(ws + O_B + 72 * MiB), 4096, (const bf16_t*)(ws + O_W2_0), 4096, 512, 8, 4, 3, 0, ep, dsm, pbid, pnb, 8); } }
  else if constexpr (ph == 12) phase_ln(p, p.in[28], p.in[29], mods1, 0, 1024, 0, 0, bid, nb, 1);
  else if constexpr (ph == 13) { EpiWin1 e{(bf16_t*)(ws + O_GATE), (bf16_t*)(ws + O_XR)};
      gemm8_phase(HA, 1024, (const bf16_t*)(ws + O_WIN1), 1024, 1024, 72, 8, 0, 0, e, dsm, pbid, pnb); }
  else if constexpr (ph == 14) { for (int u = bid; u < 4608; u += nb) lru_unit(p, u, 1, smem); }
  else if constexpr (ph == 15) phase_lru_carry(p, bid, nb);
  else if constexpr (ph == 16) { for (int u = bid; u < 4608; u += nb) lru_unit(p, u, 2, smem); }
  else if constexpr (ph == 17) { EpiRes e{p.in[0], p.in[2], XA, mods1, 2048, 0, ALPHA, (const float*)(ws + O_STATS), p.in[28], p.in[29]};
      gemm8_phase(HA, 1024, (const bf16_t*)(ws + O_WOUT1), 1024, 1024, 64, 4, 1, 0, e, dsm, pbid, pnb); }
  else if constexpr (ph == 18) phase_ln(p, p.in[41], p.in[42], mods1, 3072, 4096, 1, 0, bid, nb);
  else if constexpr (ph == 19 || ph == 21) { constexpr int hf = (ph - 19) >> 1; EpiMlp1 e{H1};
      gemm8_phase(HA, 1024, (const bf16_t*)(ws + O_W1_1) + (size_t)hf * 2048 * 1024, 1024, 1024, 64, 8, 1, 0, e, dsm, pbid, pnb); }
  else if constexpr (ph == 20 || ph == 22) { constexpr int hf = (ph - 20) >> 1; EpiRes e{p.in[0], p.in[2], XA, mods1, 5120, 0, hf ? 1.f : ALPHA, hf ? nullptr : (const float*)(ws + O_STATS), p.in[41], p.in[42]};
      gemm8_phase(H1, 2048, (const bf16_t*)(ws + O_W2_1) + (size_t)hf * 2048, 4096, 2048, 64, 4, 1, 0, e, dsm, pbid, pnb); }
  else if constexpr (ph == 23) phase_ln(p, p.in[45], p.in[46], mods1, 0, 0, 1, 1, bid, nb);
}

template <int PH, int HI>
DI void run_range(const Params& p, char* smem, char* dsm, int bid, int nb, int pbid, int pnb, const XcdBarrier& xb) {
  run_phase<PH>(p, smem, dsm, bid, nb, pbid, pnb);
  if constexpr (PH < HI) { if constexpr (PH != 3) xcd_barrier(xb); run_range<PH + 1, HI>(p, smem, dsm, bid, nb, pbid, pnb, xb); }
}
constexpr int DYN_LDS = 131072;
template <int LO, int HI>
__global__ void __launch_bounds__(512, 2) mega(Params p) {
  extern __shared__ __attribute__((aligned(16))) char dsm[];
  __shared__ uint4 xb_words;
  XcdBarrier xb; xb.bar = (unsigned*)(p.ws + O_BAR); xb.x = 0; xb.st = (volatile LAS unsigned*)&xb_words;
  if constexpr (LO < HI) {
    if (threadIdx.x == 0) xb_words = make_uint4(0u, 0u, 0u, 0u);
    __syncthreads();
    xb = xcd_barrier_post((unsigned*)(p.ws + O_BAR), (volatile LAS unsigned*)&xb_words);
    if (p.njobs < 0) cg::this_grid().sync();
  }
  const int vb = __builtin_amdgcn_readfirstlane(threadIdx.x >> 8);
  run_range<LO, HI>(p, dsm + vb * SMEM_BYTES, dsm, blockIdx.x * 2 + vb, gridDim.x * 2, blockIdx.x, gridDim.x, xb);
}
template <int PH>
static void launch_split(const Params& p, int grid, hipStream_t stream) {
  (void)hipFuncSetAttribute((const void*)mega<PH, PH>, hipFuncAttributeMaxDynamicSharedMemorySize, DYN_LDS);
  hipLaunchKernelGGL((mega<PH, PH>), dim3(grid), dim3(512), DYN_LDS, stream, p);
  if constexpr (PH + 1 < N_PHASES) launch_split<PH + 1>(p, grid, stream);
}

extern "C" void kernel_launch(void* const* d_in, const int* in_sizes, int n_in, void* d_out, int out_size, void* d_ws, size_t ws_size, hipStream_t stream) {
  static int grid_blocks = 0;
  if (!grid_blocks) {
    int dev = 0, cus = 0, per_cu = 0;
    (void)hipGetDevice(&dev);
    (void)hipDeviceGetAttribute(&cus, hipDeviceAttributeMultiprocessorCount, dev);
    (void)hipFuncSetAttribute((const void*)mega<0, N_PHASES - 1>, hipFuncAttributeMaxDynamicSharedMemorySize, DYN_LDS);
    (void)hipOccupancyMaxActiveBlocksPerMultiprocessor(&per_cu, mega<0, N_PHASES - 1>, 512, DYN_LDS);
    if (per_cu > 1) per_cu = 1;
    if (per_cu < 1) per_cu = 1;
    grid_blocks = cus * per_cu;
  }
  if (n_in != 47 || ws_size < 256 * MiB) { fprintf(stderr, "kernel_launch: bad args n_in %d ws %zu\n", n_in, ws_size); return; }
  Params p; memset(&p, 0, sizeof(p));
  for (int i = 0; i < 47; ++i) p.in[i] = (const float*)d_in[i];
  p.out = (float*)d_out; p.ws = (char*)d_ws;
  char* ws = (char*)d_ws;
  int nj = 0, tiles = 0;
  auto add = [&](int src, size_t soff, size_t dst, int K, int N, int Npad, int nbatch, int scale) {
    CvtJob& J = p.jobs[nj++];
    J.src = (const float*)d_in[src] + soff; J.dst = (bf16_t*)(ws + dst); J.scale = scale >= 0 ? (const float*)d_in[scale] : nullptr;
    J.K = K; J.N = N; J.Npad = Npad; J.nbatch = nbatch; J.tile0 = tiles; J.lds = N;
    tiles += nbatch * (K / 64) * (Npad / 64);
  };
  add(6, 0, O_WIN0, 1024, 2560, 2560, 1, -1); p.jobs[nj - 1].lds = 2592;
  add(6, 2560, O_WTAIL, 1024, 32, 256, 1, -1); p.jobs[nj - 1].lds = 2592;
  add(8, 0, O_WUQ, 384, 768, 768, 1, 7);
  add(10, 0, O_WUK, 256, 512, 512, 1, 9);
  add(11, 0, O_WUV, 256, 512, 512, 1, 9);
  add(14, 0, O_W2T, 64, 512, 512, 2, -1);
  add(16, 0, O_A2T, 64, 512, 512, 2, -1);
  add(17, 0, O_G2T, 128, 512, 512, 1, -1);
  p.ncvt_early = tiles;
  add(23, 0, O_WOUT0, 1024, 1024, 1024, 1, -1);
  add(26, 0, O_W1_0, 1024, 4096, 4096, 1, -1);
  add(27, 0, O_W2_0, 4096, 1024, 1024, 1, -1);
  add(32, 0, O_WIN1, 1024, 2048, 2048, 1, -1);
  add(35, 0, O_GAT, 128, 128, 128, 16, -1);
  add(37, 0, O_GXT, 128, 128, 128, 16, -1);
  add(40, 0, O_WOUT1, 1024, 1024, 1024, 1, -1);
  add(43, 0, O_W1_1, 1024, 4096, 4096, 1, -1);
  add(44, 0, O_W2_1, 4096, 1024, 1024, 1, -1);
  p.njobs = nj; p.ncvt = tiles;
#if N_LAUNCH_SPLIT
  launch_split<0>(p, grid_blocks, stream);
#else
  (void)hipMemsetAsync(ws + O_BAR, 0, XCD_BAR_WORDS * 4, stream);
  void* args[] = {&p};
  hipError_t e = hipLaunchCooperativeKernel((void*)mega<0, N_PHASES - 1>, dim3(grid_blocks), dim3(512), args, DYN_LDS, stream);
  if (e != hipSuccess) fprintf(stderr, "cooperative launch failed: %s (grid %d)\n", hipGetErrorString(e), grid_blocks);
#endif
}
```
